# Optimizing an MI355X kernel written in HIP

```python
import math
import jax, jax.numpy as jnp
from jax import lax
import numpy as np

D_MODEL = 1024
BATCH = 8
SEQ = 2048
DEPTH = 2
DEC_BATCH = 128
DEC_SEQ = 4
PAST_LEN = 16384
PAGE_SIZE = 128

GDN_HEADS = 4
GDN_DK = 128
GDN_DV = 128
MLSTM_HEADS = 4
MLSTM_DQK = 64
MLSTM_DV = 64
SSD_HEADS = 4
SSD_HEAD_DIM = 64
SSD_GROUPS = 2
SSD_STATE = 128
CONV_WIDTH = 4
FFN_CONV_WIDTH = 3
D_FF = 2816
CHUNK = 64
EPS = 1e-6

GDN_QK = GDN_HEADS * GDN_DK
GDN_V = GDN_HEADS * GDN_DV
MLSTM_QK = MLSTM_HEADS * MLSTM_DQK
MLSTM_V = MLSTM_HEADS * MLSTM_DV
SSD_INNER = SSD_HEADS * SSD_HEAD_DIM
SSD_BC = SSD_GROUPS * SSD_STATE
D_MIX = GDN_V + MLSTM_V + SSD_INNER
CONV_DIM = 2 * GDN_QK + GDN_V + SSD_INNER + 2 * SSD_BC
IN_COLS = CONV_DIM + GDN_V + 2 * GDN_HEADS + 2 * MLSTM_QK + 2 * MLSTM_V + 2 * MLSTM_HEADS + SSD_INNER + SSD_HEADS
CONV_SIZES = (GDN_QK, GDN_QK, GDN_V, SSD_INNER, SSD_BC, SSD_BC)
REST_SIZES = (GDN_V, GDN_HEADS, GDN_HEADS, MLSTM_QK, MLSTM_QK, MLSTM_V, MLSTM_V,
              MLSTM_HEADS, MLSTM_HEADS, SSD_INNER, SSD_HEADS)

kernel_name = "hymba_gdn_mlstm_ssd_convffn_step"


def rms_norm(x, w):
    xf = x.astype(jnp.float32)
    y = xf * lax.rsqrt(jnp.mean(xf * xf, axis=-1, keepdims=True) + EPS)
    return (y * w.astype(jnp.float32)).astype(x.dtype)


def l2norm(x):
    return x * lax.rsqrt(jnp.sum(x * x, axis=-1, keepdims=True) + EPS)


def _split(t, sizes):
    return jnp.split(t, np.cumsum(sizes)[:-1].tolist(), axis=-1)


def _to_chunks(t, n_chunks):
    b, l = t.shape[:2]
    return jnp.swapaxes(t.reshape((b, n_chunks, l // n_chunks) + t.shape[2:]), 0, 1)


def _from_chunks(t):
    t = jnp.swapaxes(t, 0, 1)
    return t.reshape((t.shape[0], t.shape[1] * t.shape[2]) + t.shape[3:])


def _masks(c):
    tril = jnp.tril(jnp.ones((c, c), dtype=bool))
    strict = jnp.tril(jnp.ones((c, c), dtype=bool), -1)
    return tril, strict


def causal_dwconv(x, buf, w, b):
    width = w.shape[0]
    L = x.shape[1]
    xp = jnp.concatenate([buf.astype(x.dtype), x], axis=1)
    y = b
    for j in range(width):
        y = y + w[j] * xp[:, j:j + L]
    return y, xp[:, L:]


def gdn_chunked(q, k, v, g, beta, s0):
    L = q.shape[1]
    c = math.gcd(L, CHUNK)
    n = L // c
    tril, strict = _masks(c)
    eye = jnp.eye(c, dtype=jnp.float32)

    def step(s, inp):
        qi, ki, vi, gi, bi = inp
        gam = jnp.cumsum(jnp.swapaxes(gi, 1, 2), axis=-1)
        bh = jnp.swapaxes(bi, 1, 2)
        decay = jnp.exp(jnp.where(tril, gam[..., :, None] - gam[..., None, :], -jnp.inf))
        kk = jnp.einsum('bihd,bjhd->bhij', ki, ki)
        m = jnp.where(strict, kk * decay * bh[..., :, None], 0.0)
        t = lax.linalg.triangular_solve(m + eye, jnp.broadcast_to(eye, m.shape), left_side=True,
                                        lower=True, unit_diagonal=True)
        u = jnp.einsum('bhij,bjhv,bhj->bhiv', t, vi, bh)
        wk = jnp.einsum('bhij,bjhd,bhj->bhid', t, ki, bh * jnp.exp(gam))
        v_new = u - jnp.einsum('bhid,bhdv->bhiv', wk, s)
        qk = jnp.einsum('bihd,bjhd->bhij', qi, ki) * decay
        o = (jnp.einsum('bihd,bhi,bhdv->bhiv', qi, jnp.exp(gam), s)
             + jnp.einsum('bhij,bhjv->bhiv', qk, v_new))
        g_last = gam[..., -1]
        s_new = (jnp.exp(g_last)[..., None, None] * s
                 + jnp.einsum('bjhd,bhj,bhjv->bhdv', ki, jnp.exp(g_last[..., None] - gam), v_new))
        return s_new, jnp.swapaxes(o, 1, 2)

    xs = tuple(_to_chunks(t, n) for t in (q, k, v, g, beta))
    s_fin, o = lax.scan(step, s0, xs)
    return _from_chunks(o), s_fin


def mlstm_chunked(q, k, v, log_i, log_f, c0, n0, m0):
    L = q.shape[1]
    c = math.gcd(L, CHUNK)
    n = L // c
    tril, _ = _masks(c)

    def step(carry, inp):
        cm, nv, m = carry
        qi, ki, vi, ii, fi = inp
        b = jnp.cumsum(jnp.swapaxes(fi, 1, 2), axis=-1)
        ih = jnp.swapaxes(ii, 1, 2)
        d = jnp.where(tril, b[..., :, None] - b[..., None, :] + ih[..., None, :], -jnp.inf)
        inter = b + m[..., None]
        m_t = jnp.maximum(inter, jnp.max(d, axis=-1))
        w_intra = jnp.exp(d - m_t[..., None])
        w_inter = jnp.exp(inter - m_t)
        s = jnp.einsum('bihd,bjhd->bhij', qi, ki) * w_intra
        num = (jnp.einsum('bihd,bhdv->bhiv', qi, cm) * w_inter[..., None]
               + jnp.einsum('bhij,bjhv->bhiv', s, vi))
        den = jnp.einsum('bihd,bhd->bhi', qi, nv) * w_inter + jnp.sum(s, axis=-1)
        den = jnp.maximum(jnp.abs(den), jnp.exp(-m_t))
        h = jnp.swapaxes(num / den[..., None], 1, 2)
        m_new = m_t[..., -1]
        b_last = b[..., -1]
        w_c = jnp.exp(b_last + m - m_new)
        w_k = jnp.exp(b_last[..., None] - b + ih - m_new[..., None])
        c_new = w_c[..., None, None] * cm + jnp.einsum('bjhd,bhj,bjhv->bhdv', ki, w_k, vi)
        n_new = w_c[..., None] * nv + jnp.einsum('bjhd,bhj->bhd', ki, w_k)
        return (c_new, n_new, m_new), h

    xs = tuple(_to_chunks(t, n) for t in (q, k, v, log_i, log_f))
    (c_fin, n_fin, m_fin), h = lax.scan(step, (c0, n0, m0), xs)
    return _from_chunks(h), c_fin, n_fin, m_fin


def ssd_chunked(x, dt, a, bm, cm, h0):
    L = x.shape[1]
    c = math.gcd(L, CHUNK)
    n = L // c
    tril, _ = _masks(c)
    rep = SSD_HEADS // SSD_GROUPS
    bh_ = jnp.repeat(bm, rep, axis=2)
    ch_ = jnp.repeat(cm, rep, axis=2)

    def step(h, inp):
        xi, dti, bi, ci = inp
        dth = jnp.swapaxes(dti, 1, 2)
        gam = jnp.cumsum(dth * a[:, None], axis=-1)
        decay = jnp.exp(jnp.where(tril, gam[..., :, None] - gam[..., None, :], -jnp.inf))
        cb = jnp.einsum('bihn,bjhn->bhij', ci, bi) * decay * dth[..., None, :]
        y = (jnp.einsum('bhij,bjhp->bihp', cb, xi)
             + jnp.einsum('bihn,bhi,bhpn->bihp', ci, jnp.exp(gam), h))
        g_last = gam[..., -1]
        h_new = (jnp.exp(g_last)[..., None, None] * h
                 + jnp.einsum('bjhp,bhj,bjhn->bhpn', xi, jnp.exp(g_last[..., None] - gam) * dth, bi))
        return h_new, y

    xs = tuple(_to_chunks(t, n) for t in (x, dt, bh_, ch_))
    h_fin, y = lax.scan(step, h0, xs)
    return _from_chunks(y), h_fin


def hybrid_mixer(h, conv_state, gdn_state, ml_c, ml_n, ml_m, ssd_state, w_in, conv_w, conv_b,
                 gdn_a_log, gdn_dt_bias, gdn_norm, mlstm_i_bias, mlstm_f_bias, mlstm_norm,
                 ssd_a_log, ssd_dt_bias, ssd_d, ssd_norm, w_out):
    B, L, _ = h.shape
    f32 = lambda t: t.astype(jnp.float32)
    proj = jnp.einsum('bld,de->ble', h, w_in)
    conv_in, rest = proj[..., :CONV_DIM], proj[..., CONV_DIM:]
    conv_out, new_conv = causal_dwconv(conv_in, conv_state, conv_w, conv_b)
    conv_out = jax.nn.silu(conv_out)
    gq, gk, gv, sx, sb, sc = _split(conv_out, CONV_SIZES)
    gg, ga, gb, mq, mk, mv, mo, mi, mf, sz, sdt = _split(rest, REST_SIZES)

    q = l2norm(f32(gq).reshape(B, L, GDN_HEADS, GDN_DK)) * (GDN_DK ** -0.5)
    k = l2norm(f32(gk).reshape(B, L, GDN_HEADS, GDN_DK))
    v = f32(gv).reshape(B, L, GDN_HEADS, GDN_DV)
    g = -jnp.exp(f32(gdn_a_log)) * jax.nn.softplus(f32(ga) + f32(gdn_dt_bias))
    beta = jax.nn.sigmoid(f32(gb))
    o_gdn, gdn_new = gdn_chunked(q, k, v, g, beta, f32(gdn_state))
    o_gdn = rms_norm(o_gdn, gdn_norm) * jax.nn.silu(f32(gg).reshape(B, L, GDN_HEADS, GDN_DV))
    o_gdn = o_gdn.reshape(B, L, GDN_V)

    mq_ = f32(mq).reshape(B, L, MLSTM_HEADS, MLSTM_DQK)
    mk_ = f32(mk).reshape(B, L, MLSTM_HEADS, MLSTM_DQK) * (MLSTM_DQK ** -0.5)
    mv_ = f32(mv).reshape(B, L, MLSTM_HEADS, MLSTM_DV)
    log_i = f32(mi) + f32(mlstm_i_bias)
    log_f = jax.nn.log_sigmoid(f32(mf) + f32(mlstm_f_bias))
    h_ml, c_new, n_new, m_new = mlstm_chunked(mq_, mk_, mv_, log_i, log_f, f32(ml_c), f32(ml_n), f32(ml_m))
    h_ml = jax.nn.sigmoid(f32(mo)).reshape(B, L, MLSTM_HEADS, MLSTM_DV) * h_ml
    h_ml = rms_norm(h_ml, mlstm_norm).reshape(B, L, MLSTM_V)

    xs = f32(sx).reshape(B, L, SSD_HEADS, SSD_HEAD_DIM)
    bm = f32(sb).reshape(B, L, SSD_GROUPS, SSD_STATE)
    cm = f32(sc).reshape(B, L, SSD_GROUPS, SSD_STATE)
    dt = jax.nn.softplus(f32(sdt) + f32(ssd_dt_bias))
    a = -jnp.exp(f32(ssd_a_log))
    y_ssd, ssd_new = ssd_chunked(xs, dt, a, bm, cm, f32(ssd_state))
    y_ssd = (y_ssd + f32(ssd_d)[:, None] * xs).reshape(B, L, SSD_INNER)
    y_ssd = rms_norm(y_ssd * jax.nn.silu(f32(sz)), ssd_norm)

    mix = jnp.concatenate([o_gdn, h_ml, y_ssd], axis=-1).astype(h.dtype)
    out = jnp.einsum('ble,ed->bld', mix, w_out)
    return (out, new_conv.astype(conv_state.dtype), gdn_new.astype(gdn_state.dtype),
            c_new.astype(ml_c.dtype), n_new.astype(ml_n.dtype), m_new.astype(ml_m.dtype),
            ssd_new.astype(ssd_state.dtype))


def conv_ffn(h, ffn_state, w_up, conv_w, conv_b, w_down):
    up = jnp.einsum('bld,df->blf', h, w_up)
    gate, val = up[..., :D_FF], up[..., D_FF:]
    gate, new_state = causal_dwconv(gate, ffn_state, conv_w, conv_b)
    out = jnp.einsum('blf,fd->bld', jax.nn.gelu(gate, approximate=True) * val, w_down)
    return out, new_state.astype(ffn_state.dtype)


def run_trunk(x, conv_s, gdn_s, mc_s, mn_s, mm_s, ssd_s, ffn_s, weights):
    (norm_mix_pre, norm_mix_post, norm_ffn_pre, norm_ffn_post, w_in, conv_w, conv_b,
     gdn_a_log, gdn_dt_bias, gdn_norm, mlstm_i_bias, mlstm_f_bias, mlstm_norm,
     ssd_a_log, ssd_dt_bias, ssd_d, ssd_norm, w_out,
     ffn_w_up, ffn_conv_w, ffn_conv_b, ffn_w_down) = weights
    per_layer = []
    for l in range(DEPTH):
        hn = rms_norm(x, norm_mix_pre[l])
        mix, nc, ng, nmc, nmn, nmm, nss = hybrid_mixer(
            hn, conv_s[l], gdn_s[l], mc_s[l], mn_s[l], mm_s[l], ssd_s[l], w_in[l], conv_w[l], conv_b[l],
            gdn_a_log[l], gdn_dt_bias[l], gdn_norm[l], mlstm_i_bias[l], mlstm_f_bias[l], mlstm_norm[l],
            ssd_a_log[l], ssd_dt_bias[l], ssd_d[l], ssd_norm[l], w_out[l])
        x = x + rms_norm(mix, norm_mix_post[l])
        hn = rms_norm(x, norm_ffn_pre[l])
        f, nf = conv_ffn(hn, ffn_s[l], ffn_w_up[l], ffn_conv_w[l], ffn_conv_b[l], ffn_w_down[l])
        x = x + rms_norm(f, norm_ffn_post[l])
        per_layer.append((nc, ng, nmc, nmn, nmm, nss, nf))
    new_states = [jnp.stack(s, axis=0) for s in zip(*per_layer)]
    return x, new_states


def _dt_bias(key, shape):
    dt = jnp.exp(jax.random.uniform(key, shape, minval=math.log(1e-3), maxval=math.log(1e-1)))
    return dt + jnp.log(-jnp.expm1(-dt))


def setup_inputs(seed: int = 0) -> dict:
    key = jax.random.key(seed)
    ks = iter(jax.random.split(key, 48))
    nrm = lambda shape, scale: scale * jax.random.normal(next(ks), shape, dtype=jnp.float32)
    gain = lambda shape: 1.0 + nrm(shape, 0.05)
    Dp = DEPTH
    inp = {}
    inp["x_prompt"] = nrm((BATCH, SEQ, D_MODEL), 1.0)
    inp["x_sample"] = nrm((DEC_BATCH, DEC_SEQ, D_MODEL), 1.0)
    inp["state_conv"] = nrm((Dp, DEC_BATCH, CONV_WIDTH - 1, CONV_DIM), 1.0)
    inp["state_gdn"] = nrm((Dp, DEC_BATCH, GDN_HEADS, GDN_DK, GDN_DV), 0.3)
    inp["state_mlstm_c"] = nrm((Dp, DEC_BATCH, MLSTM_HEADS, MLSTM_DQK, MLSTM_DV), 0.3)
    inp["state_mlstm_n"] = nrm((Dp, DEC_BATCH, MLSTM_HEADS, MLSTM_DQK), 0.3)
    inp["state_mlstm_m"] = nrm((Dp, DEC_BATCH, MLSTM_HEADS), 1.0)
    inp["state_ssd"] = nrm((Dp, DEC_BATCH, SSD_HEADS, SSD_HEAD_DIM, SSD_STATE), 0.3)
    inp["state_ffn_conv"] = nrm((Dp, DEC_BATCH, FFN_CONV_WIDTH - 1, D_FF), 1.0)
    inp["norm_mix_pre"] = gain((Dp, D_MODEL))
    inp["norm_mix_post"] = gain((Dp, D_MODEL))
    inp["norm_ffn_pre"] = gain((Dp, D_MODEL))
    inp["norm_ffn_post"] = gain((Dp, D_MODEL))
    inp["w_in"] = nrm((Dp, D_MODEL, IN_COLS), D_MODEL ** -0.5)
    inp["conv_w"] = nrm((Dp, CONV_WIDTH, CONV_DIM), CONV_WIDTH ** -0.5)
    inp["conv_b"] = nrm((Dp, CONV_DIM), 0.01)
    inp["gdn_a_log"] = jnp.log(jax.random.uniform(next(ks), (Dp, GDN_HEADS), minval=1.0, maxval=16.0))
    inp["gdn_dt_bias"] = _dt_bias(next(ks), (Dp, GDN_HEADS))
    inp["gdn_norm"] = gain((Dp, GDN_DV))
    inp["mlstm_i_bias"] = nrm((Dp, MLSTM_HEADS), 0.1)
    inp["mlstm_f_bias"] = jnp.linspace(3.0, 6.0, MLSTM_HEADS, dtype=jnp.float32)[None, :] + nrm((Dp, MLSTM_HEADS), 0.1)
    inp["mlstm_norm"] = gain((Dp, MLSTM_DV))
    inp["ssd_a_log"] = jnp.log(jax.random.uniform(next(ks), (Dp, SSD_HEADS), minval=1.0, maxval=16.0))
    inp["ssd_dt_bias"] = _dt_bias(next(ks), (Dp, SSD_HEADS))
    inp["ssd_d"] = gain((Dp, SSD_HEADS))
    inp["ssd_norm"] = gain((Dp, SSD_INNER))
    inp["w_out"] = nrm((Dp, D_MIX, D_MODEL), D_MIX ** -0.5)
    inp["ffn_w_up"] = nrm((Dp, D_MODEL, 2 * D_FF), D_MODEL ** -0.5)
    inp["ffn_conv_w"] = nrm((Dp, FFN_CONV_WIDTH, D_FF), FFN_CONV_WIDTH ** -0.5)
    inp["ffn_conv_b"] = nrm((Dp, D_FF), 0.01)
    inp["ffn_w_down"] = nrm((Dp, D_FF, D_MODEL), D_FF ** -0.5)
    return inp


def reference(x_prompt, x_sample, state_conv, state_gdn, state_mlstm_c, state_mlstm_n, state_mlstm_m,
              state_ssd, state_ffn_conv, norm_mix_pre, norm_mix_post, norm_ffn_pre, norm_ffn_post,
              w_in, conv_w, conv_b, gdn_a_log, gdn_dt_bias, gdn_norm, mlstm_i_bias, mlstm_f_bias,
              mlstm_norm, ssd_a_log, ssd_dt_bias, ssd_d, ssd_norm, w_out,
              ffn_w_up, ffn_conv_w, ffn_conv_b, ffn_w_down):
    weights = (norm_mix_pre, norm_mix_post, norm_ffn_pre, norm_ffn_post, w_in, conv_w, conv_b,
               gdn_a_log, gdn_dt_bias, gdn_norm, mlstm_i_bias, mlstm_f_bias, mlstm_norm,
               ssd_a_log, ssd_dt_bias, ssd_d, ssd_norm, w_out,
               ffn_w_up, ffn_conv_w, ffn_conv_b, ffn_w_down)
    bp = x_prompt.shape[0]
    dtp = x_prompt.dtype
    z_conv = jnp.zeros((DEPTH, bp, CONV_WIDTH - 1, CONV_DIM), dtp)
    z_gdn = jnp.zeros((DEPTH, bp, GDN_HEADS, GDN_DK, GDN_DV), dtp)
    z_mc = jnp.zeros((DEPTH, bp, MLSTM_HEADS, MLSTM_DQK, MLSTM_DV), dtp)
    z_mn = jnp.zeros((DEPTH, bp, MLSTM_HEADS, MLSTM_DQK), dtp)
    z_mm = jnp.zeros((DEPTH, bp, MLSTM_HEADS), dtp)
    z_ssd = jnp.zeros((DEPTH, bp, SSD_HEADS, SSD_HEAD_DIM, SSD_STATE), dtp)
    z_ffn = jnp.zeros((DEPTH, bp, FFN_CONV_WIDTH - 1, D_FF), dtp)
    y_prompt, (p_conv, p_gdn, p_mc, p_mn, p_mm, p_ssd, p_ffn) = run_trunk(
        x_prompt, z_conv, z_gdn, z_mc, z_mn, z_mm, z_ssd, z_ffn, weights)
    y_sample, (s_conv, s_gdn, s_mc, s_mn, s_mm, s_ssd, s_ffn) = run_trunk(
        x_sample, state_conv, state_gdn, state_mlstm_c, state_mlstm_n, state_mlstm_m, state_ssd,
        state_ffn_conv, weights)
    return (y_prompt, y_sample, p_conv, p_gdn, p_mc, p_mn, p_mm, p_ssd, p_ffn,
            s_conv, s_gdn, s_mc, s_mn, s_mm, s_ssd, s_ffn)
```

```cpp
#include <hip/hip_runtime.h>
#include <hip/hip_cooperative_groups.h>
#include <cstdio>
namespace cg = cooperative_groups;
namespace pg8 {
#define PG8_LAS __attribute__((address_space(3)))
}
__device__ __forceinline__ int otid() { int t = threadIdx.x; asm volatile("" : "+v"(t)); return t; }
__device__ __forceinline__ int obid() { int b = blockIdx.x; asm volatile("" : "+s"(b)); return b; }
namespace pg8 {
typedef unsigned short bf16_t;
typedef short bf16x8 __attribute__((ext_vector_type(8)));
typedef float f32x4 __attribute__((ext_vector_type(4)));
typedef unsigned u32x4 __attribute__((ext_vector_type(4)));
constexpr int BM = 256, BK = 64, HALF = 128, HTB = HALF * BK * 2  , STAGE_BYTES = 8 * HTB, NXCD = 8, WGM = 8;

__host__ __device__ __forceinline__ int lds_byte(int r, int c) { const int st = (r >> 4) * 2 + (c >> 5), rr = r & 15, cc = c & 31, ob = rr * 64 + cc * 2; return st * 1024 + (ob ^ (((ob >> 9) & 1) << 5)); }
__host__ __device__ __forceinline__ void stage_rc(int b, int& R, int& C) { const int st = b / 1024, sb = b % 1024, swz = sb ^ (((sb >> 9) & 1) << 5); R = (st >> 1) * 16 + swz / 64; C = (st & 1) * 32 + (swz % 64) / 2; }
__host__ __device__ __forceinline__ int perm32(int rho) { const int n = rho >> 4, i = rho & 15; return 8 * (i >> 2) + 4 * n + (i & 3); }
struct Unit { int pm, pn; };
struct Gemm { const bf16_t* A; const bf16_t* Bt; int M, N, K; };

struct StaticOrder {
    int nM, nN, nwg, G, c;
    __host__ __device__ void init(int M, int N, int G_, int c_) { nM = M / BM; nN = N / BM; nwg = nM * nN; G = G_; c = c_; }
    __host__ __device__ bool next(int i, Unit& u) const {
        const long L = (long)i * G + c; if (L >= nwg) return false;
        int wgid = (int)L; { const int q = nwg / NXCD, r = nwg % NXCD, xcd = wgid % NXCD, off = wgid / NXCD; wgid = (xcd < r ? xcd * (q + 1) : r * (q + 1) + (xcd - r) * q) + off; }
        const int nig = WGM * nN, gid = wgid / nig, fm = gid * WGM, gsz = (nM - fm) < WGM ? (nM - fm) : WGM;
        u.pm = fm + ((wgid % nig) % gsz); u.pn = (wgid % nig) / gsz; return true;
    }
    __device__ __forceinline__ void a_ready(const Unit&) const {}
    __device__ __forceinline__ void done(const Unit&) const {}
};
__device__ __forceinline__ unsigned cvt_pk_bf16(float lo, float hi) { unsigned r; asm volatile("v_cvt_pk_bf16_f32 %0, %1, %2" : "=v"(r) : "v"(lo), "v"(hi)); return r; }
struct EpiSplit {
    static constexpr bool PERM = true, AFTER_DRAIN = false;
    bf16_t* O1; int ld1; int nt1; bf16_t* O2; int ld2;
    __device__ __forceinline__ void operator()(const f32x4 (&acc)[2][2][4][2], const Unit& u, int wr, int wc, int fr, int fq) const {
        bf16_t* base; int colt, ld;
        if (u.pn < nt1) { base = O1; colt = u.pn * BM; ld = ld1; } else { base = O2; colt = (u.pn - nt1) * BM; ld = ld2; }
        const int row0 = u.pm * BM + wr * 64 + fr; const int col0 = colt + wc * 32 + 8 * fq;
#pragma unroll
        for (int ai = 0; ai < 2; ++ai)
#pragma unroll
            for (int m = 0; m < 4; ++m) { bf16_t* rowp = base + (size_t)(row0 + ai * HALF + m * 16) * ld + col0;
#pragma unroll
                for (int bj = 0; bj < 2; ++bj) { const f32x4 v0 = acc[ai][bj][m][0], v1 = acc[ai][bj][m][1];
                    u32x4 w; w.x = cvt_pk_bf16(v0[0], v0[1]); w.y = cvt_pk_bf16(v0[2], v0[3]); w.z = cvt_pk_bf16(v1[0], v1[1]); w.w = cvt_pk_bf16(v1[2], v1[3]);
                    *(u32x4*)(rowp + bj * HALF) = w; } }
    }
};
template <class Epi, class Sched, bool STAMP = false>
__device__ __forceinline__ void gemm_phase(PG8_LAS unsigned char* lds, const Gemm g, const Sched& S, const Epi& E, unsigned long long* stamps) {
    const int tid = otid(), wid = __builtin_amdgcn_readfirstlane(tid >> 6), lane = tid & 63, wr = wid >> 2, wc = wid & 3, fr = lane & 15, fq = lane >> 4;
    const int K = g.K, nt = K / BK;
    int ts_lo = 0, ts_hi = 0, nts = 0; const unsigned long long rt_entry = STAMP ? (unsigned long long)wall_clock64() : 0ull;
#define PG8_STAMP() do { if (STAMP && wid == 0 && nts < 64) { const unsigned long long _c = (unsigned long long)clock64(); \
        ts_lo = (lane == nts) ? (int)(unsigned)_c : ts_lo; ts_hi = (lane == nts) ? (int)(unsigned)(_c >> 32) : ts_hi; ++nts; } } while (0)
    PG8_STAMP();
    unsigned voffA[2], voffB[2];
#pragma unroll
    for (int i = 0; i < 2; ++i) { int R, C; stage_rc(tid * 16 + i * 8192, R, C); const int Rb = Epi::PERM ? ((R & ~31) + perm32(R & 31)) : R;
        voffA[i] = (unsigned)(R * K + C) * 2u; voffB[i] = (unsigned)(Rb * K + C) * 2u; }
    const size_t kstep = (size_t)(BK * 2);
    const size_t hstep = (size_t)HALF * K * 2;
    const size_t tstep = 2 * hstep;
    const unsigned ldsw = (unsigned)wid * 1024u;
    const int aoff = lds_byte(wr * 64 + fr, fq * 8), boff = lds_byte(wc * 32 + fr, fq * 8);
#define PG8_SA(b, h) (((b) * 2 + (h)) * HTB)
#define PG8_SB(b, h) ((4 + (b) * 2 + (h)) * HTB)
#define PG8_STAGE(bufoff, gbase, voff) do { _Pragma("unroll") for (int _i = 0; _i < 2; ++_i) \
        __builtin_amdgcn_global_load_lds((const unsigned*)((const char*)(gbase) + (voff)[_i]), (PG8_LAS unsigned*)(lds + (bufoff) + ldsw + _i * 8192), 16, 0, 0); } while (0)
#define PG8_LDA(dst, b, h) do { _Pragma("unroll") for (int m = 0; m < 4; ++m) _Pragma("unroll") for (int k = 0; k < 2; ++k) dst[m][k] = *(const PG8_LAS bf16x8*)(lds + PG8_SA(b, h) + aoff + m * 2048 + k * 1024); } while (0)
#define PG8_LDB(dst, b, h) do { _Pragma("unroll") for (int n = 0; n < 2; ++n) _Pragma("unroll") for (int k = 0; k < 2; ++k) dst[n][k] = *(const PG8_LAS bf16x8*)(lds + PG8_SB(b, h) + boff + n * 2048 + k * 1024); } while (0)
#define PG8_MMA(ai, bj, At, Bt) do { __builtin_amdgcn_s_setprio(1); _Pragma("unroll") for (int m = 0; m < 4; ++m) _Pragma("unroll") for (int n = 0; n < 2; ++n) _Pragma("unroll") for (int k = 0; k < 2; ++k) \
        acc[ai][bj][m][n] = __builtin_amdgcn_mfma_f32_16x16x32_bf16(Bt[n][k], At[m][k], acc[ai][bj][m][n], 0, 0, 0); __builtin_amdgcn_s_setprio(0); } while (0)
#define PG8_WAIT_V(n) asm volatile("s_waitcnt vmcnt(" #n ")" ::: "memory")
#define PG8_WAIT_L(n) asm volatile("s_waitcnt lgkmcnt(" #n ")" ::: "memory")
#define PG8_BAR __builtin_amdgcn_s_barrier()
#define PG8_SCHED __builtin_amdgcn_sched_barrier(0)
    Unit cur, nxt; int ui = 0;
    if (!S.next(0, cur)) return;
    f32x4 acc[2][2][4][2];
#pragma unroll
    for (int a = 0; a < 2; ++a)
#pragma unroll
        for (int b = 0; b < 2; ++b)
#pragma unroll
            for (int m = 0; m < 4; ++m)
#pragma unroll
                for (int n = 0; n < 2; ++n) acc[a][b][m][n] = (f32x4){0.f, 0.f, 0.f, 0.f};
    bf16x8 At[4][2], B0[2][2], B1[2][2];
    const char* cA = (const char*)g.A + (size_t)cur.pm * tstep; const char* cB = (const char*)g.Bt + (size_t)cur.pn * tstep;
    S.a_ready(cur);
    PG8_STAGE(PG8_SB(0, 0), cB, voffB); PG8_STAGE(PG8_SA(0, 0), cA, voffA); PG8_STAGE(PG8_SB(0, 1), cB + hstep, voffB); PG8_STAGE(PG8_SA(0, 1), cA + hstep, voffA);
    if (wr == 1) PG8_BAR;
    PG8_WAIT_V(4); PG8_BAR;
    PG8_STAGE(PG8_SB(1, 0), cB + kstep, voffB); PG8_STAGE(PG8_SA(1, 0), cA + kstep, voffA); PG8_STAGE(PG8_SB(1, 1), cB + hstep + kstep, voffB);
    PG8_WAIT_V(6); PG8_BAR;
    PG8_STAMP();
    for (;;) {
        const bool has_next = S.next(ui + 1, nxt);
        const char* nA = has_next ? (const char*)g.A + (size_t)nxt.pm * tstep : cA; const char* nB = has_next ? (const char*)g.Bt + (size_t)nxt.pn * tstep : cB;
        for (int t = 0; t < nt; t += 2) {
            const bool last = (t == nt - 2);
            const char* a1 = cA + (size_t)(t + 1) * kstep;
            const char* a2 = last ? nA : cA + (size_t)(t + 2) * kstep; const char* b2 = last ? nB : cB + (size_t)(t + 2) * kstep;
            const char* a3 = a2 + kstep; const char* b3 = b2 + kstep;
            if (last && has_next) S.a_ready(nxt);
            PG8_LDB(B0, 0, 0); PG8_SCHED; PG8_LDA(At, 0, 0); PG8_STAGE(PG8_SA(1, 1), a1 + hstep, voffA);
            PG8_WAIT_L(8); PG8_BAR; PG8_WAIT_L(0); PG8_MMA(0, 0, At, B0); PG8_BAR; PG8_SCHED;
            PG8_LDB(B1, 0, 1); PG8_STAGE(PG8_SB(0, 0), b2, voffB);
            PG8_BAR; PG8_WAIT_L(0); PG8_MMA(0, 1, At, B1); PG8_BAR;
            PG8_LDA(At, 0, 1); PG8_STAGE(PG8_SA(0, 0), a2, voffA);
            PG8_BAR; PG8_WAIT_L(0); PG8_MMA(1, 0, At, B0); PG8_BAR; PG8_SCHED;
            PG8_STAGE(PG8_SB(0, 1), b2 + hstep, voffB);
            PG8_WAIT_V(6); PG8_BAR; PG8_MMA(1, 1, At, B1); PG8_BAR;
            PG8_LDB(B0, 1, 0); PG8_SCHED; PG8_LDA(At, 1, 0); PG8_STAGE(PG8_SA(0, 1), a2 + hstep, voffA);
            PG8_WAIT_L(8); PG8_BAR; PG8_WAIT_L(0); PG8_MMA(0, 0, At, B0); PG8_BAR; PG8_SCHED;
            PG8_LDB(B1, 1, 1); PG8_STAGE(PG8_SB(1, 0), b3, voffB);
            PG8_BAR; PG8_WAIT_L(0); PG8_MMA(0, 1, At, B1); PG8_BAR;
            PG8_LDA(At, 1, 1); PG8_STAGE(PG8_SA(1, 0), a3, voffA);
            PG8_BAR; PG8_WAIT_L(0); PG8_MMA(1, 0, At, B0); PG8_BAR; PG8_SCHED;
            PG8_STAGE(PG8_SB(1, 1), b3 + hstep, voffB);
            PG8_WAIT_V(6); PG8_BAR; PG8_MMA(1, 1, At, B1); PG8_BAR;
        }
        PG8_STAMP();
        if constexpr (!Epi::AFTER_DRAIN) { E(acc, cur, wr, wc, fr, fq); S.done(cur); }
        PG8_STAMP();
        if (!has_next) break;
#pragma unroll
        for (int a = 0; a < 2; ++a)
#pragma unroll
            for (int b = 0; b < 2; ++b)
#pragma unroll
                for (int m = 0; m < 4; ++m)
#pragma unroll
                    for (int n = 0; n < 2; ++n) acc[a][b][m][n] = (f32x4){0.f, 0.f, 0.f, 0.f};
        cur = nxt; cA = nA; cB = nB; ++ui;
    }
    PG8_WAIT_V(0);
    if (wr == 0) PG8_BAR;
    PG8_BAR;
    if constexpr (Epi::AFTER_DRAIN) { E.fused(acc, cur, wr, wc, fr, fq, lds, wid, lane); S.done(cur); }
    PG8_STAMP();
    if (STAMP && wid == 0) { stamps[lane] = lane < nts ? (((unsigned long long)(unsigned)ts_hi << 32) | (unsigned)ts_lo) : 0ull;
        if (lane == 62) stamps[62] = rt_entry; if (lane == 63) stamps[63] = (unsigned long long)wall_clock64(); }
#undef PG8_STAMP
#undef PG8_SA
#undef PG8_SB
#undef PG8_STAGE
#undef PG8_LDA
#undef PG8_LDB
#undef PG8_MMA
#undef PG8_WAIT_V
#undef PG8_WAIT_L
#undef PG8_BAR
#undef PG8_SCHED
}
}
using pg8::bf16_t;

constexpr int NTOK = 16896, NPROMPT = 16384, DM = 1024, CONVD = 2304, INC = 4116, INCP = 4352, PBLD = 2048, DFF = 2816;
constexpr int O_GG = 0, O_MQ = 520, O_MK = 776, O_MV = 1032, O_MO = 1288, O_MI = 1544, O_MF = 1548, O_SZ = 1552, O_SDT = 1808, O_GA = 512, O_GB = 516;
constexpr float EPSF = 1e-6f;

struct Params {
  const float* in[31];
  float* out;
  unsigned char* ws;
  long o_ys, o_pconv, o_pgdn, o_pmc, o_pmn, o_pmm, o_pssd, o_pffn, o_sconv, o_sgdn, o_smc, o_smn, o_smm, o_sssd, o_sffn;
  size_t w_in, w_out, w_up, w_dn, hn, gates, ctr, big;
};
constexpr size_t SZ_PROJA = (size_t)NTOK * CONVD * 2, SZ_PROJB = (size_t)NTOK * PBLD * 2, SZ_GV = (size_t)NTOK * DFF * 2;

__device__ __forceinline__ float bf2f(unsigned short b) { return __uint_as_float((unsigned)b << 16); }
__device__ __forceinline__ void unpack8(const uint4 u, float (&f)[8]) {
  f[0] = __uint_as_float(u.x << 16); f[1] = __uint_as_float(u.x & 0xffff0000u);
  f[2] = __uint_as_float(u.y << 16); f[3] = __uint_as_float(u.y & 0xffff0000u);
  f[4] = __uint_as_float(u.z << 16); f[5] = __uint_as_float(u.z & 0xffff0000u);
  f[6] = __uint_as_float(u.w << 16); f[7] = __uint_as_float(u.w & 0xffff0000u);
}
__device__ __forceinline__ uint4 pack8(const float (&f)[8]) {
  uint4 r; r.x = pg8::cvt_pk_bf16(f[0], f[1]); r.y = pg8::cvt_pk_bf16(f[2], f[3]); r.z = pg8::cvt_pk_bf16(f[4], f[5]); r.w = pg8::cvt_pk_bf16(f[6], f[7]); return r;
}
__device__ __forceinline__ void load8f(const float* p, float (&f)[8]) {
  const float4 a = *(const float4*)p, b = *(const float4*)(p + 4);
  f[0] = a.x; f[1] = a.y; f[2] = a.z; f[3] = a.w; f[4] = b.x; f[5] = b.y; f[6] = b.z; f[7] = b.w;
}
__device__ __forceinline__ void store8f(float* p, const float (&f)[8]) {
  *(float4*)p = make_float4(f[0], f[1], f[2], f[3]); *(float4*)(p + 4) = make_float4(f[4], f[5], f[6], f[7]);
}
__device__ __forceinline__ float siluf(float x) { return x / (1.0f + __expf(-x)); }
__device__ __forceinline__ float sigmoidf_(float x) { return 1.0f / (1.0f + __expf(-x)); }
__device__ __forceinline__ float softplusf_(float x) { return x > 20.0f ? x : log1pf(expf(x)); }
__device__ __forceinline__ float dppf(float x, const int ctrl_sel) {
  int v = __float_as_int(x), r;
  if (ctrl_sel == 0) r = __builtin_amdgcn_update_dpp(0, v, 0xB1, 0xf, 0xf, true);
  else if (ctrl_sel == 1) r = __builtin_amdgcn_update_dpp(0, v, 0x4E, 0xf, 0xf, true);
  else if (ctrl_sel == 2) r = __builtin_amdgcn_update_dpp(0, v, 0x141, 0xf, 0xf, true);
  else r = __builtin_amdgcn_update_dpp(0, v, 0x140, 0xf, 0xf, true);
  return __int_as_float(r);
}
__device__ __forceinline__ float sum8(float x) { x += dppf(x, 0); x += dppf(x, 1); x += dppf(x, 2); return x; }
__device__ __forceinline__ float sum16(float x) { x += dppf(x, 0); x += dppf(x, 1); x += dppf(x, 2); x += dppf(x, 3); return x; }
__device__ __forceinline__ float wave_sum(float x) {
#pragma unroll
  for (int o = 32; o > 0; o >>= 1) x += __shfl_xor(x, o);
  return x;
}
__device__ __forceinline__ void decode_row(int row, int& isp, int& b, int& pos) {
  if (row < NPROMPT) { isp = 1; b = row >> 11; pos = row & 2047; } else { isp = 0; const int r = row - NPROMPT; b = r >> 2; pos = r & 3; }
}

__device__ void phase_wconv(const Params& p, int l, float* tile) {
  const int tid = otid();
  const int T0 = 16 * 68, T1 = T0 + 16 * 16, T2 = T1 + 16 * 88, T3 = T2 + 44 * 16;
  for (int t = obid(); t < T3; t += gridDim.x) {
    const float* src; bf16_t* dst; int K, N, nk, tt;
    if (t < T0) { src = p.in[13] + (size_t)l * 1024 * INC; dst = (bf16_t*)(p.ws + p.w_in); K = 1024; N = INC; nk = 16; tt = t; }
    else if (t < T1) { src = p.in[26] + (size_t)l * 1024 * 1024; dst = (bf16_t*)(p.ws + p.w_out); K = 1024; N = 1024; nk = 16; tt = t - T0; }
    else if (t < T2) { src = p.in[27] + (size_t)l * 1024 * 5632; dst = (bf16_t*)(p.ws + p.w_up); K = 1024; N = 5632; nk = 16; tt = t - T1; }
    else { src = p.in[30] + (size_t)l * DFF * 1024; dst = (bf16_t*)(p.ws + p.w_dn); K = DFF; N = 1024; nk = 44; tt = t - T2; }
    const int k0 = (tt % nk) * 64, n0 = (tt / nk) * 64;
#pragma unroll
    for (int i = 0; i < 8; ++i) { const int kk = (tid >> 6) + 8 * i, nn = tid & 63;
      tile[nn * 65 + kk] = (n0 + nn < N) ? src[(size_t)(k0 + kk) * N + n0 + nn] : 0.0f; }
    __syncthreads();
#pragma unroll
    for (int i = 0; i < 8; ++i) { const int nn = (tid >> 6) + 8 * i, kk = tid & 63;
      const float v = tile[nn * 65 + kk]; unsigned u = __float_as_uint(v); u += 0x7FFFu + ((u >> 16) & 1u);
      dst[(size_t)(n0 + nn) * K + k0 + kk] = (bf16_t)(u >> 16); }
    __syncthreads();
  }
}

__device__ void phase_rowwise(const Params& p, bool first, const bf16_t* add, const float* w_add, const float* w_norm, bf16_t* hn) {
  const int lane = otid() & 63, wv = otid() >> 6;
  for (int row = obid() * 8 + wv; row < NTOK; row += gridDim.x * 8) {
    float* xr = p.out + (size_t)row * DM;
    const float* xi = first ? (row < NPROMPT ? p.in[0] + (size_t)row * DM : p.in[1] + (size_t)(row - NPROMPT) * DM) : xr;
    float x[2][8];
#pragma unroll
    for (int j = 0; j < 2; ++j) load8f(xi + j * 512 + lane * 8, x[j]);
    if (add) {
      float o[2][8]; float ss = 0.f;
#pragma unroll
      for (int j = 0; j < 2; ++j) { unpack8(*(const uint4*)(add + (size_t)row * DM + j * 512 + lane * 8), o[j]);
#pragma unroll
        for (int e = 0; e < 8; ++e) ss += o[j][e] * o[j][e]; }
      ss = wave_sum(ss); const float r = rsqrtf(ss * (1.0f / DM) + EPSF);
#pragma unroll
      for (int j = 0; j < 2; ++j) { float w[8]; load8f(w_add + j * 512 + lane * 8, w);
#pragma unroll
        for (int e = 0; e < 8; ++e) x[j][e] += o[j][e] * r * w[e]; }
    }
    if (first || add) {
#pragma unroll
      for (int j = 0; j < 2; ++j) store8f(xr + j * 512 + lane * 8, x[j]);
    }
    if (w_norm) {
      float ss = 0.f;
#pragma unroll
      for (int j = 0; j < 2; ++j)
#pragma unroll
        for (int e = 0; e < 8; ++e) ss += x[j][e] * x[j][e];
      ss = wave_sum(ss); const float r = rsqrtf(ss * (1.0f / DM) + EPSF);
#pragma unroll
      for (int j = 0; j < 2; ++j) { float w[8], y[8]; load8f(w_norm + j * 512 + lane * 8, w);
#pragma unroll
        for (int e = 0; e < 8; ++e) y[e] = x[j][e] * r * w[e];
        *(uint4*)(hn + (size_t)row * DM + j * 512 + lane * 8) = pack8(y); }
    }
  }
}

__device__ void phase_prep(const Params& p, int l) {
  const bf16_t* projA = (const bf16_t*)(p.ws + p.big);
  const bf16_t* projB = (const bf16_t*)(p.ws + p.big + SZ_PROJA);
  bf16_t* convo = (bf16_t*)(p.ws + p.big + SZ_PROJA + SZ_PROJB);
  float* gates = (float*)(p.ws + p.gates);
  const float* cw = p.in[14] + (size_t)l * 4 * CONVD; const float* cb = p.in[15] + (size_t)l * CONVD;
  const long gtid = (long)obid() * 512 + otid(), gstride = (long)gridDim.x * 512;
  for (long u = gtid; u < (long)NTOK * 288; u += gstride) {
    const int row = (int)(u / 288), v = (int)(u - (long)row * 288), c0 = v * 8;
    int isp, b, pos; decode_row(row, isp, b, pos);
    float xp[4][8];
#pragma unroll
    for (int j = 0; j < 4; ++j) {
      const int pj = pos - 3 + j;
      if (pj >= 0) unpack8(*(const uint4*)(projA + (size_t)(row - 3 + j) * CONVD + c0), xp[j]);
      else if (isp) {
#pragma unroll
        for (int e = 0; e < 8; ++e) xp[j][e] = 0.f;
      } else load8f(p.in[2] + (((size_t)l * 128 + b) * 3 + (pos + j)) * CONVD + c0, xp[j]);
    }
    float y[8]; load8f(cb + c0, y);
#pragma unroll
    for (int j = 0; j < 4; ++j) { float w[8]; load8f(cw + j * CONVD + c0, w);
#pragma unroll
      for (int e = 0; e < 8; ++e) y[e] += w[e] * xp[j][e]; }
#pragma unroll
    for (int e = 0; e < 8; ++e) y[e] = siluf(y[e]);
    if (c0 < 1024) {
      float ss = 0.f;
#pragma unroll
      for (int e = 0; e < 8; ++e) ss += y[e] * y[e];
      ss = sum16(ss);
      const float sc = rsqrtf(ss + EPSF) * (c0 < 512 ? 0.08838834764831845f : 1.0f);
#pragma unroll
      for (int e = 0; e < 8; ++e) y[e] *= sc;
    }
    *(uint4*)(convo + (size_t)row * CONVD + c0) = pack8(y);
    if (isp) { if (pos >= 2045) store8f(p.out + p.o_pconv + (((size_t)l * 8 + b) * 3 + (pos - 2045)) * CONVD + c0, xp[3]); }
    else { if (pos >= 1) store8f(p.out + p.o_sconv + (((size_t)l * 128 + b) * 3 + (pos - 1)) * CONVD + c0, xp[3]); }
  }
  for (long i = gtid; i < (long)NTOK * 4; i += gstride) {
    const int row = (int)(i >> 2), h = (int)(i & 3);
    const bf16_t* pb = projB + (size_t)row * PBLD;
    const float ga = bf2f(pb[O_GA + h]), gb = bf2f(pb[O_GB + h]), mi = bf2f(pb[O_MI + h]), mf = bf2f(pb[O_MF + h]), sdt = bf2f(pb[O_SDT + h]);
    float* g = gates + (size_t)row * 32;
    g[h] = -expf(p.in[16][l * 4 + h]) * softplusf_(ga + p.in[17][l * 4 + h]);
    g[4 + h] = sigmoidf_(gb);
    g[8 + h] = mi + p.in[19][l * 4 + h];
    g[12 + h] = -softplusf_(-(mf + p.in[20][l * 4 + h]));
    const float dt = softplusf_(sdt + p.in[23][l * 4 + h]);
    g[16 + h] = dt;
    g[20 + h] = dt * (-expf(p.in[22][l * 4 + h]));
  }
}

constexpr int TC = 32;

__device__ void gdn_item(const Params& p, float* lds, int row0, int T, int h, int sl, const float* sin, float* sout) {
  const int tid = otid(), cl = tid >> 4, s = tid & 15, col = sl * 32 + cl;
  const bf16_t* convo = (const bf16_t*)(p.ws + p.big + SZ_PROJA + SZ_PROJB);
  const float* gates = (const float*)(p.ws + p.gates);
  bf16_t* raw = (bf16_t*)(p.ws + p.hn);
  constexpr int BUF = 9280;
  float* obuf = lds + 2 * BUF;
  float S[8];
#pragma unroll
  for (int i = 0; i < 8; ++i) S[i] = sin ? sin[(size_t)(8 * s + i) * 128 + col] : 0.f;
  const int nch = (T + TC - 1) / TC;
  uint4 rq, rk, rv; float ra = 0.f, rb = 0.f;
  rq = rk = rv = make_uint4(0, 0, 0, 0);
  auto stage_load = [&](int c) {
    const int tt = tid >> 4, cv = tid & 15, t = c * TC + tt;
    if (t < T) { const bf16_t* r = convo + (size_t)(row0 + t) * CONVD + h * 128 + cv * 8; rq = *(const uint4*)r; rk = *(const uint4*)(r + 512); }
    if (tid < 128) { const int t2 = c * TC + (tid >> 2); if (t2 < T) rv = *(const uint4*)(convo + (size_t)(row0 + t2) * CONVD + 1024 + h * 128 + sl * 32 + (tid & 3) * 8); }
    else if (tid < 160) { const int t3 = c * TC + (tid - 128); if (t3 < T) { const float* g = gates + (size_t)(row0 + t3) * 32; ra = __expf(g[h]); rb = g[4 + h]; } }
  };
  auto stage_store = [&](float* buf) {
    const int tt = tid >> 4, cv = tid & 15;
    float f[8]; unpack8(rq, f); store8f(buf + tt * 128 + cv * 8, f); unpack8(rk, f); store8f(buf + 4096 + tt * 128 + cv * 8, f);
    if (tid < 128) { unpack8(rv, f); store8f(buf + 8192 + (tid >> 2) * 32 + (tid & 3) * 8, f); }
    else if (tid < 160) { buf[9216 + tid - 128] = ra; buf[9248 + tid - 128] = rb; }
  };
  __syncthreads();
  stage_load(0); stage_store(lds); __syncthreads();
  for (int c = 0; c < nch; ++c) {
    const float* buf = lds + (c & 1) * BUF;
    if (c + 1 < nch) stage_load(c + 1);
    const int tcnt = min(TC, T - c * TC);
    for (int t = 0; t < tcnt; ++t) {
      float q[8], k[8]; load8f(buf + t * 128 + 8 * s, q); load8f(buf + 4096 + t * 128 + 8 * s, k);
      const float v = buf[8192 + t * 32 + cl], a = buf[9216 + t], bt = buf[9248 + t];
      float pk = 0.f, pq = 0.f, pqk = 0.f;
#pragma unroll
      for (int i = 0; i < 8; ++i) { pk += k[i] * S[i]; pq += q[i] * S[i]; pqk += q[i] * k[i]; }
      pk = sum16(pk); pq = sum16(pq); pqk = sum16(pqk);
      const float r = bt * (v - a * pk);
      const float o = a * pq + pqk * r;
#pragma unroll
      for (int i = 0; i < 8; ++i) S[i] = a * S[i] + k[i] * r;
      if (s == 0) obuf[t * 32 + cl] = o;
    }
    __syncthreads();
    {
      const int tt = tid >> 4, cp = (tid & 15) * 2;
      if (tt < tcnt) { const unsigned w = pg8::cvt_pk_bf16(obuf[tt * 32 + cp], obuf[tt * 32 + cp + 1]);
        *(unsigned*)(raw + (size_t)(row0 + c * TC + tt) * DM + h * 128 + sl * 32 + cp) = w; }
    }
    if (c + 1 < nch) stage_store(lds + ((c + 1) & 1) * BUF);
    __syncthreads();
  }
#pragma unroll
  for (int i = 0; i < 8; ++i) sout[(size_t)(8 * s + i) * 128 + col] = S[i];
}

__device__ void mlstm_item(const Params& p, float* lds, int row0, int T, int h, const float* cin, const float* nin, const float* min_, float* cout, float* nout, float* mout) {
  const int tid = otid(), col = tid >> 3, s = tid & 7;
  const bf16_t* projB = (const bf16_t*)(p.ws + p.big + SZ_PROJA);
  const float* gates = (const float*)(p.ws + p.gates);
  bf16_t* raw = (bf16_t*)(p.ws + p.hn);
  constexpr int BUF = 6208;
  float* obuf = lds + 2 * BUF;
  float C[8], n[8]; float m = min_ ? min_[0] : 0.f;
#pragma unroll
  for (int i = 0; i < 8; ++i) { C[i] = cin ? cin[(size_t)(8 * s + i) * 64 + col] : 0.f; n[i] = nin ? nin[8 * s + i] : 0.f; }
  const int nch = (T + TC - 1) / TC;
  uint4 r0, r1; float rli = 0.f, rlf = 0.f; r0 = r1 = make_uint4(0, 0, 0, 0);
  auto stage_load = [&](int c) {
    const int u = tid & 255, tt = u >> 3, cv = u & 7, t = c * TC + tt;
    if (t < T) { const bf16_t* r = projB + (size_t)(row0 + t) * PBLD + h * 64 + cv * 8;
      if (tid < 256) { r0 = *(const uint4*)(r + O_MQ); r1 = *(const uint4*)(r + O_MV); } else { r0 = *(const uint4*)(r + O_MK); } }
    if (tid >= 256 && tid < 288) { const int t3 = c * TC + (tid - 256); if (t3 < T) { const float* g = gates + (size_t)(row0 + t3) * 32; rli = g[8 + h]; rlf = g[12 + h]; } }
  };
  auto stage_store = [&](float* buf) {
    const int u = tid & 255, tt = u >> 3, cv = u & 7; float f[8];
    if (tid < 256) { unpack8(r0, f); store8f(buf + tt * 64 + cv * 8, f); unpack8(r1, f); store8f(buf + 4096 + tt * 64 + cv * 8, f); }
    else { unpack8(r0, f);
#pragma unroll
      for (int e = 0; e < 8; ++e) f[e] *= 0.125f;
      store8f(buf + 2048 + tt * 64 + cv * 8, f);
      if (tid < 288) { buf[6144 + tid - 256] = rli; buf[6176 + tid - 256] = rlf; } }
  };
  __syncthreads();
  stage_load(0); stage_store(lds); __syncthreads();
  for (int c = 0; c < nch; ++c) {
    const float* buf = lds + (c & 1) * BUF;
    if (c + 1 < nch) stage_load(c + 1);
    const int tcnt = min(TC, T - c * TC);
    for (int t = 0; t < tcnt; ++t) {
      float q[8], k[8]; load8f(buf + t * 64 + 8 * s, q); load8f(buf + 2048 + t * 64 + 8 * s, k);
      const float v = buf[4096 + t * 64 + col], li = buf[6144 + t], lf = buf[6176 + t];
      const float mn = fmaxf(lf + m, li), fp = __expf(lf + m - mn), ip = __expf(li - mn);
      float pc = 0.f, pn = 0.f, pqk = 0.f;
#pragma unroll
      for (int i = 0; i < 8; ++i) { pc += q[i] * C[i]; pn += q[i] * n[i]; pqk += q[i] * k[i]; }
      pc = sum8(pc); pn = sum8(pn); pqk = sum8(pqk);
      const float num = fp * pc + ip * pqk * v;
      float den = fp * pn + ip * pqk; den = fmaxf(fabsf(den), __expf(-mn));
      const float iv = ip * v;
#pragma unroll
      for (int i = 0; i < 8; ++i) { C[i] = fp * C[i] + iv * k[i]; n[i] = fp * n[i] + ip * k[i]; }
      m = mn;
      if (s == 0) obuf[t * 64 + col] = num / den;
    }
    __syncthreads();
    { const int tt = tid >> 4, cp = (tid & 15) * 4;
      if (tt < tcnt) { uint2 w; w.x = pg8::cvt_pk_bf16(obuf[tt * 64 + cp], obuf[tt * 64 + cp + 1]); w.y = pg8::cvt_pk_bf16(obuf[tt * 64 + cp + 2], obuf[tt * 64 + cp + 3]);
        *(uint2*)(raw + (size_t)(row0 + c * TC + tt) * DM + 512 + h * 64 + cp) = w; } }
    if (c + 1 < nch) stage_store(lds + ((c + 1) & 1) * BUF);
    __syncthreads();
  }
#pragma unroll
  for (int i = 0; i < 8; ++i) { cout[(size_t)(8 * s + i) * 64 + col] = C[i]; if (col == 0) nout[8 * s + i] = n[i]; }
  if (tid == 0) mout[0] = m;
}

__device__ void ssd_item(const Params& p, float* lds, int row0, int T, int h, const float* hin, float* hout) {
  const int tid = otid(), pp = tid >> 3, s = tid & 7, grp = h >> 1;
  const bf16_t* convo = (const bf16_t*)(p.ws + p.big + SZ_PROJA + SZ_PROJB);
  const float* gates = (const float*)(p.ws + p.gates);
  bf16_t* raw = (bf16_t*)(p.ws + p.hn);
  constexpr int BUF = 10304;
  float* obuf = lds + 2 * BUF;
  float H[16];
#pragma unroll
  for (int i = 0; i < 16; ++i) H[i] = hin ? hin[(size_t)pp * 128 + 16 * s + i] : 0.f;
  const int nch = (T + TC - 1) / TC;
  uint4 rB, rC, rx; float rdt = 0.f, rda = 0.f; rB = rC = rx = make_uint4(0, 0, 0, 0);
  auto stage_load = [&](int c) {
    const int tt = tid >> 4, cv = tid & 15, t = c * TC + tt;
    if (t < T) { const bf16_t* r = convo + (size_t)(row0 + t) * CONVD + grp * 128 + cv * 8; rB = *(const uint4*)(r + 1792); rC = *(const uint4*)(r + 2048); }
    if (tid < 256) { const int t2 = c * TC + (tid >> 3); if (t2 < T) rx = *(const uint4*)(convo + (size_t)(row0 + t2) * CONVD + 1536 + h * 64 + (tid & 7) * 8); }
    else if (tid < 288) { const int t3 = c * TC + (tid - 256); if (t3 < T) { const float* g = gates + (size_t)(row0 + t3) * 32; rdt = g[16 + h]; rda = __expf(g[20 + h]); } }
  };
  auto stage_store = [&](float* buf) {
    const int tt = tid >> 4, cv = tid & 15; float f[8];
    unpack8(rB, f); store8f(buf + 2048 + tt * 128 + cv * 8, f); unpack8(rC, f); store8f(buf + 6144 + tt * 128 + cv * 8, f);
    if (tid < 256) { unpack8(rx, f); store8f(buf + (tid >> 3) * 64 + (tid & 7) * 8, f); }
    else if (tid < 288) { buf[10240 + tid - 256] = rdt; buf[10272 + tid - 256] = rda; }
  };
  __syncthreads();
  stage_load(0); stage_store(lds); __syncthreads();
  for (int c = 0; c < nch; ++c) {
    const float* buf = lds + (c & 1) * BUF;
    if (c + 1 < nch) stage_load(c + 1);
    const int tcnt = min(TC, T - c * TC);
    for (int t = 0; t < tcnt; ++t) {
      float Bn[16], Cn[16];
      load8f(buf + 2048 + t * 128 + 16 * s, *(float(*)[8])&Bn[0]); load8f(buf + 2048 + t * 128 + 16 * s + 8, *(float(*)[8])&Bn[8]);
      load8f(buf + 6144 + t * 128 + 16 * s, *(float(*)[8])&Cn[0]); load8f(buf + 6144 + t * 128 + 16 * s + 8, *(float(*)[8])&Cn[8]);
      const float x = buf[t * 64 + pp], dt = buf[10240 + t], dA = buf[10272 + t];
      float pc = 0.f, pbc = 0.f;
#pragma unroll
      for (int i = 0; i < 16; ++i) { pc += Cn[i] * H[i]; pbc += Bn[i] * Cn[i]; }
      pc = sum8(pc); pbc = sum8(pbc);
      const float dtx = dt * x;
#pragma unroll
      for (int i = 0; i < 16; ++i) H[i] = dA * H[i] + dtx * Bn[i];
      if (s == 0) obuf[t * 64 + pp] = dA * pc + dtx * pbc;
    }
    __syncthreads();
    { const int tt = tid >> 4, cp = (tid & 15) * 4;
      if (tt < tcnt) { uint2 w; w.x = pg8::cvt_pk_bf16(obuf[tt * 64 + cp], obuf[tt * 64 + cp + 1]); w.y = pg8::cvt_pk_bf16(obuf[tt * 64 + cp + 2], obuf[tt * 64 + cp + 3]);
        *(uint2*)(raw + (size_t)(row0 + c * TC + tt) * DM + 768 + h * 64 + cp) = w; } }
    if (c + 1 < nch) stage_store(lds + ((c + 1) & 1) * BUF);
    __syncthreads();
  }
#pragma unroll
  for (int i = 0; i < 16; ++i) hout[(size_t)pp * 128 + 16 * s + i] = H[i];
}

__device__ void phase_mixers(const Params& p, int l, float* lds) {
  for (int it = obid(); it < 192; it += gridDim.x) {
    if (it < 128) { const int b = it >> 4, h = (it >> 2) & 3, sl = it & 3;
      gdn_item(p, lds, b * 2048, 2048, h, sl, nullptr, p.out + p.o_pgdn + (((size_t)l * 8 + b) * 4 + h) * 16384); }
    else if (it < 160) { const int i = it - 128, b = i >> 2, h = i & 3; const size_t bh = ((size_t)l * 8 + b) * 4 + h;
      mlstm_item(p, lds, b * 2048, 2048, h, nullptr, nullptr, nullptr, p.out + p.o_pmc + bh * 4096, p.out + p.o_pmn + bh * 64, p.out + p.o_pmm + bh); }
    else { const int i = it - 160, b = i >> 2, h = i & 3; const size_t bh = ((size_t)l * 8 + b) * 4 + h;
      ssd_item(p, lds, b * 2048, 2048, h, nullptr, p.out + p.o_pssd + bh * 8192); }
  }
  unsigned* ctr = (unsigned*)(p.ws + p.ctr) + l;
  int* slot = (int*)(lds + 32000);
  for (;;) {
    __syncthreads();
    if (otid() == 0) *slot = (int)atomicAdd(ctr, 1u);
    __syncthreads();
    const int it = *slot;
    if (it >= 3072) break;
    if (it < 2048) { const int b = it >> 4, h = (it >> 2) & 3, sl = it & 3; const size_t bh = ((size_t)l * 128 + b) * 4 + h;
      gdn_item(p, lds, NPROMPT + b * 4, 4, h, sl, p.in[3] + bh * 16384, p.out + p.o_sgdn + bh * 16384); }
    else if (it < 2560) { const int i = it - 2048, b = i >> 2, h = i & 3; const size_t bh = ((size_t)l * 128 + b) * 4 + h;
      mlstm_item(p, lds, NPROMPT + b * 4, 4, h, p.in[4] + bh * 4096, p.in[5] + bh * 64, p.in[6] + bh, p.out + p.o_smc + bh * 4096, p.out + p.o_smn + bh * 64, p.out + p.o_smm + bh); }
    else { const int i = it - 2560, b = i >> 2, h = i & 3; const size_t bh = ((size_t)l * 128 + b) * 4 + h;
      ssd_item(p, lds, NPROMPT + b * 4, 4, h, p.in[7] + bh * 8192, p.out + p.o_sssd + bh * 8192); }
  }
}

__device__ void phase_mixout(const Params& p, int l) {
  const bf16_t* projB = (const bf16_t*)(p.ws + p.big + SZ_PROJA);
  const bf16_t* convo = (const bf16_t*)(p.ws + p.big + SZ_PROJA + SZ_PROJB);
  const bf16_t* raw = (const bf16_t*)(p.ws + p.hn);
  bf16_t* mix = (bf16_t*)(p.ws + p.big);
  const int lane = otid() & 63, wv = otid() >> 6;
  for (int row = obid() * 8 + wv; row < NTOK; row += gridDim.x * 8) {
    const int c0 = lane * 16;
    float v[2][8];
    unpack8(*(const uint4*)(raw + (size_t)row * DM + c0), v[0]); unpack8(*(const uint4*)(raw + (size_t)row * DM + c0 + 8), v[1]);
    const bf16_t* pb = projB + (size_t)row * PBLD;
    float ss = 0.f;
    if (lane < 32) {
#pragma unroll
      for (int j = 0; j < 2; ++j)
#pragma unroll
        for (int e = 0; e < 8; ++e) ss += v[j][e] * v[j][e];
    } else if (lane < 48) {
      const int cm = c0 - 512;
#pragma unroll
      for (int j = 0; j < 2; ++j) { float g[8]; unpack8(*(const uint4*)(pb + O_MO + cm + j * 8), g);
#pragma unroll
        for (int e = 0; e < 8; ++e) { v[j][e] *= sigmoidf_(g[e]); ss += v[j][e] * v[j][e]; } }
    } else {
      const int cs = c0 - 768; const float dd = p.in[24][l * 4 + (cs >> 6)];
#pragma unroll
      for (int j = 0; j < 2; ++j) { float x[8], z[8]; unpack8(*(const uint4*)(convo + (size_t)row * CONVD + 1536 + cs + j * 8), x); unpack8(*(const uint4*)(pb + O_SZ + cs + j * 8), z);
#pragma unroll
        for (int e = 0; e < 8; ++e) { v[j][e] = (v[j][e] + dd * x[e]) * siluf(z[e]); ss += v[j][e] * v[j][e]; } }
    }
    const float s2 = ss + __shfl_xor(ss, 1), s4 = s2 + __shfl_xor(s2, 2), s8 = s4 + __shfl_xor(s4, 4), s16 = s8 + __shfl_xor(s8, 8);
    float y[2][8];
    if (lane < 32) {
      const float r = rsqrtf(s8 * (1.0f / 128.0f) + EPSF);
#pragma unroll
      for (int j = 0; j < 2; ++j) { float g[8], w[8]; unpack8(*(const uint4*)(pb + O_GG + c0 + j * 8), g); load8f(p.in[18] + l * 128 + (c0 & 127) + j * 8, w);
#pragma unroll
        for (int e = 0; e < 8; ++e) y[j][e] = v[j][e] * r * w[e] * siluf(g[e]); }
    } else if (lane < 48) {
      const float r = rsqrtf(s4 * (1.0f / 64.0f) + EPSF);
#pragma unroll
      for (int j = 0; j < 2; ++j) { float w[8]; load8f(p.in[21] + l * 64 + (c0 & 63) + j * 8, w);
#pragma unroll
        for (int e = 0; e < 8; ++e) y[j][e] = v[j][e] * r * w[e]; }
    } else {
      const float r = rsqrtf(s16 * (1.0f / 256.0f) + EPSF);
#pragma unroll
      for (int j = 0; j < 2; ++j) { float w[8]; load8f(p.in[25] + l * 256 + (c0 - 768) + j * 8, w);
#pragma unroll
        for (int e = 0; e < 8; ++e) y[j][e] = v[j][e] * r * w[e]; }
    }
    *(uint4*)(mix + (size_t)row * DM + c0) = pack8(y[0]); *(uint4*)(mix + (size_t)row * DM + c0 + 8) = pack8(y[1]);
  }
}

__device__ void phase_act(const Params& p, int l) {
  const bf16_t* G = (const bf16_t*)(p.ws + p.big);
  bf16_t* V = (bf16_t*)(p.ws + p.big + SZ_GV);
  const float* cw = p.in[28] + (size_t)l * 3 * DFF; const float* cb = p.in[29] + (size_t)l * DFF;
  const long gtid = (long)obid() * 512 + otid(), gstride = (long)gridDim.x * 512;
  for (long u = gtid; u < (long)NTOK * 352; u += gstride) {
    const int row = (int)(u / 352), c0 = (int)(u - (long)row * 352) * 8;
    int isp, b, pos; decode_row(row, isp, b, pos);
    float g[3][8];
#pragma unroll
    for (int j = 0; j < 3; ++j) {
      const int pj = pos - 2 + j;
      if (pj >= 0) unpack8(*(const uint4*)(G + (size_t)(row - 2 + j) * DFF + c0), g[j]);
      else if (isp) {
#pragma unroll
        for (int e = 0; e < 8; ++e) g[j][e] = 0.f;
      } else load8f(p.in[8] + (((size_t)l * 128 + b) * 2 + (pos + j)) * DFF + c0, g[j]);
    }
    float y[8], val[8]; load8f(cb + c0, y);
#pragma unroll
    for (int j = 0; j < 3; ++j) { float w[8]; load8f(cw + j * DFF + c0, w);
#pragma unroll
      for (int e = 0; e < 8; ++e) y[e] += w[e] * g[j][e]; }
    unpack8(*(const uint4*)(V + (size_t)row * DFF + c0), val);
#pragma unroll
    for (int e = 0; e < 8; ++e) { const float t = y[e], uu = 0.7978845608028654f * (t + 0.044715f * t * t * t);
      const float th = 1.0f - 2.0f / (1.0f + __expf(2.0f * uu)); y[e] = 0.5f * t * (1.0f + th) * val[e]; }
    *(uint4*)(V + (size_t)row * DFF + c0) = pack8(y);
    if (isp) { if (pos >= 2046) store8f(p.out + p.o_pffn + (((size_t)l * 8 + b) * 2 + (pos - 2046)) * DFF + c0, g[2]); }
    else { if (pos >= 2) store8f(p.out + p.o_sffn + (((size_t)l * 128 + b) * 2 + (pos - 2)) * DFF + c0, g[2]); }
  }
}

template <class T> __device__ __forceinline__ T* uni(T* q) {
  const unsigned long long v = (unsigned long long)q;
  const unsigned lo = __builtin_amdgcn_readfirstlane((unsigned)v), hi = __builtin_amdgcn_readfirstlane((unsigned)(v >> 32));
  return (T*)(((unsigned long long)hi << 32) | lo);
}
__global__ void __launch_bounds__(512, 2) mk_forward(Params pk) {
  extern __shared__ __attribute__((aligned(16))) unsigned char shm[];
  cg::grid_group grid = cg::this_grid();
  float* ldsf = (float*)shm;
  Params* lp = (Params*)(shm + 131072);
  if (otid() == 0) *lp = pk;
  __syncthreads();
  const Params& p = *lp;
  if (obid() == 0 && otid() < 8) ((unsigned*)(p.ws + p.ctr))[otid()] = 0u;
  phase_wconv(p, 0, ldsf);
  phase_rowwise(p, true, nullptr, nullptr, p.in[9], (bf16_t*)(p.ws + p.hn));
  grid.sync();
#pragma unroll 1
  for (int step = 0; step < 20; ++step) {
    const int l = step / 10, s = step - l * 10;
    if (s == 0 || s == 4 || s == 6 || s == 8) {
      pg8::Gemm g; pg8::EpiSplit e;
      bf16_t* big = (bf16_t*)(p.ws + p.big);
      if (s == 0) { g.A = (const bf16_t*)(p.ws + p.hn); g.Bt = (const bf16_t*)(p.ws + p.w_in); g.M = NTOK; g.N = INCP; g.K = 1024;
        e.O1 = big; e.ld1 = CONVD; e.nt1 = 9; e.O2 = (bf16_t*)(p.ws + p.big + SZ_PROJA); e.ld2 = PBLD; }
      else if (s == 4) { g.A = big; g.Bt = (const bf16_t*)(p.ws + p.w_out); g.M = NTOK; g.N = 1024; g.K = 1024;
        e.O1 = (bf16_t*)(p.ws + p.big + SZ_PROJA + SZ_PROJB); e.ld1 = DM; e.nt1 = 1000; e.O2 = e.O1; e.ld2 = DM; }
      else if (s == 6) { g.A = (const bf16_t*)(p.ws + p.hn); g.Bt = (const bf16_t*)(p.ws + p.w_up); g.M = NTOK; g.N = 5632; g.K = 1024;
        e.O1 = big; e.ld1 = DFF; e.nt1 = 11; e.O2 = (bf16_t*)(p.ws + p.big + SZ_GV); e.ld2 = DFF; }
      else { g.A = (const bf16_t*)(p.ws + p.big + SZ_GV); g.Bt = (const bf16_t*)(p.ws + p.w_dn); g.M = NTOK; g.N = 1024; g.K = DFF;
        e.O1 = (bf16_t*)(p.ws + p.hn); e.ld1 = DM; e.nt1 = 1000; e.O2 = e.O1; e.ld2 = DM; }
      g.A = uni(g.A); g.Bt = uni(g.Bt); e.O1 = uni(e.O1); e.O2 = uni(e.O2);
      pg8::StaticOrder S; S.init(g.M, g.N, (int)gridDim.x, (int)obid());
      pg8::gemm_phase<pg8::EpiSplit, pg8::StaticOrder, false>((PG8_LAS unsigned char*)shm, g, S, e, nullptr);
    } else if (s == 1) phase_prep(p, l);
    else if (s == 2) phase_mixers(p, l, ldsf);
    else if (s == 3) phase_mixout(p, l);
    else if (s == 5) phase_rowwise(p, false, (const bf16_t*)(p.ws + p.big + SZ_PROJA + SZ_PROJB), p.in[10] + l * DM, p.in[11] + l * DM, (bf16_t*)(p.ws + p.hn));
    else if (s == 7) phase_act(p, l);
    else {
      phase_rowwise(p, false, (const bf16_t*)(p.ws + p.hn), p.in[12] + l * DM, l == 0 ? p.in[9] + DM : nullptr, (bf16_t*)(p.ws + p.hn));
      if (l == 0) phase_wconv(p, 1, ldsf);
    }
    if (step < 19) grid.sync();
  }
}

extern "C" void kernel_launch(void* const* d_in, const int* in_sizes, int n_in, void* d_out, int out_size, void* d_ws, size_t ws_size, hipStream_t stream) {
  constexpr size_t kDynLds = 131072 + 1024;
  static int grid_blocks = 0;
  if (!grid_blocks) {
    int dev = 0, cus = 0, per_cu = 0;
    (void)hipGetDevice(&dev);
    (void)hipDeviceGetAttribute(&cus, hipDeviceAttributeMultiprocessorCount, dev);
    (void)hipFuncSetAttribute((const void*)mk_forward, hipFuncAttributeMaxDynamicSharedMemorySize, (int)kDynLds);
    (void)hipOccupancyMaxActiveBlocksPerMultiprocessor(&per_cu, mk_forward, 512, kDynLds);
    if (per_cu < 1) per_cu = 1;
    grid_blocks = cus * 1;
  }
  Params p{};
  for (int i = 0; i < 31; ++i) p.in[i] = (const float*)d_in[i];
  p.out = (float*)d_out; p.ws = (unsigned char*)d_ws;
  long o = 0;
  o += 16777216L; p.o_ys = o; o += 524288L;
  p.o_pconv = o; o += 2L * 8 * 3 * 2304; p.o_pgdn = o; o += 2L * 8 * 4 * 16384; p.o_pmc = o; o += 2L * 8 * 4 * 4096; p.o_pmn = o; o += 2L * 8 * 4 * 64;
  p.o_pmm = o; o += 2L * 8 * 4; p.o_pssd = o; o += 2L * 8 * 4 * 8192; p.o_pffn = o; o += 2L * 8 * 2 * 2816;
  p.o_sconv = o; o += 2L * 128 * 3 * 2304; p.o_sgdn = o; o += 2L * 128 * 4 * 16384; p.o_smc = o; o += 2L * 128 * 4 * 4096; p.o_smn = o; o += 2L * 128 * 4 * 64;
  p.o_smm = o; o += 2L * 128 * 4; p.o_sssd = o; o += 2L * 128 * 4 * 8192; p.o_sffn = o; o += 2L * 128 * 2 * 2816;
  size_t w = 0;
  p.w_in = w; w += (size_t)INCP * 1024 * 2; p.w_out = w; w += (size_t)1024 * 1024 * 2; p.w_up = w; w += (size_t)5632 * 1024 * 2; p.w_dn = w; w += (size_t)1024 * DFF * 2;
  p.hn = w; w += (size_t)NTOK * DM * 2; p.gates = w; w += (size_t)NTOK * 32 * 4; p.ctr = w; w += 256; p.big = w; w += SZ_PROJA + SZ_PROJB + SZ_PROJA;
  if (w > ws_size || o != (long)out_size) { fprintf(stderr, "workspace/out size mismatch: need %zu have %zu, out %ld vs %d\n", w, ws_size, o, out_size); return; }
  void* args[] = {&p};
  hipError_t e = hipLaunchCooperativeKernel((void*)mk_forward, dim3(grid_blocks), dim3(512), args, kDynLds, stream);
  if (e != hipSuccess) fprintf(stderr, "cooperative launch failed: %s (grid %d)\n", hipGetErrorString(e), grid_blocks);
}
```

```cpp
#include <hip/hip_runtime.h>
#include <hip/hip_cooperative_groups.h>
#include <cstdio>
namespace cg = cooperative_groups;
namespace pg8 {
#define PG8_LAS __attribute__((address_space(3)))
}
__device__ __forceinline__ int otid() { int t = threadIdx.x; asm volatile("" : "+v"(t)); return t; }
__device__ __forceinline__ int obid() { int b = blockIdx.x; asm volatile("" : "+s"(b)); return b; }
namespace pg8 {
typedef unsigned short bf16_t;
typedef short bf16x8 __attribute__((ext_vector_type(8)));
typedef float f32x4 __attribute__((ext_vector_type(4)));
typedef unsigned u32x4 __attribute__((ext_vector_type(4)));
constexpr int BM = 256, BK = 64, HALF = 128, HTB = HALF * BK * 2  , STAGE_BYTES = 8 * HTB, NXCD = 8, WGM = 8;

__host__ __device__ __forceinline__ int lds_byte(int r, int c) { const int st = (r >> 4) * 2 + (c >> 5), rr = r & 15, cc = c & 31, ob = rr * 64 + cc * 2; return st * 1024 + (ob ^ (((ob >> 9) & 1) << 5)); }
__host__ __device__ __forceinline__ void stage_rc(int b, int& R, int& C) { const int st = b / 1024, sb = b % 1024, swz = sb ^ (((sb >> 9) & 1) << 5); R = (st >> 1) * 16 + swz / 64; C = (st & 1) * 32 + (swz % 64) / 2; }
__host__ __device__ __forceinline__ int perm32(int rho) { const int n = rho >> 4, i = rho & 15; return 8 * (i >> 2) + 4 * n + (i & 3); }
struct Unit { int pm, pn, koff; };
struct Gemm { const bf16_t* A; const bf16_t* Bt; int M, N, K, ld; };

struct StaticOrder {
    int nM, nN, nwg, G, c;
    __host__ __device__ void init(int M, int N, int G_, int c_) { nM = M / BM; nN = N / BM; nwg = nM * nN; G = G_; c = c_; }
    __host__ __device__ bool next(int i, Unit& u) const {
        const long L = (long)i * G + c; if (L >= nwg) return false;
        int wgid = (int)L; { const int q = nwg / NXCD, r = nwg % NXCD, xcd = wgid % NXCD, off = wgid / NXCD; wgid = (xcd < r ? xcd * (q + 1) : r * (q + 1) + (xcd - r) * q) + off; }
        const int nig = WGM * nN, gid = wgid / nig, fm = gid * WGM, gsz = (nM - fm) < WGM ? (nM - fm) : WGM;
        u.pm = fm + ((wgid % nig) % gsz); u.pn = (wgid % nig) / gsz; u.koff = 0; return true;
    }
    __device__ __forceinline__ void a_ready(const Unit&) const {}
    __device__ __forceinline__ void done(const Unit&) const {}
};
__device__ __forceinline__ unsigned cvt_pk_bf16(float lo, float hi) { unsigned r; asm volatile("v_cvt_pk_bf16_f32 %0, %1, %2" : "=v"(r) : "v"(lo), "v"(hi)); return r; }
struct SliceOrder {
    int nN, nsl, total, G, c;
    __host__ __device__ void init(int M, int N, int Kfull, int G_, int c_) { nN = N / BM; nsl = Kfull / 256; total = (M / BM) * nN * nsl; G = G_; c = c_; }
    __host__ __device__ bool next(int i, Unit& u) const { const int L = i * G + c; if (L >= total) return false; const int t = L / nsl; u.pm = t / nN; u.pn = t - u.pm * nN; u.koff = (L - t * nsl) * 256; return true; }
    __device__ __forceinline__ void a_ready(const Unit&) const {}
    __device__ __forceinline__ void done(const Unit&) const {}
};
struct MkOrder {
    StaticOrder st; SliceOrder sl; int mode;
    __host__ __device__ bool next(int i, Unit& u) const { return mode ? sl.next(i, u) : st.next(i, u); }
    __device__ __forceinline__ void a_ready(const Unit&) const {}
    __device__ __forceinline__ void done(const Unit&) const {}
};
struct EpiSplit {
    static constexpr bool PERM = true, AFTER_DRAIN = false;
    bf16_t* O1; int ld1; int nt1; bf16_t* O2; int ld2; float* F;
    __device__ __forceinline__ void operator()(const f32x4 (&acc)[2][2][4][2], const Unit& u, int wr, int wc, int fr, int fq) const {
        if (F) {
            const int row0 = u.pm * BM + wr * 64 + fr; const int col0 = u.pn * BM + wc * 32 + 8 * fq;
            float* slab = F + (size_t)(u.koff >> 8) * (512 * 1024);
#pragma unroll
            for (int ai = 0; ai < 2; ++ai)
#pragma unroll
                for (int m = 0; m < 4; ++m) { float* rowp = slab + (size_t)(row0 + ai * HALF + m * 16) * 1024 + col0;
#pragma unroll
                    for (int bj = 0; bj < 2; ++bj)
#pragma unroll
                        for (int n = 0; n < 2; ++n) *(f32x4*)(rowp + bj * HALF + 4 * n) = acc[ai][bj][m][n]; }
            return;
        }
        bf16_t* base; int colt, ld;
        if (u.pn < nt1) { base = O1; colt = u.pn * BM; ld = ld1; } else { base = O2; colt = (u.pn - nt1) * BM; ld = ld2; }
        const int row0 = u.pm * BM + wr * 64 + fr; const int col0 = colt + wc * 32 + 8 * fq;
#pragma unroll
        for (int ai = 0; ai < 2; ++ai)
#pragma unroll
            for (int m = 0; m < 4; ++m) { bf16_t* rowp = base + (size_t)(row0 + ai * HALF + m * 16) * ld + col0;
#pragma unroll
                for (int bj = 0; bj < 2; ++bj) { const f32x4 v0 = acc[ai][bj][m][0], v1 = acc[ai][bj][m][1];
                    u32x4 w; w.x = cvt_pk_bf16(v0[0], v0[1]); w.y = cvt_pk_bf16(v0[2], v0[3]); w.z = cvt_pk_bf16(v1[0], v1[1]); w.w = cvt_pk_bf16(v1[2], v1[3]);
                    *(u32x4*)(rowp + bj * HALF) = w; } }
    }
};
template <class Epi, class Sched, bool STAMP = false>
__device__ __forceinline__ void gemm_phase(PG8_LAS unsigned char* lds, const Gemm g, const Sched& S, const Epi& E, unsigned long long* stamps) {
    const int tid = otid(), wid = __builtin_amdgcn_readfirstlane(tid >> 6), lane = tid & 63, wr = wid >> 2, wc = wid & 3, fr = lane & 15, fq = lane >> 4;
    const int K = g.ld, nt = g.K / BK;
    int ts_lo = 0, ts_hi = 0, nts = 0; const unsigned long long rt_entry = STAMP ? (unsigned long long)wall_clock64() : 0ull;
#define PG8_STAMP() do { if (STAMP && wid == 0 && nts < 64) { const unsigned long long _c = (unsigned long long)clock64(); \
        ts_lo = (lane == nts) ? (int)(unsigned)_c : ts_lo; ts_hi = (lane == nts) ? (int)(unsigned)(_c >> 32) : ts_hi; ++nts; } } while (0)
    PG8_STAMP();
    unsigned voffA[2], voffB[2];
#pragma unroll
    for (int i = 0; i < 2; ++i) { int R, C; stage_rc(tid * 16 + i * 8192, R, C); const int Rb = Epi::PERM ? ((R & ~31) + perm32(R & 31)) : R;
        voffA[i] = (unsigned)(R * K + C) * 2u; voffB[i] = (unsigned)(Rb * K + C) * 2u; }
    const size_t kstep = (size_t)(BK * 2);
    const size_t hstep = (size_t)HALF * K * 2;
    const size_t tstep = 2 * hstep;
    const unsigned ldsw = (unsigned)wid * 1024u;
    const int aoff = lds_byte(wr * 64 + fr, fq * 8), boff = lds_byte(wc * 32 + fr, fq * 8);
#define PG8_SA(b, h) (((b) * 2 + (h)) * HTB)
#define PG8_SB(b, h) ((4 + (b) * 2 + (h)) * HTB)
#define PG8_STAGE(bufoff, gbase, voff) do { _Pragma("unroll") for (int _i = 0; _i < 2; ++_i) \
        __builtin_amdgcn_global_load_lds((const unsigned*)((const char*)(gbase) + (voff)[_i]), (PG8_LAS unsigned*)(lds + (bufoff) + ldsw + _i * 8192), 16, 0, 0); } while (0)
#define PG8_LDA(dst, b, h) do { _Pragma("unroll") for (int m = 0; m < 4; ++m) _Pragma("unroll") for (int k = 0; k < 2; ++k) dst[m][k] = *(const PG8_LAS bf16x8*)(lds + PG8_SA(b, h) + aoff + m * 2048 + k * 1024); } while (0)
#define PG8_LDB(dst, b, h) do { _Pragma("unroll") for (int n = 0; n < 2; ++n) _Pragma("unroll") for (int k = 0; k < 2; ++k) dst[n][k] = *(const PG8_LAS bf16x8*)(lds + PG8_SB(b, h) + boff + n * 2048 + k * 1024); } while (0)
#define PG8_MMA(ai, bj, At, Bt) do { __builtin_amdgcn_s_setprio(1); _Pragma("unroll") for (int m = 0; m < 4; ++m) _Pragma("unroll") for (int n = 0; n < 2; ++n) _Pragma("unroll") for (int k = 0; k < 2; ++k) \
        acc[ai][bj][m][n] = __builtin_amdgcn_mfma_f32_16x16x32_bf16(Bt[n][k], At[m][k], acc[ai][bj][m][n], 0, 0, 0); __builtin_amdgcn_s_setprio(0); } while (0)
#define PG8_WAIT_V(n) asm volatile("s_waitcnt vmcnt(" #n ")" ::: "memory")
#define PG8_WAIT_L(n) asm volatile("s_waitcnt lgkmcnt(" #n ")" ::: "memory")
#define PG8_BAR __builtin_amdgcn_s_barrier()
#define PG8_SCHED __builtin_amdgcn_sched_barrier(0)
    Unit cur, nxt; int ui = 0;
    if (!S.next(0, cur)) return;
    f32x4 acc[2][2][4][2];
#pragma unroll
    for (int a = 0; a < 2; ++a)
#pragma unroll
        for (int b = 0; b < 2; ++b)
#pragma unroll
            for (int m = 0; m < 4; ++m)
#pragma unroll
                for (int n = 0; n < 2; ++n) acc[a][b][m][n] = (f32x4){0.f, 0.f, 0.f, 0.f};
    bf16x8 At[4][2], B0[2][2], B1[2][2];
    const char* cA = (const char*)g.A + (size_t)cur.pm * tstep + (size_t)cur.koff * 2; const char* cB = (const char*)g.Bt + (size_t)cur.pn * tstep + (size_t)cur.koff * 2;
    S.a_ready(cur);
    PG8_STAGE(PG8_SB(0, 0), cB, voffB); PG8_STAGE(PG8_SA(0, 0), cA, voffA); PG8_STAGE(PG8_SB(0, 1), cB + hstep, voffB); PG8_STAGE(PG8_SA(0, 1), cA + hstep, voffA);
    if (wr == 1) PG8_BAR;
    PG8_WAIT_V(4); PG8_BAR;
    PG8_STAGE(PG8_SB(1, 0), cB + kstep, voffB); PG8_STAGE(PG8_SA(1, 0), cA + kstep, voffA); PG8_STAGE(PG8_SB(1, 1), cB + hstep + kstep, voffB);
    PG8_WAIT_V(6); PG8_BAR;
    PG8_STAMP();
    for (;;) {
        const bool has_next = S.next(ui + 1, nxt);
        const char* nA = has_next ? (const char*)g.A + (size_t)nxt.pm * tstep + (size_t)nxt.koff * 2 : cA; const char* nB = has_next ? (const char*)g.Bt + (size_t)nxt.pn * tstep + (size_t)nxt.koff * 2 : cB;
        for (int t = 0; t < nt; t += 2) {
            const bool last = (t == nt - 2);
            const char* a1 = cA + (size_t)(t + 1) * kstep;
            const char* a2 = last ? nA : cA + (size_t)(t + 2) * kstep; const char* b2 = last ? nB : cB + (size_t)(t + 2) * kstep;
            const char* a3 = a2 + kstep; const char* b3 = b2 + kstep;
            if (last && has_next) S.a_ready(nxt);
            PG8_LDB(B0, 0, 0); PG8_SCHED; PG8_LDA(At, 0, 0); PG8_STAGE(PG8_SA(1, 1), a1 + hstep, voffA);
            PG8_WAIT_L(8); PG8_BAR; PG8_WAIT_L(0); PG8_MMA(0, 0, At, B0); PG8_BAR; PG8_SCHED;
            PG8_LDB(B1, 0, 1); PG8_STAGE(PG8_SB(0, 0), b2, voffB);
            PG8_BAR; PG8_WAIT_L(0); PG8_MMA(0, 1, At, B1); PG8_BAR;
            PG8_LDA(At, 0, 1); PG8_STAGE(PG8_SA(0, 0), a2, voffA);
            PG8_BAR; PG8_WAIT_L(0); PG8_MMA(1, 0, At, B0); PG8_BAR; PG8_SCHED;
            PG8_STAGE(PG8_SB(0, 1), b2 + hstep, voffB);
            PG8_WAIT_V(6); PG8_BAR; PG8_MMA(1, 1, At, B1); PG8_BAR;
            PG8_LDB(B0, 1, 0); PG8_SCHED; PG8_LDA(At, 1, 0); PG8_STAGE(PG8_SA(0, 1), a2 + hstep, voffA);
            PG8_WAIT_L(8); PG8_BAR; PG8_WAIT_L(0); PG8_MMA(0, 0, At, B0); PG8_BAR; PG8_SCHED;
            PG8_LDB(B1, 1, 1); PG8_STAGE(PG8_SB(1, 0), b3, voffB);
            PG8_BAR; PG8_WAIT_L(0); PG8_MMA(0, 1, At, B1); PG8_BAR;
            PG8_LDA(At, 1, 1); PG8_STAGE(PG8_SA(1, 0), a3, voffA);
            PG8_BAR; PG8_WAIT_L(0); PG8_MMA(1, 0, At, B0); PG8_BAR; PG8_SCHED;
            PG8_STAGE(PG8_SB(1, 1), b3 + hstep, voffB);
            PG8_WAIT_V(6); PG8_BAR; PG8_MMA(1, 1, At, B1); PG8_BAR;
        }
        PG8_STAMP();
        if constexpr (!Epi::AFTER_DRAIN) { E(acc, cur, wr, wc, fr, fq); S.done(cur); }
        PG8_STAMP();
        if (!has_next) break;
#pragma unroll
        for (int a = 0; a < 2; ++a)
#pragma unroll
            for (int b = 0; b < 2; ++b)
#pragma unroll
                for (int m = 0; m < 4; ++m)
#pragma unroll
                    for (int n = 0; n < 2; ++n) acc[a][b][m][n] = (f32x4){0.f, 0.f, 0.f, 0.f};
        cur = nxt; cA = nA; cB = nB; ++ui;
    }
    PG8_WAIT_V(0);
    if (wr == 0) PG8_BAR;
    PG8_BAR;
    if constexpr (Epi::AFTER_DRAIN) { E.fused(acc, cur, wr, wc, fr, fq, lds, wid, lane); S.done(cur); }
    PG8_STAMP();
    if (STAMP && wid == 0) { stamps[lane] = lane < nts ? (((unsigned long long)(unsigned)ts_hi << 32) | (unsigned)ts_lo) : 0ull;
        if (lane == 62) stamps[62] = rt_entry; if (lane == 63) stamps[63] = (unsigned long long)wall_clock64(); }
#undef PG8_STAMP
#undef PG8_SA
#undef PG8_SB
#undef PG8_STAGE
#undef PG8_LDA
#undef PG8_LDB
#undef PG8_MMA
#undef PG8_WAIT_V
#undef PG8_WAIT_L
#undef PG8_BAR
#undef PG8_SCHED
}
}
using pg8::bf16_t;

constexpr int NTOK = 16896, NPROMPT = 16384, DM = 1024, CONVD = 2304, INC = 4116, INCP = 4352, PBLD = 2048, DFF = 2816;
constexpr int O_GG = 0, O_MQ = 520, O_MK = 776, O_MV = 1032, O_MO = 1288, O_MI = 1544, O_MF = 1548, O_SZ = 1552, O_SDT = 1808, O_GA = 512, O_GB = 516;
constexpr float EPSF = 1e-6f;

struct Params {
  const float* in[31];
  float* out;
  unsigned char* ws;
  long o_ys, o_pconv, o_pgdn, o_pmc, o_pmn, o_pmm, o_pssd, o_pffn, o_sconv, o_sgdn, o_smc, o_smn, o_smm, o_sssd, o_sffn;
  size_t w_in, w_out, w_up, w_dn, hn, gates, ctr, big;
};
constexpr size_t SZ_PROJA = (size_t)NTOK * CONVD * 2, SZ_PROJB = (size_t)NTOK * PBLD * 2, SZ_GV = (size_t)NTOK * DFF * 2;

typedef __bf16 bf16x2_n __attribute__((ext_vector_type(2)));
__device__ __forceinline__ unsigned pk2(float a, float b) { bf16x2_n v = {(__bf16)a, (__bf16)b}; return __builtin_bit_cast(unsigned, v); }
__device__ __forceinline__ float bf2f(unsigned short b) { return __uint_as_float((unsigned)b << 16); }
__device__ __forceinline__ void unpack8(const uint4 u, float (&f)[8]) {
  f[0] = __uint_as_float(u.x << 16); f[1] = __uint_as_float(u.x & 0xffff0000u);
  f[2] = __uint_as_float(u.y << 16); f[3] = __uint_as_float(u.y & 0xffff0000u);
  f[4] = __uint_as_float(u.z << 16); f[5] = __uint_as_float(u.z & 0xffff0000u);
  f[6] = __uint_as_float(u.w << 16); f[7] = __uint_as_float(u.w & 0xffff0000u);
}
__device__ __forceinline__ uint4 pack8(const float (&f)[8]) {
  uint4 r; r.x = pk2(f[0], f[1]); r.y = pk2(f[2], f[3]); r.z = pk2(f[4], f[5]); r.w = pk2(f[6], f[7]); return r;
}
__device__ __forceinline__ void load8f(const float* p, float (&f)[8]) {
  const float4 a = *(const float4*)p, b = *(const float4*)(p + 4);
  f[0] = a.x; f[1] = a.y; f[2] = a.z; f[3] = a.w; f[4] = b.x; f[5] = b.y; f[6] = b.z; f[7] = b.w;
}
__device__ __forceinline__ void store8f(float* p, const float (&f)[8]) {
  *(float4*)p = make_float4(f[0], f[1], f[2], f[3]); *(float4*)(p + 4) = make_float4(f[4], f[5], f[6], f[7]);
}
__device__ __forceinline__ float siluf(float x) { return x * __builtin_amdgcn_rcpf(1.0f + __expf(-x)); }
__device__ __forceinline__ float sigmoidf_(float x) { return __builtin_amdgcn_rcpf(1.0f + __expf(-x)); }
__device__ __forceinline__ float softplusf_(float x) { return x > 20.0f ? x : log1pf(expf(x)); }
__device__ __forceinline__ float dppf(float x, const int ctrl_sel) {
  int v = __float_as_int(x), r;
  if (ctrl_sel == 0) r = __builtin_amdgcn_update_dpp(0, v, 0xB1, 0xf, 0xf, true);
  else if (ctrl_sel == 1) r = __builtin_amdgcn_update_dpp(0, v, 0x4E, 0xf, 0xf, true);
  else if (ctrl_sel == 2) r = __builtin_amdgcn_update_dpp(0, v, 0x141, 0xf, 0xf, true);
  else r = __builtin_amdgcn_update_dpp(0, v, 0x140, 0xf, 0xf, true);
  return __int_as_float(r);
}
__device__ __forceinline__ float sum8(float x) { x += dppf(x, 0); x += dppf(x, 1); x += dppf(x, 2); return x; }
__device__ __forceinline__ float sum16(float x) { x += dppf(x, 0); x += dppf(x, 1); x += dppf(x, 2); x += dppf(x, 3); return x; }
__device__ __forceinline__ float wave_sum(float x) {
  x = sum16(x);
  const int v = __float_as_int(x);
  return __int_as_float(__builtin_amdgcn_readlane(v, 0)) + __int_as_float(__builtin_amdgcn_readlane(v, 16)) + (__int_as_float(__builtin_amdgcn_readlane(v, 32)) + __int_as_float(__builtin_amdgcn_readlane(v, 48)));
}
__device__ __forceinline__ void decode_row(int row, int& isp, int& b, int& pos) {
  if (row < NPROMPT) { isp = 1; b = row >> 11; pos = row & 2047; } else { isp = 0; const int r = row - NPROMPT; b = r >> 2; pos = r & 3; }
}

__device__ __forceinline__ void phase_wconv(const Params& p, int l, float* tile) {
  const int tid = otid();
  const int T0 = 16 * 68 / 4, T1 = T0 + 16 * 16 / 4, T2 = T1 + 16 * 88 / 4, T3 = T2 + 44 * 16 / 4;
  for (int t = obid(); t < T3; t += gridDim.x) {
    const float* src; bf16_t* dst; int K, N, nk, tt;
    if (t < T0) { src = p.in[13] + (size_t)l * 1024 * INC; dst = (bf16_t*)(p.ws + p.w_in); K = 1024; N = INC; nk = 4; tt = t; }
    else if (t < T1) { src = p.in[26] + (size_t)l * 1024 * 1024; dst = (bf16_t*)(p.ws + p.w_out); K = 1024; N = 1024; nk = 4; tt = t - T0; }
    else if (t < T2) { src = p.in[27] + (size_t)l * 1024 * 5632; dst = (bf16_t*)(p.ws + p.w_up); K = 1024; N = 5632; nk = 4; tt = t - T1; }
    else { src = p.in[30] + (size_t)l * DFF * 1024; dst = (bf16_t*)(p.ws + p.w_dn); K = DFF; N = 1024; nk = 11; tt = t - T2; }
    const int k0 = (tt % nk) * 256, n0 = (tt / nk) * 64;
    float v[32];
    { const int nn = tid & 63; const bool ok = n0 + nn < N; const float* sp = src + (size_t)(k0 + (tid >> 6)) * N + n0 + nn;
#pragma unroll
      for (int i = 0; i < 32; ++i) v[i] = ok ? sp[(size_t)(8 * i) * N] : 0.0f;
#pragma unroll
      for (int i = 0; i < 32; ++i) tile[nn * 257 + (tid >> 6) + 8 * i] = v[i]; }
    __syncthreads();
    { const int kp = tid & 127;
#pragma unroll
      for (int i = 0; i < 16; ++i) { const int nn = (tid >> 7) + 4 * i;
        *(unsigned*)(dst + (size_t)(n0 + nn) * K + k0 + 2 * kp) = pk2(tile[nn * 257 + 2 * kp], tile[nn * 257 + 2 * kp + 1]); } }
    __syncthreads();
  }
}

__device__ __forceinline__ void rw_row(const Params& p, int row, float (&x)[2][8], const float (&o)[2][8], bool hasadd, bool hasnorm, const float (&wa)[2][8], const float (&wn)[2][8], bf16_t* hn, int lane) {
  float* xr = p.out + (size_t)row * DM;
  if (hasadd) {
    float ss = 0.f;
#pragma unroll
    for (int j = 0; j < 2; ++j)
#pragma unroll
      for (int e = 0; e < 8; ++e) ss += o[j][e] * o[j][e];
    ss = wave_sum(ss); const float rr = rsqrtf(ss * (1.0f / DM) + EPSF);
#pragma unroll
    for (int j = 0; j < 2; ++j)
#pragma unroll
      for (int e = 0; e < 8; ++e) x[j][e] += o[j][e] * rr * wa[j][e];
    if (hasnorm) {
#pragma unroll
      for (int j = 0; j < 2; ++j) *(uint4*)((bf16_t*)xr + DM + j * 512 + lane * 8) = pack8(x[j]);
    } else {
#pragma unroll
      for (int j = 0; j < 2; ++j) store8f(xr + j * 512 + lane * 8, x[j]);
    }
  }
  if (hasnorm) {
    float ss = 0.f;
#pragma unroll
    for (int j = 0; j < 2; ++j)
#pragma unroll
      for (int e = 0; e < 8; ++e) ss += x[j][e] * x[j][e];
    ss = wave_sum(ss); const float rr = rsqrtf(ss * (1.0f / DM) + EPSF);
#pragma unroll
    for (int j = 0; j < 2; ++j) { float y[8];
#pragma unroll
      for (int e = 0; e < 8; ++e) y[e] = x[j][e] * rr * wn[j][e];
      *(uint4*)(hn + (size_t)row * DM + j * 512 + lane * 8) = pack8(y); }
  }
}
__device__ __forceinline__ void phase_rowwise(const Params& p, bool first, const bf16_t* add, const float* w_add, const float* w_norm, bf16_t* hn, int nsl) {
  constexpr int NR = 2;
  const int lane = otid() & 63, wv = otid() >> 6;
  const int W = gridDim.x * 8, gw = obid() * 8 + wv;
  const bool hasadd = add != nullptr, hasnorm = w_norm != nullptr;
  float wa[2][8], wn[2][8];
#pragma unroll
  for (int j = 0; j < 2; ++j) {
    if (hasadd) load8f(w_add + j * 512 + lane * 8, wa[j]);
    if (hasnorm) load8f(w_norm + j * 512 + lane * 8, wn[j]);
  }
  uint4 cx[NR][4], co[NR][2], nx[NR][4], no[NR][2];
#pragma unroll
  for (int r = 0; r < NR; ++r) { cx[r][0] = cx[r][1] = cx[r][2] = cx[r][3] = co[r][0] = co[r][1] = make_uint4(0u, 0u, 0u, 0u); nx[r][0] = nx[r][1] = nx[r][2] = nx[r][3] = no[r][0] = no[r][1] = make_uint4(0u, 0u, 0u, 0u); }
#define RW_LOAD(X, O, r0_) do { _Pragma("unroll") for (int r = 0; r < NR; ++r) { const int row = (r0_) + r * W; \
      if (row < NPROMPT) { \
        if (first) { const float* xi = p.in[0] + (size_t)row * DM + lane * 8; X[r][0] = *(const uint4*)xi; X[r][1] = *(const uint4*)(xi + 4); X[r][2] = *(const uint4*)(xi + 512); X[r][3] = *(const uint4*)(xi + 516); } \
        else { const bf16_t* xb = (const bf16_t*)(p.out + (size_t)row * DM) + DM + lane * 8; X[r][0] = *(const uint4*)xb; X[r][2] = *(const uint4*)(xb + 512); } \
        if (hasadd) { O[r][0] = *(const uint4*)(add + (size_t)row * DM + lane * 8); O[r][1] = *(const uint4*)(add + (size_t)row * DM + 512 + lane * 8); } } } } while (0)
  RW_LOAD(cx, co, gw);
  for (int row0 = gw; row0 < NPROMPT; row0 += NR * W) {
    if (row0 + NR * W < NPROMPT) RW_LOAD(nx, no, row0 + NR * W);
#pragma unroll
    for (int r = 0; r < NR; ++r) { const int row = row0 + r * W;
      if (row < NPROMPT) {
        float x[2][8], o[2][8];
#pragma unroll
        for (int j = 0; j < 2; ++j) {
          if (first) { x[j][0] = __uint_as_float(cx[r][2 * j].x); x[j][1] = __uint_as_float(cx[r][2 * j].y); x[j][2] = __uint_as_float(cx[r][2 * j].z); x[j][3] = __uint_as_float(cx[r][2 * j].w);
            x[j][4] = __uint_as_float(cx[r][2 * j + 1].x); x[j][5] = __uint_as_float(cx[r][2 * j + 1].y); x[j][6] = __uint_as_float(cx[r][2 * j + 1].z); x[j][7] = __uint_as_float(cx[r][2 * j + 1].w); }
          else unpack8(cx[r][2 * j], x[j]);
          if (hasadd) unpack8(co[r][j], o[j]);
        }
        rw_row(p, row, x, o, hasadd, hasnorm, wa, wn, hn, lane);
      } }
#pragma unroll
    for (int r = 0; r < NR; ++r) { cx[r][0] = nx[r][0]; cx[r][1] = nx[r][1]; cx[r][2] = nx[r][2]; cx[r][3] = nx[r][3]; co[r][0] = no[r][0]; co[r][1] = no[r][1]; }
  }
#undef RW_LOAD
  for (int row = NPROMPT + gw; row < NTOK; row += W) {
    float x[2][8], o[2][8];
#pragma unroll
    for (int j = 0; j < 2; ++j) {
      if (first) load8f(p.in[1] + (size_t)(row - NPROMPT) * DM + j * 512 + lane * 8, x[j]);
      else unpack8(*(const uint4*)((const bf16_t*)(p.out + (size_t)row * DM) + DM + j * 512 + lane * 8), x[j]);
      if (hasadd) { const float* of = (const float*)(p.ws + p.big + ((size_t)40 << 20)) + (size_t)(row - NPROMPT) * DM + j * 512 + lane * 8; load8f(of, o[j]);
        for (int ks = 1; ks < nsl; ++ks) { float t8[8]; load8f(of + (size_t)ks * (512 * 1024), t8);
#pragma unroll
          for (int e = 0; e < 8; ++e) o[j][e] += t8[e]; } }
    }
    rw_row(p, row, x, o, hasadd, hasnorm, wa, wn, hn, lane);
  }
}

__device__ __forceinline__ void phase_prep(const Params& p, int l) {
  const bf16_t* projA = (const bf16_t*)(p.ws + p.big);
  const bf16_t* projB = (const bf16_t*)(p.ws + p.big + SZ_PROJA);
  bf16_t* convo = (bf16_t*)(p.ws + p.big + SZ_PROJA + SZ_PROJB);
  float* gates = (float*)(p.ws + p.gates);
  const float* cw = p.in[14] + (size_t)l * 4 * CONVD; const float* cb = p.in[15] + (size_t)l * CONVD;
  const int gtid = obid() * 512 + otid(), gstride = gridDim.x * 512;
  if (gtid < 455 * 288) {
    const int v = gtid % 288, c0 = v * 8;
    float w[4][8], bias[8]; load8f(cb + c0, bias);
#pragma unroll
    for (int j = 0; j < 4; ++j) load8f(cw + j * CONVD + c0, w[j]);
    uint4 cur[7], nxt[7];
#pragma unroll
    for (int i = 0; i < 7; ++i) cur[i] = nxt[i] = make_uint4(0u, 0u, 0u, 0u);
#define PREP_LOAD(R, ch) do { const int rb_ = (ch) * 4; const bf16_t* q_ = projA + (size_t)rb_ * CONVD + c0; \
      _Pragma("unroll") for (int i = 0; i < 4; ++i) R[3 + i] = *(const uint4*)(q_ + (size_t)i * CONVD); \
      if ((rb_ & 2047) > 0) { _Pragma("unroll") for (int j = 0; j < 3; ++j) R[j] = *(const uint4*)(q_ - (size_t)(3 - j) * CONVD); } } while (0)
    int chunk = gtid / 288;
    PREP_LOAD(cur, chunk);
#pragma unroll 1
    for (; chunk < 4095; chunk += 455) {
      if (chunk + 455 < 4095) PREP_LOAD(nxt, chunk + 455);
      const int rbase = chunk * 4, b = rbase >> 11, pos0 = rbase & 2047;
      float xp[7][8];
#pragma unroll
      for (int i = 0; i < 4; ++i) unpack8(cur[3 + i], xp[3 + i]);
      if (pos0 > 0) {
#pragma unroll
        for (int j = 0; j < 3; ++j) unpack8(cur[j], xp[j]);
      } else {
#pragma unroll
        for (int j = 0; j < 3; ++j)
#pragma unroll
          for (int e = 0; e < 8; ++e) xp[j][e] = 0.f;
      }
#pragma unroll
      for (int i = 0; i < 4; ++i) {
        float y[8];
#pragma unroll
        for (int e = 0; e < 8; ++e) y[e] = siluf(bias[e] + w[0][e] * xp[i][e] + w[1][e] * xp[i + 1][e] + w[2][e] * xp[i + 2][e] + w[3][e] * xp[i + 3][e]);
        if (c0 < 1024) {
          float ss = 0.f;
#pragma unroll
          for (int e = 0; e < 8; ++e) ss += y[e] * y[e];
          ss = sum16(ss);
          const float sc = rsqrtf(ss + EPSF) * (c0 < 512 ? 0.08838834764831845f : 1.0f);
#pragma unroll
          for (int e = 0; e < 8; ++e) y[e] *= sc;
        }
        *(uint4*)(convo + (size_t)(rbase + i) * CONVD + c0) = pack8(y);
        if (pos0 == 2044 && i >= 1) store8f(p.out + p.o_pconv + (((size_t)l * 8 + b) * 3 + (i - 1)) * CONVD + c0, xp[3 + i]);
      }
#pragma unroll
      for (int i = 0; i < 7; ++i) cur[i] = nxt[i];
    }
#undef PREP_LOAD
  }
  for (int it = 4095 * 288 + gtid; it < (NTOK / 4) * 288; it += gstride) {
    const int chunk = it / 288, v = it - chunk * 288, c0 = v * 8, rbase = chunk * 4;
    int isp, b, pos0; decode_row(rbase, isp, b, pos0);
    uint4 rw[4]; float xp[7][8];
#pragma unroll
    for (int i = 0; i < 4; ++i) rw[i] = *(const uint4*)(projA + (size_t)(rbase + i) * CONVD + c0);
    if (isp) {
      if (pos0 > 0) {
#pragma unroll
        for (int j = 0; j < 3; ++j) unpack8(*(const uint4*)(projA + (size_t)(rbase - 3 + j) * CONVD + c0), xp[j]);
      } else {
#pragma unroll
        for (int j = 0; j < 3; ++j)
#pragma unroll
          for (int e = 0; e < 8; ++e) xp[j][e] = 0.f;
      }
    } else {
#pragma unroll
      for (int j = 0; j < 3; ++j) load8f(p.in[2] + (((size_t)l * 128 + b) * 3 + j) * CONVD + c0, xp[j]);
    }
    float w[4][8], bias[8]; load8f(cb + c0, bias);
#pragma unroll
    for (int j = 0; j < 4; ++j) load8f(cw + j * CONVD + c0, w[j]);
#pragma unroll
    for (int i = 0; i < 4; ++i) unpack8(rw[i], xp[3 + i]);
    const bool lastc = isp ? (pos0 == 2044) : true;
#pragma unroll
    for (int i = 0; i < 4; ++i) {
      float y[8];
#pragma unroll
      for (int e = 0; e < 8; ++e) y[e] = siluf(bias[e] + w[0][e] * xp[i][e] + w[1][e] * xp[i + 1][e] + w[2][e] * xp[i + 2][e] + w[3][e] * xp[i + 3][e]);
      if (c0 < 1024) {
        float ss = 0.f;
#pragma unroll
        for (int e = 0; e < 8; ++e) ss += y[e] * y[e];
        ss = sum16(ss);
        const float sc = rsqrtf(ss + EPSF) * (c0 < 512 ? 0.08838834764831845f : 1.0f);
#pragma unroll
        for (int e = 0; e < 8; ++e) y[e] *= sc;
      }
      *(uint4*)(convo + (size_t)(rbase + i) * CONVD + c0) = pack8(y);
      if (lastc && i >= 1) store8f((isp ? p.out + p.o_pconv + (((size_t)l * 8 + b) * 3 + (i - 1)) * CONVD : p.out + p.o_sconv + (((size_t)l * 128 + b) * 3 + (i - 1)) * CONVD) + c0, xp[3 + i]);
    }
  }
  for (int i = gtid; i < NTOK * 4; i += gstride) {
    const int row = i >> 2, h = i & 3;
    const bf16_t* pb = projB + (size_t)row * PBLD;
    const float ga = bf2f(pb[O_GA + h]), gb = bf2f(pb[O_GB + h]), mi = bf2f(pb[O_MI + h]), mf = bf2f(pb[O_MF + h]), sdt = bf2f(pb[O_SDT + h]);
    float* g = gates + (size_t)row * 32;
    g[h] = -expf(p.in[16][l * 4 + h]) * softplusf_(ga + p.in[17][l * 4 + h]);
    g[4 + h] = sigmoidf_(gb);
    g[8 + h] = mi + p.in[19][l * 4 + h];
    g[12 + h] = -softplusf_(-(mf + p.in[20][l * 4 + h]));
    const float dt = softplusf_(sdt + p.in[23][l * 4 + h]);
    g[16 + h] = dt;
    g[20 + h] = dt * (-expf(p.in[22][l * 4 + h]));
  }
}

typedef float f2 __attribute__((ext_vector_type(2)));
typedef float f4 __attribute__((ext_vector_type(4)));
#define LAS __attribute__((address_space(3)))
constexpr int TC = 32;
__device__ __forceinline__ void lds_store8(LAS float* q, const float (&f)[8]) { *(LAS f4*)q = (f4){f[0], f[1], f[2], f[3]}; *(LAS f4*)(q + 4) = (f4){f[4], f[5], f[6], f[7]}; }
__device__ __forceinline__ float hsum(f2 a) { return a.x + a.y; }

__device__ __forceinline__ void gdn_item(const Params& p, LAS float* lds, int row0, int T, int h, int sl, float* sout) {
  const int tid = otid(), cl = tid >> 4, s = tid & 15, col = sl * 32 + cl;
  const bf16_t* convo = (const bf16_t*)(p.ws + p.big + SZ_PROJA + SZ_PROJB);
  const float* gates = (const float*)(p.ws + p.gates);
  bf16_t* raw = (bf16_t*)(p.ws + p.hn);
  constexpr int BUF = 9344;
  LAS float* obuf = lds + 2 * BUF;
  f2 S[4];
#pragma unroll
  for (int i = 0; i < 4; ++i) S[i] = (f2){0.f, 0.f};
  const int nch = T / TC;
  uint4 rq, rk, rv; float ra = 0.f, rb = 0.f;
  rq = rk = rv = make_uint4(0, 0, 0, 0);
  const int tt = tid >> 4, cv = tid & 15;
#define GDN_LOAD(c) do { { const bf16_t* r_ = convo + (size_t)(row0 + (c) * TC + tt) * CONVD + h * 128 + cv * 8; rq = *(const uint4*)r_; rk = *(const uint4*)(r_ + 512); } \
    if (tid < 128) rv = *(const uint4*)(convo + (size_t)(row0 + (c) * TC + (tid >> 2)) * CONVD + 1024 + h * 128 + sl * 32 + (tid & 3) * 8); \
    else if (tid < 160) { const float* g_ = gates + (size_t)(row0 + (c) * TC + (tid - 128)) * 32; ra = __expf(g_[h]); rb = g_[4 + h]; } } while (0)
#define GDN_STORE(buf) do { float fq_[8], fk_[8]; unpack8(rq, fq_); unpack8(rk, fk_); lds_store8((buf) + tt * 128 + cv * 8, fq_); lds_store8((buf) + 4096 + tt * 128 + cv * 8, fk_); \
    float d_ = 0.f; _Pragma("unroll") for (int e = 0; e < 8; ++e) d_ += fq_[e] * fk_[e]; d_ = sum16(d_); if (cv == 0) (buf)[9216 + tt * 4 + 2] = d_; \
    if (tid < 128) { unpack8(rv, fq_); lds_store8((buf) + 8192 + (tid >> 2) * 32 + (tid & 3) * 8, fq_); } \
    else if (tid < 160) { (buf)[9216 + (tid - 128) * 4] = ra; (buf)[9216 + (tid - 128) * 4 + 1] = rb; } } while (0)
  __syncthreads();
  GDN_LOAD(0); GDN_STORE(lds); __syncthreads();
  for (int c = 0; c < nch; ++c) {
    const LAS float* buf = lds + (c & 1) * BUF;
    if (c + 1 < nch) GDN_LOAD(c + 1);
    f4 kA_l, kA_h, qA_l, qA_h, scA, kB_l, kB_h, qB_l, qB_h, scB; float vA, vB;
#define GDN_FETCH(X, t) do { const int t_ = (t); k##X##_l = *(const LAS f4*)(buf + 4096 + t_ * 128 + 8 * s); k##X##_h = *(const LAS f4*)(buf + 4096 + t_ * 128 + 8 * s + 4); \
      q##X##_l = *(const LAS f4*)(buf + t_ * 128 + 8 * s); q##X##_h = *(const LAS f4*)(buf + t_ * 128 + 8 * s + 4); v##X = buf[8192 + t_ * 32 + cl]; sc##X = *(const LAS f4*)(buf + 9216 + t_ * 4); } while (0)
#define GDN_STEP(X, t) do { const f2 k0 = {k##X##_l.x, k##X##_l.y}, k1 = {k##X##_l.z, k##X##_l.w}, k2 = {k##X##_h.x, k##X##_h.y}, k3 = {k##X##_h.z, k##X##_h.w}; \
      const f2 q0 = {q##X##_l.x, q##X##_l.y}, q1 = {q##X##_l.z, q##X##_l.w}, q2 = {q##X##_h.x, q##X##_h.y}, q3 = {q##X##_h.z, q##X##_h.w}; \
      f2 t0 = k0 * S[0], t1 = k2 * S[2], u0 = q0 * S[0], u1 = q2 * S[2]; t0 = k1 * S[1] + t0; t1 = k3 * S[3] + t1; u0 = q1 * S[1] + u0; u1 = q3 * S[3] + u1; \
      float pk = hsum(t0 + t1), pq = hsum(u0 + u1); pk = sum16(pk); pq = sum16(pq); \
      const float a = sc##X.x, r = sc##X.y * (v##X - a * pk), o = a * pq + sc##X.z * r; const f2 a2 = {a, a}, r2 = {r, r}; \
      S[0] = k0 * r2 + a2 * S[0]; S[1] = k1 * r2 + a2 * S[1]; S[2] = k2 * r2 + a2 * S[2]; S[3] = k3 * r2 + a2 * S[3]; \
      if (s == 0) obuf[(t) * 32 + cl] = o; } while (0)
    GDN_FETCH(A, 0);
#pragma unroll 1
    for (int t = 0; t < TC; t += 2) {
      GDN_FETCH(B, t + 1);
      GDN_STEP(A, t);
      GDN_FETCH(A, min(t + 2, TC - 1));
      GDN_STEP(B, t + 1);
    }
    __syncthreads();
    { const int cp = cv * 2; const unsigned w = pk2(obuf[tt * 32 + cp], obuf[tt * 32 + cp + 1]);
      *(unsigned*)(raw + (size_t)(row0 + c * TC + tt) * DM + h * 128 + sl * 32 + cp) = w; }
    if (c + 1 < nch) { LAS float* nb = lds + ((c + 1) & 1) * BUF; GDN_STORE(nb); }
    __syncthreads();
  }
#pragma unroll
  for (int i = 0; i < 4; ++i) { sout[(size_t)(8 * s + 2 * i) * 128 + col] = S[i].x; sout[(size_t)(8 * s + 2 * i + 1) * 128 + col] = S[i].y; }
#undef GDN_LOAD
#undef GDN_STORE
#undef GDN_FETCH
#undef GDN_STEP
}

__device__ __forceinline__ void ssd_item(const Params& p, LAS float* lds, int row0, int T, int h, int half, float* hout) {
  const int tid = otid(), pl = tid >> 4, s = tid & 15, grp = h >> 1;
  const bf16_t* convo = (const bf16_t*)(p.ws + p.big + SZ_PROJA + SZ_PROJB);
  const float* gates = (const float*)(p.ws + p.gates);
  bf16_t* raw = (bf16_t*)(p.ws + p.hn);
  constexpr int BUF = 9344;
  LAS float* obuf = lds + 2 * BUF;
  f2 H[4];
#pragma unroll
  for (int i = 0; i < 4; ++i) H[i] = (f2){0.f, 0.f};
  const int nch = T / TC;
  uint4 rB, rC, rx; float rdt = 0.f, rda = 0.f; rB = rC = rx = make_uint4(0, 0, 0, 0);
  const int tt = tid >> 4, cv = tid & 15;
#define SSD_LOAD(c) do { { const bf16_t* r_ = convo + (size_t)(row0 + (c) * TC + tt) * CONVD + grp * 128 + cv * 8; rB = *(const uint4*)(r_ + 1792); rC = *(const uint4*)(r_ + 2048); } \
    if (tid < 128) rx = *(const uint4*)(convo + (size_t)(row0 + (c) * TC + (tid >> 2)) * CONVD + 1536 + h * 64 + half * 32 + (tid & 3) * 8); \
    else if (tid < 160) { const float* g_ = gates + (size_t)(row0 + (c) * TC + (tid - 128)) * 32; rdt = g_[16 + h]; rda = __expf(g_[20 + h]); } } while (0)
#define SSD_STORE(buf) do { float fb_[8], fc_[8]; unpack8(rB, fb_); unpack8(rC, fc_); lds_store8((buf) + 1024 + tt * 128 + cv * 8, fb_); lds_store8((buf) + 5120 + tt * 128 + cv * 8, fc_); \
    float d_ = 0.f; _Pragma("unroll") for (int e = 0; e < 8; ++e) d_ += fb_[e] * fc_[e]; d_ = sum16(d_); if (cv == 0) (buf)[9216 + tt * 4 + 2] = d_; \
    if (tid < 128) { unpack8(rx, fb_); lds_store8((buf) + (tid >> 2) * 32 + (tid & 3) * 8, fb_); } \
    else if (tid < 160) { (buf)[9216 + (tid - 128) * 4] = rda; (buf)[9216 + (tid - 128) * 4 + 1] = rdt; } } while (0)
  __syncthreads();
  SSD_LOAD(0); SSD_STORE(lds); __syncthreads();
  for (int c = 0; c < nch; ++c) {
    const LAS float* buf = lds + (c & 1) * BUF;
    if (c + 1 < nch) SSD_LOAD(c + 1);
    f4 bA_l, bA_h, cA_l, cA_h, scA, bB_l, bB_h, cB_l, cB_h, scB; float xA, xB;
#define SSD_FETCH(X, t) do { const int t_ = (t); b##X##_l = *(const LAS f4*)(buf + 1024 + t_ * 128 + 8 * s); b##X##_h = *(const LAS f4*)(buf + 1024 + t_ * 128 + 8 * s + 4); \
      c##X##_l = *(const LAS f4*)(buf + 5120 + t_ * 128 + 8 * s); c##X##_h = *(const LAS f4*)(buf + 5120 + t_ * 128 + 8 * s + 4); x##X = buf[t_ * 32 + pl]; sc##X = *(const LAS f4*)(buf + 9216 + t_ * 4); } while (0)
#define SSD_STEP(X, t) do { const f2 b0 = {b##X##_l.x, b##X##_l.y}, b1 = {b##X##_l.z, b##X##_l.w}, b2 = {b##X##_h.x, b##X##_h.y}, b3 = {b##X##_h.z, b##X##_h.w}; \
      const f2 c0 = {c##X##_l.x, c##X##_l.y}, c1 = {c##X##_l.z, c##X##_l.w}, c2 = {c##X##_h.x, c##X##_h.y}, c3 = {c##X##_h.z, c##X##_h.w}; \
      f2 t0 = c0 * H[0], t1 = c2 * H[2]; t0 = c1 * H[1] + t0; t1 = c3 * H[3] + t1; \
      float pc = hsum(t0 + t1); pc = sum16(pc); \
      const float dA = sc##X.x, dtx = sc##X.y * x##X, y = dA * pc + dtx * sc##X.z; const f2 a2 = {dA, dA}, r2 = {dtx, dtx}; \
      H[0] = b0 * r2 + a2 * H[0]; H[1] = b1 * r2 + a2 * H[1]; H[2] = b2 * r2 + a2 * H[2]; H[3] = b3 * r2 + a2 * H[3]; \
      if (s == 0) obuf[(t) * 32 + pl] = y; } while (0)
    SSD_FETCH(A, 0);
#pragma unroll 1
    for (int t = 0; t < TC; t += 2) {
      SSD_FETCH(B, t + 1);
      SSD_STEP(A, t);
      SSD_FETCH(A, min(t + 2, TC - 1));
      SSD_STEP(B, t + 1);
    }
    __syncthreads();
    { const int cp = cv * 2; const unsigned w = pk2(obuf[tt * 32 + cp], obuf[tt * 32 + cp + 1]);
      *(unsigned*)(raw + (size_t)(row0 + c * TC + tt) * DM + 768 + h * 64 + half * 32 + cp) = w; }
    if (c + 1 < nch) { LAS float* nb = lds + ((c + 1) & 1) * BUF; SSD_STORE(nb); }
    __syncthreads();
  }
  { float* ho = hout + (size_t)(half * 32 + pl) * 128 + 8 * s;
    *(float4*)ho = make_float4(H[0].x, H[0].y, H[1].x, H[1].y); *(float4*)(ho + 4) = make_float4(H[2].x, H[2].y, H[3].x, H[3].y); }
#undef SSD_LOAD
#undef SSD_STORE
#undef SSD_FETCH
#undef SSD_STEP
}

__device__ __forceinline__ void mlstm_item(const Params& p, LAS float* lds, int row0, int T, int h, float* cout, float* nout, float* mout) {
  const int tid = otid(), col = tid >> 3, s = tid & 7, lane = tid & 63;
  const bf16_t* projB = (const bf16_t*)(p.ws + p.big + SZ_PROJA);
  const float* gates = (const float*)(p.ws + p.gates);
  bf16_t* raw = (bf16_t*)(p.ws + p.hn);
  constexpr int BUF = 6272;
  LAS float* obuf = lds + 2 * BUF;
  f2 C[4], n[4];
#pragma unroll
  for (int i = 0; i < 4; ++i) { C[i] = (f2){0.f, 0.f}; n[i] = (f2){0.f, 0.f}; }
  float mcar = 0.f;
  const int nch = T / TC;
  uint4 r0, r1; float rli = 0.f, rlf = 0.f; r0 = r1 = make_uint4(0, 0, 0, 0);
  const int u = tid & 255, tt = u >> 3, cv = u & 7;
#define ML_LOAD(c) do { const bf16_t* r_ = projB + (size_t)(row0 + (c) * TC + tt) * PBLD + h * 64 + cv * 8; \
    if (tid < 256) { r0 = *(const uint4*)(r_ + O_MQ); r1 = *(const uint4*)(r_ + O_MK); } else { r0 = *(const uint4*)(r_ + O_MV); \
      if (tid < 288) { const float* g_ = gates + (size_t)(row0 + (c) * TC + (tid - 256)) * 32; rli = g_[8 + h]; rlf = g_[12 + h]; } } } while (0)
#define ML_STORE(buf) do { float f0_[8], f1_[8]; unpack8(r0, f0_); \
    if (tid < 256) { unpack8(r1, f1_); _Pragma("unroll") for (int e = 0; e < 8; ++e) f1_[e] *= 0.125f; lds_store8((buf) + tt * 64 + cv * 8, f0_); lds_store8((buf) + 2048 + tt * 64 + cv * 8, f1_); \
      float d_ = 0.f; _Pragma("unroll") for (int e = 0; e < 8; ++e) d_ += f0_[e] * f1_[e]; d_ = sum8(d_); if (cv == 0) (buf)[6144 + tt * 4 + 2] = d_; } \
    else { lds_store8((buf) + 4096 + tt * 64 + cv * 8, f0_); \
      if (tid < 320) {     \
        float F_ = rlf; _Pragma("unroll") for (int o_ = 1; o_ < 32; o_ <<= 1) { const float t_ = __shfl_up(F_, o_); if (lane >= o_) F_ += t_; } \
        float G_ = rli - F_; _Pragma("unroll") for (int o_ = 1; o_ < 32; o_ <<= 1) { const float t_ = __shfl_up(G_, o_); if (lane >= o_) G_ = fmaxf(G_, t_); } \
        const float m_ = F_ + fmaxf(mcar, G_); float mp_ = __shfl_up(m_, 1); if (lane == 0) mp_ = mcar; \
        if (lane < 32) { (buf)[6144 + lane * 4] = __expf(rlf + mp_ - m_); (buf)[6144 + lane * 4 + 1] = __expf(rli - m_); (buf)[6144 + lane * 4 + 3] = __expf(-m_); } \
        mcar = __shfl(m_, 31); } } } while (0)
  __syncthreads();
  ML_LOAD(0); ML_STORE(lds); __syncthreads();
  for (int c = 0; c < nch; ++c) {
    const LAS float* buf = lds + (c & 1) * BUF;
    if (c + 1 < nch) ML_LOAD(c + 1);
    f4 kA_l, kA_h, qA_l, qA_h, scA, kB_l, kB_h, qB_l, qB_h, scB; float vA, vB;
#define ML_FETCH(X, t) do { const int t_ = (t); k##X##_l = *(const LAS f4*)(buf + 2048 + t_ * 64 + 8 * s); k##X##_h = *(const LAS f4*)(buf + 2048 + t_ * 64 + 8 * s + 4); \
      q##X##_l = *(const LAS f4*)(buf + t_ * 64 + 8 * s); q##X##_h = *(const LAS f4*)(buf + t_ * 64 + 8 * s + 4); v##X = buf[4096 + t_ * 64 + col]; sc##X = *(const LAS f4*)(buf + 6144 + t_ * 4); } while (0)
#define ML_STEP(X, t) do { const f2 k0 = {k##X##_l.x, k##X##_l.y}, k1 = {k##X##_l.z, k##X##_l.w}, k2 = {k##X##_h.x, k##X##_h.y}, k3 = {k##X##_h.z, k##X##_h.w}; \
      const f2 q0 = {q##X##_l.x, q##X##_l.y}, q1 = {q##X##_l.z, q##X##_l.w}, q2 = {q##X##_h.x, q##X##_h.y}, q3 = {q##X##_h.z, q##X##_h.w}; \
      f2 t0 = q0 * C[0], t1 = q2 * C[2], u0 = q0 * n[0], u1 = q2 * n[2]; t0 = q1 * C[1] + t0; t1 = q3 * C[3] + t1; u0 = q1 * n[1] + u0; u1 = q3 * n[3] + u1; \
      float pc = hsum(t0 + t1), pn = hsum(u0 + u1); pc = sum8(pc); pn = sum8(pn); \
      const float fp = sc##X.x, ip = sc##X.y, iqk = ip * sc##X.z, num = fp * pc + iqk * v##X; const float den = fmaxf(fabsf(fp * pn + iqk), sc##X.w); \
      const float iv = ip * v##X; const f2 f2_ = {fp, fp}, iv2 = {iv, iv}, ip2 = {ip, ip}; \
      C[0] = k0 * iv2 + f2_ * C[0]; C[1] = k1 * iv2 + f2_ * C[1]; C[2] = k2 * iv2 + f2_ * C[2]; C[3] = k3 * iv2 + f2_ * C[3]; \
      n[0] = k0 * ip2 + f2_ * n[0]; n[1] = k1 * ip2 + f2_ * n[1]; n[2] = k2 * ip2 + f2_ * n[2]; n[3] = k3 * ip2 + f2_ * n[3]; \
      if (s == 0) obuf[(t) * 64 + col] = num * __builtin_amdgcn_rcpf(den); } while (0)
    ML_FETCH(A, 0);
#pragma unroll 1
    for (int t = 0; t < TC; t += 2) {
      ML_FETCH(B, t + 1);
      ML_STEP(A, t);
      ML_FETCH(A, min(t + 2, TC - 1));
      ML_STEP(B, t + 1);
    }
    __syncthreads();
    { const int t2 = tid >> 4, cp = (tid & 15) * 4;
      uint2 w; w.x = pk2(obuf[t2 * 64 + cp], obuf[t2 * 64 + cp + 1]); w.y = pk2(obuf[t2 * 64 + cp + 2], obuf[t2 * 64 + cp + 3]);
      *(uint2*)(raw + (size_t)(row0 + c * TC + t2) * DM + 512 + h * 64 + cp) = w; }
    if (c + 1 < nch) { LAS float* nb = lds + ((c + 1) & 1) * BUF; ML_STORE(nb); }
    __syncthreads();
  }
#pragma unroll
  for (int i = 0; i < 4; ++i) { cout[(size_t)(8 * s + 2 * i) * 64 + col] = C[i].x; cout[(size_t)(8 * s + 2 * i + 1) * 64 + col] = C[i].y;
    if (col == 0) { nout[8 * s + 2 * i] = n[i].x; nout[8 * s + 2 * i + 1] = n[i].y; } }
  if (tid == 256) mout[0] = mcar;
#undef ML_LOAD
#undef ML_STORE
#undef ML_FETCH
#undef ML_STEP
}

typedef short bf16x8_t __attribute__((ext_vector_type(8)));
typedef unsigned u32x4_t __attribute__((ext_vector_type(4)));
typedef unsigned u32x2_t __attribute__((ext_vector_type(2)));
__device__ __forceinline__ void lds_st16(LAS bf16_t* q, const uint4 v) { *(LAS u32x4_t*)q = (u32x4_t){v.x, v.y, v.z, v.w}; }
__device__ __forceinline__ void lds_st8(LAS bf16_t* q, unsigned a, unsigned b) { *(LAS u32x2_t*)q = (u32x2_t){a, b}; }
__device__ __forceinline__ unsigned short f2bf(float f) { unsigned u = __float_as_uint(f); u += 0x7FFFu + ((u >> 16) & 1u); return (unsigned short)(u >> 16); }
template <int K> __device__ __forceinline__ f4 mma_rows(const LAS bf16_t* A, int lda, const LAS bf16_t* B, int ldb, f4 acc, int lane) {
  const LAS bf16_t* ap = A + (lane & 15) * lda + (lane >> 4) * 8; const LAS bf16_t* bp = B + (lane & 15) * ldb + (lane >> 4) * 8;
#pragma unroll
  for (int k0 = 0; k0 < K; k0 += 32) acc = __builtin_amdgcn_mfma_f32_16x16x32_bf16(*(const LAS bf16x8_t*)(ap + k0), *(const LAS bf16x8_t*)(bp + k0), acc, 0, 0, 0);
  return acc;
}
template <int K, bool SWA, bool SWB> __device__ __forceinline__ f4 mma_rows_sw(const LAS bf16_t* A, int arow0, int lda, const LAS bf16_t* B, int brow0, int ldb, f4 acc, int lane) {
  const int ar = arow0 + (lane & 15), br = brow0 + (lane & 15), g = lane >> 4;
  const LAS bf16_t* ap = A + ar * lda; const LAS bf16_t* bp = B + br * ldb;
  const int sa = SWA ? ((ar >> 3) & 7) : 0, sb = SWB ? ((br >> 3) & 7) : 0;
#pragma unroll
  for (int k0 = 0; k0 < K; k0 += 32) { const int kc = (k0 >> 3) + g;
    acc = __builtin_amdgcn_mfma_f32_16x16x32_bf16(*(const LAS bf16x8_t*)(ap + ((kc ^ sa) << 3)), *(const LAS bf16x8_t*)(bp + ((kc ^ sb) << 3)), acc, 0, 0, 0); }
  return acc;
}
template <int K, int NB, int NTOT, bool SWA, bool SWB> __device__ __forceinline__ void mma_strip(const LAS bf16_t* A, int arow0, int lda, const LAS bf16_t* B, int brow0, int ldb, f4 (&acc)[NTOT], const int off, int lane) {
  const int ar = arow0 + (lane & 15), g = lane >> 4; const LAS bf16_t* ap = A + ar * lda; const int sa = SWA ? ((ar >> 3) & 7) : 0;
  bf16x8_t af[K / 32];
#pragma unroll
  for (int ks = 0; ks < K / 32; ++ks) af[ks] = *(const LAS bf16x8_t*)(ap + (((ks * 4 + g) ^ sa) << 3));
#pragma unroll
  for (int nb = 0; nb < NB; ++nb) { const int br = brow0 + nb * 16 + (lane & 15); const LAS bf16_t* bp = B + br * ldb; const int sb = SWB ? ((br >> 3) & 7) : 0;
#pragma unroll
    for (int ks = 0; ks < K / 32; ++ks) acc[off + nb] = __builtin_amdgcn_mfma_f32_16x16x32_bf16(af[ks], *(const LAS bf16x8_t*)(bp + (((ks * 4 + g) ^ sb) << 3)), acc[off + nb], 0, 0, 0); }
}
__device__ __forceinline__ int swz_col(int row, int col) { return ((((col >> 3) ^ (row >> 3)) & 7) << 3) | (col & 7); }
template <int CTRL, int RMASK> __device__ __forceinline__ float dpp_id(float x, float ident) {
  return __int_as_float(__builtin_amdgcn_update_dpp(__float_as_int(ident), __float_as_int(x), CTRL, RMASK, 0xf, false));
}
__device__ __forceinline__ float wave_scan_add(float x, int lane) {
  (void)lane;
  x += dpp_id<0x111, 0xf>(x, 0.f); x += dpp_id<0x112, 0xf>(x, 0.f); x += dpp_id<0x114, 0xf>(x, 0.f); x += dpp_id<0x118, 0xf>(x, 0.f);
  x += dpp_id<0x142, 0xa>(x, 0.f); x += dpp_id<0x143, 0xc>(x, 0.f);
  return x;
}
__device__ __forceinline__ float wave_scan_max(float x, int lane) {
  (void)lane; const float ninf = -__builtin_inff();
  x = fmaxf(x, dpp_id<0x111, 0xf>(x, ninf)); x = fmaxf(x, dpp_id<0x112, 0xf>(x, ninf)); x = fmaxf(x, dpp_id<0x114, 0xf>(x, ninf)); x = fmaxf(x, dpp_id<0x118, 0xf>(x, ninf));
  x = fmaxf(x, dpp_id<0x142, 0xa>(x, ninf)); x = fmaxf(x, dpp_id<0x143, 0xc>(x, ninf));
  return x;
}

#define LDS_BARRIER() do { asm volatile("s_waitcnt lgkmcnt(0)" ::: "memory"); __builtin_amdgcn_s_barrier(); asm volatile("" ::: "memory"); } while (0)
#define GAS __attribute__((address_space(1)))
__device__ __forceinline__ void unpack8(const u32x4_t u, float (&f)[8]) { unpack8(make_uint4(u.x, u.y, u.z, u.w), f); }
__device__ __forceinline__ void lds_st16(LAS bf16_t* q, const u32x4_t v) { *(LAS u32x4_t*)q = v; }
template <int MODE>
__device__ __forceinline__ void gla_item(const Params& p, LAS unsigned char* ldsb, int l, int b, int h, int sl) {
  constexpr int DQ = (MODE == 1) ? 64 : 128, DVP = (MODE == 1) ? 80 : (MODE == 2) ? 32 : 64, NVT = DVP / 16, NQT = DQ / 16, NVR = (MODE == 2) ? 2 : 4;
  constexpr int LQ = DQ + 8, LJ = 72, NQV = DQ / 64;
  constexpr int STILES = (NQT * NVT + 3) / 4;
  LAS bf16_t* Qs = (LAS bf16_t*)ldsb;
  LAS bf16_t* Ks = Qs + 64 * LQ;
  LAS bf16_t* KwT = Ks + 64 * LQ;
  LAS bf16_t* VT = KwT + DQ * LJ;
  LAS bf16_t* ST = VT + DVP * LJ;
  LAS bf16_t* Ws = ST + DVP * LQ;
  LAS bf16_t* Ts = Ws + 64 * LJ;
  LAS bf16_t* RT = Ts + 64 * LJ;
  LAS float* scal = (LAS float*)(RT + 64 * LJ);
  const int tid = otid(), lane = tid & 63, wv = tid >> 6, j = tid >> 3, fv = tid & 7;
  const int row0 = b * 2048;
  const GAS bf16_t* convo = (const GAS bf16_t*)(p.ws + p.big + SZ_PROJA + SZ_PROJB);
  const GAS bf16_t* projB = (const GAS bf16_t*)(p.ws + p.big + SZ_PROJA);
  const GAS float* gates = (const GAS float*)(p.ws + p.gates);
  GAS bf16_t* raw = (GAS bf16_t*)(p.ws + p.hn);
  const GAS bf16_t* qsrc; const GAS bf16_t* ksrc; const GAS bf16_t* vsrc; int ldsrc, ocol;
  if (MODE == 0) { ldsrc = CONVD; qsrc = convo + 2048 + (h >> 1) * 128; ksrc = convo + 1792 + (h >> 1) * 128; vsrc = convo + 1536 + h * 64; ocol = 768 + h * 64; }
  else if (MODE == 1) { ldsrc = PBLD; qsrc = projB + O_MQ + h * 64; ksrc = projB + O_MK + h * 64; vsrc = projB + O_MV + h * 64; ocol = 512 + h * 64; }
  else { ldsrc = CONVD; qsrc = convo + h * 128; ksrc = convo + 512 + h * 128; vsrc = convo + 1024 + h * 128 + sl * 32; ocol = h * 128 + sl * 32; }
  const GAS bf16_t* tsrc = (const GAS bf16_t*)(p.ws + p.big) + (size_t)(b * 4 + h) * 32 * 4096;
  __syncthreads();
  for (int i = tid; i < DVP * LQ / 2; i += 512) ((LAS unsigned*)ST)[i] = 0u;
  for (int i = tid; i < 64 * LJ / 2; i += 512) ((LAS unsigned*)Ws)[i] = 0u;
  if (MODE == 1) { for (int i = tid; i < 16 * LJ; i += 512) VT[64 * LJ + i] = (i < LJ) ? (bf16_t)0x3F80 : (bf16_t)0; }
  f4 accS[STILES];
#pragma unroll
  for (int t = 0; t < STILES; ++t) accS[t] = (f4){0.f, 0.f, 0.f, 0.f};
  float mprev = 0.f;
  u32x4_t rq[NQV], rk[NQV], rv, rt, rp; float ga = 0.f, gla = 0.f, gbt = 0.f;
  rv = rt = rp = (u32x4_t){0u, 0u, 0u, 0u};
#define GLA_LOAD(c) do { const size_t r_ = (size_t)(row0 + (c) * 64 + j) * ldsrc; \
    _Pragma("unroll") for (int q_ = 0; q_ < NQV; ++q_) { rq[q_] = *(const GAS u32x4_t*)(qsrc + r_ + (fv + 8 * q_) * 8); rk[q_] = *(const GAS u32x4_t*)(ksrc + r_ + (fv + 8 * q_) * 8); } \
    if (MODE != 2 || fv < 4) rv = *(const GAS u32x4_t*)(vsrc + r_ + fv * 8); \
    if (MODE == 2) { rt = *(const GAS u32x4_t*)(tsrc + ((size_t)(c) * 64 + j) * 64 + fv * 8); rp = *(const GAS u32x4_t*)(tsrc + (size_t)1024 * 4096 + ((size_t)(c) * 64 + j) * 64 + fv * 8); } \
    } while (0)
#define GLA_GATES(c) do { if (wv == 0) { const GAS float* g_ = gates + (size_t)(row0 + (c) * 64 + lane) * 32; \
      if (MODE == 0) { ga = g_[20 + h]; gla = __logf(g_[16 + h]); } else if (MODE == 1) { ga = g_[12 + h]; gla = g_[8 + h]; } else { ga = g_[h]; gla = 0.f; gbt = g_[4 + h]; } } } while (0)
#define GLA_SCAN(buf) do { if (wv == 0) { LAS float* s_ = scal + (buf) * 320; const float g_ = wave_scan_add(ga, lane); float m_ = 0.f; \
      if (MODE == 1) { const float pm_ = wave_scan_max(gla - g_, lane); m_ = g_ + fmaxf(mprev, pm_); } \
      const float ri_ = g_ - m_, cj_ = g_ - gla + ((MODE == 1) ? 2.0794415416798357f : 0.f), ri63_ = __int_as_float(__builtin_amdgcn_readlane(__float_as_int(ri_), 63)); \
      s_[lane] = ri_; s_[64 + lane] = cj_; s_[128 + lane] = __expf(ri_ + mprev); s_[192 + lane] = __expf(ri63_ - cj_); s_[256 + lane] = (MODE == 2) ? gbt : __expf(-m_); \
      if (MODE == 1) mprev = __int_as_float(__builtin_amdgcn_readlane(__float_as_int(m_), 63)); } } while (0)
#define GLA_STORE(buf) do { const LAS float* s_ = scal + (buf) * 320; const float wj_ = s_[192 + j]; const int pj_ = (((j >> 3) ^ fv) << 3) | (j & 7); \
    _Pragma("unroll") for (int q_ = 0; q_ < NQV; ++q_) { lds_st16(Qs + j * LQ + (fv + 8 * q_) * 8, rq[q_]); lds_st16(Ks + j * LQ + (fv + 8 * q_) * 8, rk[q_]); \
      float f_[8]; unpack8(rk[q_], f_); _Pragma("unroll") for (int e = 0; e < 8; e += 2) { const unsigned pr_ = pk2(f_[e] * wj_, f_[e + 1] * wj_); KwT[((fv + 8 * q_) * 8 + e) * LJ + pj_] = (bf16_t)(pr_ & 0xffffu); KwT[((fv + 8 * q_) * 8 + e + 1) * LJ + pj_] = (bf16_t)(pr_ >> 16); } } \
    if (MODE != 2 || fv < 4) { LAS bf16_t* vt_ = VT + fv * 8 * LJ + pj_; vt_[0] = (bf16_t)(rv.x & 0xffffu); vt_[LJ] = (bf16_t)(rv.x >> 16); vt_[2 * LJ] = (bf16_t)(rv.y & 0xffffu); vt_[3 * LJ] = (bf16_t)(rv.y >> 16); \
      vt_[4 * LJ] = (bf16_t)(rv.z & 0xffffu); vt_[5 * LJ] = (bf16_t)(rv.z >> 16); vt_[6 * LJ] = (bf16_t)(rv.w & 0xffffu); vt_[7 * LJ] = (bf16_t)(rv.w >> 16); } \
    if (MODE == 2) { lds_st16(Ts + j * LJ + fv * 8, rt); lds_st16(Ws + j * LJ + fv * 8, rp); } } while (0)
  GLA_GATES(0); GLA_LOAD(0); GLA_SCAN(0); GLA_GATES(1);
  LDS_BARRIER();
  GLA_STORE(0);
  LDS_BARRIER();
#pragma unroll 1
  for (int c = 0; c < 32; ++c) {
    const LAS float* sc = scal + (c & 1) * 320;
    if (c + 1 < 32) GLA_LOAD(c + 1);
    f4 accO[NVT];
#define GLA_O1() do { if (wv < 4) { _Pragma("unroll") for (int nb = 0; nb < NVT; ++nb) accO[nb] = (f4){0.f, 0.f, 0.f, 0.f}; \
      mma_strip<DQ, NVT, NVT, false, false>(Qs, wv * 16, LQ, ST, 0, LQ, accO, 0, lane); \
      const f4 rs4 = *(const LAS f4*)(sc + 128 + wv * 16 + (lane >> 4) * 4); \
      _Pragma("unroll") for (int nb = 0; nb < NVT; ++nb) accO[nb] *= rs4; } } while (0)
    if (MODE == 2) {
      f4 dA[1];
#pragma unroll
      for (int k = 0; k < 1; ++k) { const int t = wv, jb = t >> 1, nb = t & 1;
        dA[k] = mma_rows<DQ>(Ks + jb * 16 * LQ, LQ, ST + nb * 16 * LQ, LQ, (f4){0.f, 0.f, 0.f, 0.f}, lane); }
#pragma unroll
      for (int k = 0; k < 1; ++k) { const int t = wv, jb = t >> 1, nb = t & 1; const f4 d = dA[k];
        const int dv = nb * 16 + (lane & 15), j0 = jb * 16 + (lane >> 4) * 4;
        const u32x2_t vv = *(const LAS u32x2_t*)(VT + dv * LJ + swz_col(dv, j0));
        const f4 bt4 = *(const LAS f4*)(sc + 256 + j0), eg4 = *(const LAS f4*)(sc + 128 + j0);
        const float v0 = __uint_as_float(vv.x << 16), v1 = __uint_as_float(vv.x & 0xffff0000u), v2 = __uint_as_float(vv.y << 16), v3 = __uint_as_float(vv.y & 0xffff0000u);
        const float r0 = bt4.x * (v0 - eg4.x * d[0]), r1 = bt4.y * (v1 - eg4.y * d[1]), r2 = bt4.z * (v2 - eg4.z * d[2]), r3 = bt4.w * (v3 - eg4.w * d[3]);
        lds_st8(RT + dv * LJ + j0, pk2(r0, r1), pk2(r2, r3)); }
      LDS_BARRIER();
      GLA_O1();
      { const int t0 = (wv < 4 ? 0 : (wv - 4) * 2), nt_ = (wv < 4 ? 0 : 2);
        f4 dB[3];
#pragma unroll
        for (int k = 0; k < 3; ++k) if (k < nt_) { const int t = t0 + k, ib = t >> 1, nb = t & 1;
          dB[k] = mma_rows<64>(Ts + ib * 16 * LJ, LJ, RT + nb * 16 * LJ, LJ, (f4){0.f, 0.f, 0.f, 0.f}, lane); }
#pragma unroll
        for (int k = 0; k < 3; ++k) if (k < nt_) { const int t = t0 + k, ib = t >> 1, nb = t & 1; const f4 d = dB[k];
          lds_st8(VT + (nb * 16 + (lane & 15)) * LJ + swz_col(nb * 16 + (lane & 15), ib * 16 + (lane >> 4) * 4), pk2(d[0], d[1]), pk2(d[2], d[3])); } }
    }
    if (MODE != 2) {
      f4 dW[3];
#pragma unroll
      for (int k = 0; k < 3; ++k) { const int t = wv - 4 + 4 * k;
        if (wv >= 4 && t < 10) { const int ib = (t >= 6) ? 3 : (t >= 3) ? 2 : (t >= 1) ? 1 : 0, jb = t - ib * (ib + 1) / 2;
          dW[k] = mma_rows<DQ>(Ks + jb * 16 * LQ, LQ, Qs + ib * 16 * LQ, LQ, (f4){0.f, 0.f, 0.f, 0.f}, lane); } }
#pragma unroll
      for (int k = 0; k < 3; ++k) { const int t = wv - 4 + 4 * k;
        if (wv >= 4 && t < 10) { const int ib = (t >= 6) ? 3 : (t >= 3) ? 2 : (t >= 1) ? 1 : 0, jb = t - ib * (ib + 1) / 2; const f4 d = dW[k];
          const int i = ib * 16 + (lane & 15), j0 = jb * 16 + (lane >> 4) * 4; const float ri = sc[i];
          const f4 cj4 = *(const LAS f4*)(sc + 64 + j0);
          const float w0 = (j0 <= i) ? d[0] * __expf(ri - cj4.x) : 0.f, w1 = (j0 + 1 <= i) ? d[1] * __expf(ri - cj4.y) : 0.f, w2 = (j0 + 2 <= i) ? d[2] * __expf(ri - cj4.z) : 0.f, w3 = (j0 + 3 <= i) ? d[3] * __expf(ri - cj4.w) : 0.f;
          lds_st8(Ws + i * LJ + j0, pk2(w0, w1), pk2(w2, w3)); } }
    }
    if (MODE != 2) GLA_O1();
    LDS_BARRIER();
    if (wv < 4) {
      mma_strip<64, NVT, NVT, false, true>(Ws, wv * 16, LJ, VT, 0, LJ, accO, 0, lane);
      GAS bf16_t* obase = raw + (size_t)(row0 + c * 64 + wv * 16 + (lane >> 4) * 4) * DM + ocol + (lane & 15);
      float inv[4];
      if (MODE == 1) {
        const f4 em4 = *(const LAS f4*)(sc + 256 + wv * 16 + (lane >> 4) * 4);
#pragma unroll
        for (int r = 0; r < 4; ++r) { const float den = __shfl(accO[NVT - 1][r], lane & 48); inv[r] = __builtin_amdgcn_rcpf(fmaxf(fabsf(den), em4[r])); }
      }
#pragma unroll
      for (int nb = 0; nb < NVR; ++nb)
#pragma unroll
        for (int r = 0; r < 4; ++r) { const float o = (MODE == 1) ? accO[nb][r] * inv[r] : accO[nb][r];
          obase[r * DM + nb * 16] = (bf16_t)(pk2(o, 0.f) & 0xffffu); }
      if (c + 1 < 32) { GLA_SCAN((c + 1) & 1); if (c + 2 < 32) GLA_GATES(c + 2); }
    } else {
      const float cs = sc[128 + 63];
#pragma unroll
      for (int t = 0; t < STILES; ++t) accS[t] *= cs;
#pragma unroll
      for (int qq = 0; qq < STILES / NVT; ++qq)
        mma_strip<64, NVT, STILES, true, true>(KwT, ((wv - 4) * (STILES / NVT) + qq) * 16, LJ, VT, 0, LJ, accS, qq * NVT, lane);
#pragma unroll
      for (int t = 0; t < STILES; ++t) { const int ti = (wv - 4) * STILES + t;
        if (ti < NQT * NVT) { const int qb = ti / NVT, nb = ti - qb * NVT;
          lds_st8(ST + (nb * 16 + (lane & 15)) * LQ + qb * 16 + (lane >> 4) * 4, pk2(accS[t][0], accS[t][1]), pk2(accS[t][2], accS[t][3])); } }
    }
    LDS_BARRIER();
    if (c + 1 < 32) GLA_STORE((c + 1) & 1);
    LDS_BARRIER();
  }
  if (wv >= 4) {
    const size_t bh = ((size_t)l * 8 + b) * 4 + h;
#pragma unroll
    for (int t = 0; t < STILES; ++t) { const int ti = (wv - 4) * STILES + t;
      if (ti < NQT * NVT) { const int qb = ti / NVT, nb = ti - qb * NVT; const int dq = qb * 16 + (lane >> 4) * 4, dv = nb * 16 + (lane & 15);
        if (MODE == 0) *(float4*)(p.out + p.o_pssd + bh * 8192 + (size_t)dv * 128 + dq) = make_float4(accS[t][0], accS[t][1], accS[t][2], accS[t][3]);
        else if (MODE == 1) {
          if (dv < 64) {
#pragma unroll
            for (int r = 0; r < 4; ++r) p.out[p.o_pmc + bh * 4096 + (size_t)(dq + r) * 64 + dv] = accS[t][r];
          } else if (dv == 64) {
#pragma unroll
            for (int r = 0; r < 4; ++r) p.out[p.o_pmn + bh * 64 + dq + r] = accS[t][r];
          }
        } else {
#pragma unroll
          for (int r = 0; r < 4; ++r) p.out[p.o_pgdn + bh * 16384 + (size_t)(dq + r) * 128 + sl * 32 + dv] = accS[t][r];
        } } }
  }
  if (MODE == 1 && tid == 0) p.out[p.o_pmm + ((size_t)l * 8 + b) * 4 + h] = mprev;
#undef GLA_LOAD
#undef GLA_O1
#undef GLA_GATES
#undef GLA_SCAN
#undef GLA_STORE
}

__device__ __forceinline__ void phase_gdnT(const Params& p, int l, LAS unsigned char* ldsb) {
  const int tid = otid(), lane = tid & 63, wv = tid >> 6;
  const bf16_t* convo = (const bf16_t*)(p.ws + p.big + SZ_PROJA + SZ_PROJB);
  const float* gates = (const float*)(p.ws + p.gates);
  bf16_t* Tb = (bf16_t*)(p.ws + p.big); bf16_t* Pb = Tb + (size_t)1024 * 4096;
  if (wv < 4) {
    LAS float* Mw = (LAS float*)ldsb + wv * 4096;
    for (int item = obid() + gridDim.x * wv; item < 1024; item += gridDim.x * 4) {
      const int b = item >> 7, h = (item >> 5) & 3, c = item & 31, row0 = b * 2048 + c * 64;
      const float g = gates[(size_t)(row0 + lane) * 32 + h], beta = gates[(size_t)(row0 + lane) * 32 + 4 + h];
      const bf16_t* kbase = convo + (size_t)(row0 + (lane & 15)) * CONVD + 512 + h * 128 + (lane >> 4) * 8;
      const bf16_t* qbase = kbase - 512;
      bf16_t* pbase = Pb + (size_t)item * 4096 + (lane >> 4) * 256 + (lane & 15);
      bf16_t* tbase = Tb + (size_t)item * 4096 + lane;
      LAS float* mbase = Mw + (lane >> 4) * 256 + (lane & 15);
      const float gam = wave_scan_add(g, lane);
      bf16x8_t kf[4][4];
#pragma unroll
      for (int rb = 0; rb < 4; ++rb)
#pragma unroll
        for (int ks = 0; ks < 4; ++ks) kf[rb][ks] = *(const bf16x8_t*)(kbase + rb * 16 * CONVD + ks * 32);
      LAS float* gtab = (LAS float*)ldsb + 16384 + wv * 128;
      gtab[lane] = gam; gtab[64 + lane] = beta;
      const float gj0 = gtab[lane & 15], gj1 = gtab[16 + (lane & 15)], gj2 = gtab[32 + (lane & 15)], gj3 = gtab[48 + (lane & 15)];
#pragma unroll
      for (int ib = 0; ib < 4; ++ib) {
        float gi[4], bi[4];
#pragma unroll
        for (int r = 0; r < 4; ++r) { gi[r] = gtab[ib * 16 + (lane >> 4) * 4 + r]; bi[r] = gtab[64 + ib * 16 + (lane >> 4) * 4 + r]; }
#pragma unroll
        for (int jb = 0; jb <= ib; ++jb) {
          f4 d = (f4){0.f, 0.f, 0.f, 0.f};
#pragma unroll
          for (int ks = 0; ks < 4; ++ks) d = __builtin_amdgcn_mfma_f32_16x16x32_bf16(kf[ib][ks], kf[jb][ks], d, 0, 0, 0);
          const float gj = jb == 0 ? gj0 : jb == 1 ? gj1 : jb == 2 ? gj2 : gj3; const int jj = jb * 16 + (lane & 15);
#pragma unroll
          for (int r = 0; r < 4; ++r) { const int ii = ib * 16 + (lane >> 4) * 4 + r; mbase[(ib * 16 + r) * 64 + jb * 16] = (jj < ii) ? d[r] * __expf(gi[r] - gj) * bi[r] : 0.f; }
        }
      }
      {
        bf16x8_t qf[4];
#pragma unroll
        for (int ib = 0; ib < 4; ++ib) {
#pragma unroll
          for (int ks = 0; ks < 4; ++ks) qf[ks] = *(const bf16x8_t*)(qbase + ib * 16 * CONVD + ks * 32);
          float gi[4];
#pragma unroll
          for (int r = 0; r < 4; ++r) gi[r] = gtab[ib * 16 + (lane >> 4) * 4 + r];
#pragma unroll
          for (int jb = 0; jb < 4; ++jb) {
            f4 d = (f4){0.f, 0.f, 0.f, 0.f};
#pragma unroll
            for (int ks = 0; ks < 4; ++ks) d = __builtin_amdgcn_mfma_f32_16x16x32_bf16(qf[ks], kf[jb][ks], d, 0, 0, 0);
            const float gj = jb == 0 ? gj0 : jb == 1 ? gj1 : jb == 2 ? gj2 : gj3; const int jj = jb * 16 + (lane & 15);
#pragma unroll
            for (int r = 0; r < 4; ++r) { const int ii = ib * 16 + (lane >> 4) * 4 + r; pbase[(ib * 16 + r) * 64 + jb * 16] = (jj <= ii) ? f2bf(d[r] * __expf(gi[r] - gj)) : (bf16_t)0; }
          }
        }
      }
      float t[64];
#pragma unroll
      for (int i = 0; i < 64; ++i) t[i] = 0.f;
#pragma unroll
      for (int i = 0; i < 64; ++i) {
        float a0 = (i == lane) ? 1.0f : 0.0f, a1 = 0.f;
#pragma unroll
        for (int j4 = 0; j4 < (i + 3) / 4; ++j4) { const f4 m = *(const LAS f4*)(Mw + i * 64 + j4 * 4);
          a0 -= m.x * t[j4 * 4]; a1 -= m.y * t[j4 * 4 + 1]; a0 -= m.z * t[j4 * 4 + 2]; a1 -= m.w * t[j4 * 4 + 3]; }
        t[i] = a0 + a1;
        if ((i & 7) == 7) __builtin_amdgcn_sched_barrier(0);
      }
#pragma unroll
      for (int i = 0; i < 64; ++i) tbase[i * 64] = f2bf(t[i]);
    }
  }
}

__device__ __forceinline__ void gdn_sample(const Params& p, LAS float* lds, int l, int item) {
  const int tid = otid(), w2 = tid >> 7, j = tid & 127;
  const int pair = item * 4 + w2, bs = pair >> 2, h = pair & 3;
  const size_t bh = ((size_t)l * 128 + bs) * 4 + h;
  const float* sin = p.in[3] + bh * 16384; float* sout = p.out + p.o_sgdn + bh * 16384;
  const bf16_t* convo = (const bf16_t*)(p.ws + p.big + SZ_PROJA + SZ_PROJB);
  const float* gates = (const float*)(p.ws + p.gates);
  bf16_t* raw = (bf16_t*)(p.ws + p.hn);
  const int row0 = NPROMPT + bs * 4;
  LAS float* lq = lds + w2 * 1536; LAS float* lk = lq + 512; LAS float* lv = lq + 1024;
  __syncthreads();
#pragma unroll
  for (int t = 0; t < 4; ++t) { const bf16_t* r = convo + (size_t)(row0 + t) * CONVD + h * 128 + j; lq[t * 128 + j] = bf2f(r[0]); lk[t * 128 + j] = bf2f(r[512]); lv[t * 128 + j] = bf2f(r[1024]); }
  float S[128];
#pragma unroll
  for (int d = 0; d < 128; ++d) S[d] = sin[(size_t)d * 128 + j];
  __syncthreads();
#pragma unroll 1
  for (int t = 0; t < 4; ++t) {
    const float* g = gates + (size_t)(row0 + t) * 32;
    const float a = __expf(g[h]), bt = g[4 + h], v = lv[t * 128 + j];
    float pk0 = 0.f, pk1 = 0.f, pq0 = 0.f, pq1 = 0.f, qk0 = 0.f, qk1 = 0.f;
#pragma unroll
    for (int d = 0; d < 128; d += 4) { if ((d & 15) == 0) __builtin_amdgcn_sched_barrier(0); const f4 k4 = *(const LAS f4*)(lk + t * 128 + d), q4 = *(const LAS f4*)(lq + t * 128 + d);
      pk0 += k4.x * S[d]; pk1 += k4.y * S[d + 1]; pk0 += k4.z * S[d + 2]; pk1 += k4.w * S[d + 3];
      pq0 += q4.x * S[d]; pq1 += q4.y * S[d + 1]; pq0 += q4.z * S[d + 2]; pq1 += q4.w * S[d + 3];
      qk0 += q4.x * k4.x; qk1 += q4.y * k4.y; qk0 += q4.z * k4.z; qk1 += q4.w * k4.w; }
    const float r = bt * (v - a * (pk0 + pk1)), o = a * (pq0 + pq1) + (qk0 + qk1) * r;
#pragma unroll
    for (int d = 0; d < 128; d += 4) { if ((d & 15) == 0) __builtin_amdgcn_sched_barrier(0); const f4 k4 = *(const LAS f4*)(lk + t * 128 + d);
      S[d] = a * S[d] + k4.x * r; S[d + 1] = a * S[d + 1] + k4.y * r; S[d + 2] = a * S[d + 2] + k4.z * r; S[d + 3] = a * S[d + 3] + k4.w * r; }
    { unsigned uu = __float_as_uint(o); uu += 0x7FFFu + ((uu >> 16) & 1u); raw[(size_t)(row0 + t) * DM + h * 128 + j] = (bf16_t)(uu >> 16); }
  }
#pragma unroll
  for (int d = 0; d < 128; ++d) sout[(size_t)d * 128 + j] = S[d];
}

__device__ __forceinline__ void mlstm_sample(const Params& p, LAS float* lds, int l, int item) {
  const int tid = otid(), wv = tid >> 6, lane = tid & 63;
  const int pair = item * 8 + wv, bs = pair >> 2, h = pair & 3;
  const size_t bh = ((size_t)l * 128 + bs) * 4 + h;
  const float* cin = p.in[4] + bh * 4096; const float* nin = p.in[5] + bh * 64;
  float* cout = p.out + p.o_smc + bh * 4096; float* nout = p.out + p.o_smn + bh * 64;
  const bf16_t* projB = (const bf16_t*)(p.ws + p.big + SZ_PROJA);
  const float* gates = (const float*)(p.ws + p.gates);
  bf16_t* raw = (bf16_t*)(p.ws + p.hn);
  const int row0 = NPROMPT + bs * 4;
  LAS float* lq = lds + wv * 768; LAS float* lk = lq + 256; LAS float* lv = lq + 512;
  __syncthreads();
#pragma unroll
  for (int t = 0; t < 4; ++t) { const bf16_t* r = projB + (size_t)(row0 + t) * PBLD + h * 64 + lane; lq[t * 64 + lane] = bf2f(r[O_MQ]); lk[t * 64 + lane] = 0.125f * bf2f(r[O_MK]); lv[t * 64 + lane] = bf2f(r[O_MV]); }
  float C[64], n[64];
#pragma unroll
  for (int d = 0; d < 64; ++d) { C[d] = cin[(size_t)d * 64 + lane]; n[d] = nin[d]; }
  float m = p.in[6][bh];
  __syncthreads();
#pragma unroll 1
  for (int t = 0; t < 4; ++t) {
    const float* g = gates + (size_t)(row0 + t) * 32;
    const float li = g[8 + h], lf = g[12 + h], v = lv[t * 64 + lane];
    const float mn = fmaxf(lf + m, li), fp = __expf(lf + m - mn), ip = __expf(li - mn);
    float pc0 = 0.f, pc1 = 0.f, pn0 = 0.f, pn1 = 0.f, qk0 = 0.f, qk1 = 0.f;
#pragma unroll
    for (int d = 0; d < 64; d += 4) { if ((d & 15) == 0) __builtin_amdgcn_sched_barrier(0); const f4 k4 = *(const LAS f4*)(lk + t * 64 + d), q4 = *(const LAS f4*)(lq + t * 64 + d);
      pc0 += q4.x * C[d]; pc1 += q4.y * C[d + 1]; pc0 += q4.z * C[d + 2]; pc1 += q4.w * C[d + 3];
      pn0 += q4.x * n[d]; pn1 += q4.y * n[d + 1]; pn0 += q4.z * n[d + 2]; pn1 += q4.w * n[d + 3];
      qk0 += q4.x * k4.x; qk1 += q4.y * k4.y; qk0 += q4.z * k4.z; qk1 += q4.w * k4.w; }
    const float iqk = ip * (qk0 + qk1), num = fp * (pc0 + pc1) + iqk * v, den = fmaxf(fabsf(fp * (pn0 + pn1) + iqk), __expf(-mn)), iv = ip * v;
#pragma unroll
    for (int d = 0; d < 64; d += 4) { if ((d & 15) == 0) __builtin_amdgcn_sched_barrier(0); const f4 k4 = *(const LAS f4*)(lk + t * 64 + d);
      C[d] = fp * C[d] + iv * k4.x; C[d + 1] = fp * C[d + 1] + iv * k4.y; C[d + 2] = fp * C[d + 2] + iv * k4.z; C[d + 3] = fp * C[d + 3] + iv * k4.w;
      n[d] = fp * n[d] + ip * k4.x; n[d + 1] = fp * n[d + 1] + ip * k4.y; n[d + 2] = fp * n[d + 2] + ip * k4.z; n[d + 3] = fp * n[d + 3] + ip * k4.w; }
    m = mn;
    { unsigned uu = __float_as_uint(num / den); uu += 0x7FFFu + ((uu >> 16) & 1u); raw[(size_t)(row0 + t) * DM + 512 + h * 64 + lane] = (bf16_t)(uu >> 16); }
  }
#pragma unroll
  for (int d = 0; d < 64; ++d) { cout[(size_t)d * 64 + lane] = C[d]; if (lane == 0) nout[d] = n[d]; }
  if (lane == 0) p.out[p.o_smm + bh] = m;
}

__device__ __forceinline__ void ssd_sample(const Params& p, LAS float* lds, int l, int item) {
  const int tid = otid(), wv = tid >> 6, lane = tid & 63;
  const int pair = item * 8 + wv, bs = pair >> 2, h = pair & 3, grp = h >> 1;
  const size_t bh = ((size_t)l * 128 + bs) * 4 + h;
  const float* hin = p.in[7] + bh * 8192 + (size_t)lane * 128; float* hout = p.out + p.o_sssd + bh * 8192 + (size_t)lane * 128;
  const bf16_t* convo = (const bf16_t*)(p.ws + p.big + SZ_PROJA + SZ_PROJB);
  const float* gates = (const float*)(p.ws + p.gates);
  bf16_t* raw = (bf16_t*)(p.ws + p.hn);
  const int row0 = NPROMPT + bs * 4;
  LAS float* lb = lds + wv * 1280; LAS float* lc = lb + 512; LAS float* lx = lb + 1024;
  __syncthreads();
#pragma unroll
  for (int t = 0; t < 4; ++t) { const bf16_t* r = convo + (size_t)(row0 + t) * CONVD;
    lb[t * 128 + lane] = bf2f(r[1792 + grp * 128 + lane]); lb[t * 128 + 64 + lane] = bf2f(r[1792 + grp * 128 + 64 + lane]);
    lc[t * 128 + lane] = bf2f(r[2048 + grp * 128 + lane]); lc[t * 128 + 64 + lane] = bf2f(r[2048 + grp * 128 + 64 + lane]);
    lx[t * 64 + lane] = bf2f(r[1536 + h * 64 + lane]); }
  float H[128];
#pragma unroll
  for (int n = 0; n < 128; n += 4) { const float4 t4 = *(const float4*)(hin + n); H[n] = t4.x; H[n + 1] = t4.y; H[n + 2] = t4.z; H[n + 3] = t4.w; }
  __syncthreads();
#pragma unroll 1
  for (int t = 0; t < 4; ++t) {
    const float* g = gates + (size_t)(row0 + t) * 32;
    const float dt = g[16 + h], dA = __expf(g[20 + h]), x = lx[t * 64 + lane];
    float pc0 = 0.f, pc1 = 0.f, bc0 = 0.f, bc1 = 0.f;
#pragma unroll
    for (int n = 0; n < 128; n += 4) { if ((n & 15) == 0) __builtin_amdgcn_sched_barrier(0); const f4 b4 = *(const LAS f4*)(lb + t * 128 + n), c4 = *(const LAS f4*)(lc + t * 128 + n);
      pc0 += c4.x * H[n]; pc1 += c4.y * H[n + 1]; pc0 += c4.z * H[n + 2]; pc1 += c4.w * H[n + 3];
      bc0 += b4.x * c4.x; bc1 += b4.y * c4.y; bc0 += b4.z * c4.z; bc1 += b4.w * c4.w; }
    const float dtx = dt * x, y = dA * (pc0 + pc1) + dtx * (bc0 + bc1);
#pragma unroll
    for (int n = 0; n < 128; n += 4) { if ((n & 15) == 0) __builtin_amdgcn_sched_barrier(0); const f4 b4 = *(const LAS f4*)(lb + t * 128 + n);
      H[n] = dA * H[n] + dtx * b4.x; H[n + 1] = dA * H[n + 1] + dtx * b4.y; H[n + 2] = dA * H[n + 2] + dtx * b4.z; H[n + 3] = dA * H[n + 3] + dtx * b4.w; }
    { unsigned uu = __float_as_uint(y); uu += 0x7FFFu + ((uu >> 16) & 1u); raw[(size_t)(row0 + t) * DM + 768 + h * 64 + lane] = (bf16_t)(uu >> 16); }
  }
#pragma unroll
  for (int n = 0; n < 128; n += 4) *(float4*)(hout + n) = make_float4(H[n], H[n + 1], H[n + 2], H[n + 3]);
}

__device__ __forceinline__ void phase_mixers(const Params& p, int l, LAS float* lds, int rep = 0) {
  for (int it = obid(); it < 192; it += gridDim.x) {
    if (it < 128) gla_item<2>(p, (LAS unsigned char*)lds, l, it >> 4, (it >> 2) & 3, it & 3);
    else if (it < 160) { const int i = it - 128; gla_item<1>(p, (LAS unsigned char*)lds, l, i >> 2, i & 3, 0); }
    else { const int i = it - 160; gla_item<0>(p, (LAS unsigned char*)lds, l, i >> 2, i & 3, 0); }
  }
  unsigned* ctr = (unsigned*)(p.ws + p.ctr) + l + 2 * rep;
  LAS int* slot = (LAS int*)(lds + 32000);
  for (;;) {
    __syncthreads();
    if (otid() == 0) *slot = (int)atomicAdd(ctr, 1u);
    __syncthreads();
    const int it = *slot;
    if (it >= 256) break;
    if (it < 128) gdn_sample(p, lds, l, it);
    else if (it < 192) mlstm_sample(p, lds, l, it - 128);
    else ssd_sample(p, lds, l, it - 192);
  }
}

__device__ __forceinline__ void phase_mixout(const Params& p, int l) {
  constexpr int NR = 3;
  const bf16_t* projB = (const bf16_t*)(p.ws + p.big + SZ_PROJA);
  const bf16_t* convo = (const bf16_t*)(p.ws + p.big + SZ_PROJA + SZ_PROJB);
  const bf16_t* raw = (const bf16_t*)(p.ws + p.hn);
  bf16_t* mix = (bf16_t*)(p.ws + p.big);
  const int lane = otid() & 63, wv = otid() >> 6, c0 = lane * 16;
  const int W = gridDim.x * 8;
  float wn[2][8]; float dd = 0.f; int auxc;
  if (lane < 32) { load8f(p.in[18] + l * 128 + (c0 & 127), wn[0]); load8f(p.in[18] + l * 128 + (c0 & 127) + 8, wn[1]); auxc = O_GG + c0; }
  else if (lane < 48) { load8f(p.in[21] + l * 64 + (c0 & 63), wn[0]); load8f(p.in[21] + l * 64 + (c0 & 63) + 8, wn[1]); auxc = O_MO + (c0 - 512); }
  else { load8f(p.in[25] + l * 256 + (c0 - 768), wn[0]); load8f(p.in[25] + l * 256 + (c0 - 768) + 8, wn[1]); auxc = O_SZ + (c0 - 768); dd = p.in[24][l * 4 + ((c0 - 768) >> 6)]; }
  uint4 rv[NR][2], ra[NR][2], rx[NR][2], nv[NR][2], na[NR][2], nx[NR][2];
#define MIXO_LOAD(RV, RA, RX, r0_) do { _Pragma("unroll") for (int r = 0; r < NR; ++r) { const int row = (r0_) + r * W; \
      if (row < NTOK) { _Pragma("unroll") for (int j = 0; j < 2; ++j) { RV[r][j] = *(const uint4*)(raw + (size_t)row * DM + c0 + j * 8); RA[r][j] = *(const uint4*)(projB + (size_t)row * PBLD + auxc + j * 8); \
          if (lane >= 48) RX[r][j] = *(const uint4*)(convo + (size_t)row * CONVD + 1536 + (c0 - 768) + j * 8); } } } } while (0)
#pragma unroll
  for (int r = 0; r < NR; ++r)
#pragma unroll
    for (int j = 0; j < 2; ++j) rv[r][j] = ra[r][j] = rx[r][j] = nv[r][j] = na[r][j] = nx[r][j] = make_uint4(0u, 0u, 0u, 0u);
  MIXO_LOAD(rv, ra, rx, obid() * 8 + wv);
  for (int row0 = obid() * 8 + wv; row0 < NTOK; row0 += NR * W) {
    if (row0 + NR * W < NTOK) MIXO_LOAD(nv, na, nx, row0 + NR * W);
#pragma unroll
    for (int r = 0; r < NR; ++r) { const int row = row0 + r * W;
      if (row < NTOK) {
        float v[2][8], g[2][8]; float ss = 0.f;
#pragma unroll
        for (int j = 0; j < 2; ++j) { unpack8(rv[r][j], v[j]); unpack8(ra[r][j], g[j]); }
        if (lane >= 48) {
#pragma unroll
          for (int j = 0; j < 2; ++j) { float x[8]; unpack8(rx[r][j], x);
#pragma unroll
            for (int e = 0; e < 8; ++e) v[j][e] = (v[j][e] + dd * x[e]) * siluf(g[j][e]); }
        } else if (lane >= 32) {
#pragma unroll
          for (int j = 0; j < 2; ++j)
#pragma unroll
            for (int e = 0; e < 8; ++e) v[j][e] *= sigmoidf_(g[j][e]);
        }
#pragma unroll
        for (int j = 0; j < 2; ++j)
#pragma unroll
          for (int e = 0; e < 8; ++e) ss += v[j][e] * v[j][e];
        const float s2 = ss + dppf(ss, 0), s4 = s2 + dppf(s2, 1), s8 = s4 + dppf(s4, 2), s16 = s8 + dppf(s8, 3);
        const float rr = lane < 32 ? rsqrtf(s8 * (1.0f / 128.0f) + EPSF) : (lane < 48 ? rsqrtf(s4 * (1.0f / 64.0f) + EPSF) : rsqrtf(s16 * (1.0f / 256.0f) + EPSF));
        float y[2][8];
#pragma unroll
        for (int j = 0; j < 2; ++j)
#pragma unroll
          for (int e = 0; e < 8; ++e) { y[j][e] = v[j][e] * rr * wn[j][e]; if (lane < 32) y[j][e] *= siluf(g[j][e]); }
        *(uint4*)(mix + (size_t)row * DM + c0) = pack8(y[0]); *(uint4*)(mix + (size_t)row * DM + c0 + 8) = pack8(y[1]);
      } }
#pragma unroll
    for (int r = 0; r < NR; ++r)
#pragma unroll
      for (int j = 0; j < 2; ++j) { rv[r][j] = nv[r][j]; ra[r][j] = na[r][j]; rx[r][j] = nx[r][j]; }
  }
#undef MIXO_LOAD
}

__device__ __forceinline__ void phase_act(const Params& p, int l) {
  const bf16_t* G = (const bf16_t*)(p.ws + p.big);
  bf16_t* V = (bf16_t*)(p.ws + p.big + SZ_GV);
  const float* cw = p.in[28] + (size_t)l * 3 * DFF; const float* cb = p.in[29] + (size_t)l * DFF;
  const int gtid = obid() * 512 + otid(), gstride = gridDim.x * 512;
  if (gtid < 372 * 352) {
    const int c0 = (gtid % 352) * 8;
    float w[3][8], bias[8]; load8f(cb + c0, bias);
#pragma unroll
    for (int j = 0; j < 3; ++j) load8f(cw + j * DFF + c0, w[j]);
    uint4 cur[10], nxt[10];
#pragma unroll
    for (int i = 0; i < 10; ++i) cur[i] = nxt[i] = make_uint4(0u, 0u, 0u, 0u);
#define ACT_LOAD(R, ch) do { const int rb_ = (ch) * 4; const bf16_t* q_ = G + (size_t)rb_ * DFF + c0; const bf16_t* v_ = V + (size_t)rb_ * DFF + c0; \
      _Pragma("unroll") for (int i = 0; i < 4; ++i) { R[2 + i] = *(const uint4*)(q_ + (size_t)i * DFF); R[6 + i] = *(const uint4*)(v_ + (size_t)i * DFF); } \
      if ((rb_ & 2047) > 0) { R[0] = *(const uint4*)(q_ - (size_t)2 * DFF); R[1] = *(const uint4*)(q_ - (size_t)DFF); } } while (0)
    int chunk = gtid / 352;
    ACT_LOAD(cur, chunk);
#pragma unroll 1
    for (; chunk < 4092; chunk += 372) {
      if (chunk + 372 < 4092) ACT_LOAD(nxt, chunk + 372);
      const int rbase = chunk * 4, b = rbase >> 11, pos0 = rbase & 2047;
      float g[6][8];
#pragma unroll
      for (int i = 0; i < 4; ++i) unpack8(cur[2 + i], g[2 + i]);
      if (pos0 > 0) { unpack8(cur[0], g[0]); unpack8(cur[1], g[1]); }
      else {
#pragma unroll
        for (int e = 0; e < 8; ++e) { g[0][e] = 0.f; g[1][e] = 0.f; }
      }
#pragma unroll
      for (int i = 0; i < 4; ++i) {
        float y[8], val[8]; unpack8(cur[6 + i], val);
#pragma unroll
        for (int e = 0; e < 8; ++e) { const float t = bias[e] + w[0][e] * g[i][e] + w[1][e] * g[i + 1][e] + w[2][e] * g[i + 2][e];
          const float uu = 0.7978845608028654f * (t + 0.044715f * t * t * t);
          y[e] = (t - t * __builtin_amdgcn_rcpf(1.0f + __expf(2.0f * uu))) * val[e]; }
        *(uint4*)(V + (size_t)(rbase + i) * DFF + c0) = pack8(y);
        if (pos0 == 2044 && i >= 2) store8f(p.out + p.o_pffn + (((size_t)l * 8 + b) * 2 + (i - 2)) * DFF + c0, g[2 + i]);
      }
#pragma unroll
      for (int i = 0; i < 10; ++i) cur[i] = nxt[i];
    }
#undef ACT_LOAD
  }
  for (int it = 4092 * 352 + gtid; it < (NTOK / 4) * 352; it += gstride) {
    const int chunk = it / 352, c0 = (it - chunk * 352) * 8, rbase = chunk * 4;
    int isp, b, pos0; decode_row(rbase, isp, b, pos0);
    uint4 rg[4], rv[4]; float g[6][8];
#pragma unroll
    for (int i = 0; i < 4; ++i) { rg[i] = *(const uint4*)(G + (size_t)(rbase + i) * DFF + c0); rv[i] = *(const uint4*)(V + (size_t)(rbase + i) * DFF + c0); }
    if (isp) {
      if (pos0 > 0) {
#pragma unroll
        for (int j = 0; j < 2; ++j) unpack8(*(const uint4*)(G + (size_t)(rbase - 2 + j) * DFF + c0), g[j]);
      } else {
#pragma unroll
        for (int j = 0; j < 2; ++j)
#pragma unroll
          for (int e = 0; e < 8; ++e) g[j][e] = 0.f;
      }
    } else {
#pragma unroll
      for (int j = 0; j < 2; ++j) load8f(p.in[8] + (((size_t)l * 128 + b) * 2 + j) * DFF + c0, g[j]);
    }
    float w[3][8], bias[8]; load8f(cb + c0, bias);
#pragma unroll
    for (int j = 0; j < 3; ++j) load8f(cw + j * DFF + c0, w[j]);
#pragma unroll
    for (int i = 0; i < 4; ++i) unpack8(rg[i], g[2 + i]);
    const bool lastc = isp ? (pos0 == 2044) : true;
#pragma unroll
    for (int i = 0; i < 4; ++i) {
      float y[8], val[8]; unpack8(rv[i], val);
#pragma unroll
      for (int e = 0; e < 8; ++e) { const float t = bias[e] + w[0][e] * g[i][e] + w[1][e] * g[i + 1][e] + w[2][e] * g[i + 2][e];
        const float uu = 0.7978845608028654f * (t + 0.044715f * t * t * t);
        y[e] = (t - t * __builtin_amdgcn_rcpf(1.0f + __expf(2.0f * uu))) * val[e]; }
      *(uint4*)(V + (size_t)(rbase + i) * DFF + c0) = pack8(y);
      if (lastc && i >= 2) store8f((isp ? p.out + p.o_pffn + (((size_t)l * 8 + b) * 2 + (i - 2)) * DFF : p.out + p.o_sffn + (((size_t)l * 128 + b) * 2 + (i - 2)) * DFF) + c0, g[2 + i]);
    }
  }
}

#define XB_TMO      128
#define XB_XCNT(j)  (256  + 64 * (j))
#define XB_XSUB(j)  (1280 + 64 * (j))
#define XB_XGEN(j)  (2304 + 64 * (j))
#define XB_TOP      3328
#define XB_TOPGEN   3392
#define XCD_BAR_WORDS 3456
#define XB_SPIN_CAP (1u << 22)
__device__ __forceinline__ unsigned xb_ld(unsigned* q)              { return __hip_atomic_load(q, __ATOMIC_RELAXED, __HIP_MEMORY_SCOPE_AGENT); }
__device__ __forceinline__ unsigned xb_add(unsigned* q, unsigned v) { return __hip_atomic_fetch_add(q, v, __ATOMIC_RELAXED, __HIP_MEMORY_SCOPE_AGENT); }
__device__ __forceinline__ unsigned xb_xcc_id() { return (unsigned)__builtin_amdgcn_s_getreg((3 << 11) | 20) & 0xFu; }
#define XB_SPIN(cond, bar) do { unsigned _sp = 0; while (cond) { __builtin_amdgcn_s_sleep(1); \
    if ((++_sp & 255u) == 0u) { if (xb_ld(&(bar)[XB_TMO])) break; if (_sp > XB_SPIN_CAP) { atomicAdd(&(bar)[XB_TMO], 1u); break; } } } } while (0)
struct XcdBarrier { unsigned* bar; unsigned x; volatile LAS unsigned* st; };
__device__ __forceinline__ XcdBarrier xcd_barrier_post(unsigned* bar, volatile LAS unsigned* st) {
  XcdBarrier b; b.bar = bar; b.x = xb_xcc_id(); b.st = st;
  if (threadIdx.x == 0) (void)xb_add(&bar[XB_XCNT(b.x)], 1u);
  return b;
}
__device__ __forceinline__ void xcd_barrier_complete(unsigned* bar, unsigned x, unsigned& nloc, unsigned& nx) {
  const unsigned G = gridDim.x * gridDim.y * gridDim.z;
  unsigned sum, cnt, mine, sp = 0u;
  for (;;) {
    sum = 0u; cnt = 0u; mine = 0u;
#pragma unroll
    for (unsigned j = 0; j < 16; ++j) { const unsigned c = xb_ld(&bar[XB_XCNT(j)]); sum += c; cnt += (c > 0u) ? 1u : 0u; mine = (j == x) ? c : mine; }
    if (sum == G) break;
    __builtin_amdgcn_s_sleep(1);
    if ((++sp & 255u) == 0u) { if (xb_ld(&bar[XB_TMO])) break; if (sp > XB_SPIN_CAP) { atomicAdd(&bar[XB_TMO], 1u); break; } }
  }
  nloc = mine > 0u ? mine : 1u; nx = cnt > 0u ? cnt : 1u;
}
__device__ __forceinline__ void xcd_barrier(const XcdBarrier& b0, const Params& p) {
  XcdBarrier b; b.st = b0.st; b.bar = (unsigned*)(p.ws + p.ctr) + 64; b.x = b0.st[2];
  asm volatile("s_waitcnt vmcnt(0)" ::: "memory");
  __syncthreads();
  if (threadIdx.x == 0) {
    unsigned* bar = b.bar;
    __builtin_amdgcn_s_waitcnt(0);
    unsigned nloc = b.st[0], nx = b.st[1];
    if (nloc == 0u) { xcd_barrier_complete(bar, b.x, nloc, nx); b.st[0] = nloc; b.st[1] = nx; }
    const unsigned old = xb_add(&bar[XB_XSUB(b.x)], 1u);
    const unsigned gen = old / nloc;
    if (old + 1u == (gen + 1u) * nloc) {
      __builtin_amdgcn_fence(__ATOMIC_RELEASE, "agent");
      asm volatile("s_waitcnt vmcnt(0)" ::: "memory");
      const unsigned og = xb_add(&bar[XB_TOP], 1u);
      const unsigned tg = og / nx;
      if (og + 1u == (tg + 1u) * nx) xb_add(&bar[XB_TOPGEN], 1u);
      else XB_SPIN(xb_ld(&bar[XB_TOPGEN]) == tg, bar);
      __builtin_amdgcn_fence(__ATOMIC_ACQUIRE, "agent");
      xb_add(&bar[XB_XGEN(b.x)], 1u);
      asm volatile("s_waitcnt vmcnt(0)" ::: "memory");
    } else {
      XB_SPIN(xb_ld(&bar[XB_XGEN(b.x)]) == gen, bar);
      __builtin_amdgcn_fence(__ATOMIC_ACQUIRE, "agent");
      asm volatile("s_waitcnt vmcnt(0)" ::: "memory");
    }
  }
  __syncthreads();
}

template <class T> __device__ __forceinline__ T* uni(T* q) {
  const unsigned long long v = (unsigned long long)q;
  const unsigned lo = __builtin_amdgcn_readfirstlane((unsigned)v), hi = __builtin_amdgcn_readfirstlane((unsigned)(v >> 32));
  return (T*)(((unsigned long long)hi << 32) | lo);
}
__global__ void __launch_bounds__(512, 2) mk_forward(Params pk) {
  extern __shared__ __attribute__((aligned(16))) unsigned char shm[];
  cg::grid_group grid = cg::this_grid();
  float* ldsf = (float*)shm;
  Params* lp = (Params*)(shm + 131072);
  volatile LAS unsigned* xst = (volatile LAS unsigned*)((LAS unsigned char*)shm + 131072 + 768);
  if (otid() == 0) { *lp = pk; xst[0] = 0u; xst[1] = 0u; xst[2] = 0u; xst[3] = 0u; }
  __syncthreads();
  const Params& p = *lp;
  XcdBarrier xb = xcd_barrier_post((unsigned*)(pk.ws + pk.ctr) + 64, xst);
  if (otid() == 0) xst[2] = xb.x;
  xb.bar = nullptr; xb.x = 0;
  phase_wconv(p, 0, ldsf);
  phase_rowwise(p, true, nullptr, nullptr, p.in[9], (bf16_t*)(p.ws + p.hn), 0);
  if (gridDim.x == 0x7fffffffu) grid.sync();
  xcd_barrier(xb, p);
#pragma unroll 1
  for (int step = 0; step < 22; ++step) {
    const int l = step / 11, s = step - l * 11;
    if (s == 0 || s == 5 || s == 7 || s == 9) {
      pg8::Gemm g; pg8::EpiSplit e;
      bf16_t* big = (bf16_t*)(p.ws + p.big);
      if (s == 0) { g.A = (const bf16_t*)(p.ws + p.hn); g.Bt = (const bf16_t*)(p.ws + p.w_in); g.M = NTOK; g.N = INCP; g.K = 1024;
        e.O1 = big; e.ld1 = CONVD; e.nt1 = 9; e.O2 = (bf16_t*)(p.ws + p.big + SZ_PROJA); e.ld2 = PBLD; }
      else if (s == 5) { g.A = big; g.Bt = (const bf16_t*)(p.ws + p.w_out); g.M = NTOK; g.N = 1024; g.K = 1024;
        e.O1 = (bf16_t*)(p.ws + p.big + SZ_PROJA + SZ_PROJB); e.ld1 = DM; e.nt1 = 1000; e.O2 = e.O1; e.ld2 = DM; }
      else if (s == 7) { g.A = (const bf16_t*)(p.ws + p.hn); g.Bt = (const bf16_t*)(p.ws + p.w_up); g.M = NTOK; g.N = 5632; g.K = 1024;
        e.O1 = big; e.ld1 = DFF; e.nt1 = 11; e.O2 = (bf16_t*)(p.ws + p.big + SZ_GV); e.ld2 = DFF; }
      else { g.A = (const bf16_t*)(p.ws + p.big + SZ_GV); g.Bt = (const bf16_t*)(p.ws + p.w_dn); g.M = NTOK; g.N = 1024; g.K = DFF;
        e.O1 = (bf16_t*)(p.ws + p.hn); e.ld1 = DM; e.nt1 = 1000; e.O2 = e.O1; e.ld2 = DM; }
      g.ld = g.K; e.F = nullptr;
      const bool split = (s == 5 || s == 9);
      if (split) g.M = NPROMPT;
      g.A = uni(g.A); g.Bt = uni(g.Bt); e.O1 = uni(e.O1); e.O2 = uni(e.O2);
      float* outs = uni((float*)(p.ws + p.big + ((size_t)40 << 20)));
#pragma unroll 1
      for (int pass = 0; pass < (split ? 2 : 1); ++pass) {
        pg8::MkOrder S; S.mode = pass;
        if (pass == 0) S.st.init(g.M, g.N, (int)gridDim.x, (int)obid());
        else { S.sl.init(NTOK - NPROMPT, g.N, g.K, (int)gridDim.x, (int)obid()); g.A += (size_t)NPROMPT * g.ld; g.M = NTOK - NPROMPT; g.K = 256; e.F = outs; }
        pg8::gemm_phase<pg8::EpiSplit, pg8::MkOrder, false>((PG8_LAS unsigned char*)shm, g, S, e, nullptr);
      }
    } else if (s == 1) phase_prep(p, l);
    else if (s == 2) phase_gdnT(p, l, (LAS unsigned char*)shm);
    else if (s == 3) phase_mixers(p, l, (LAS float*)shm);
    else if (s == 4) phase_mixout(p, l);
    else if (s == 6) phase_rowwise(p, l == 0, (const bf16_t*)(p.ws + p.big + SZ_PROJA + SZ_PROJB), p.in[10] + l * DM, p.in[11] + l * DM, (bf16_t*)(p.ws + p.hn), 4);
    else if (s == 8) phase_act(p, l);
    else {
      phase_rowwise(p, false, (const bf16_t*)(p.ws + p.hn), p.in[12] + l * DM, l == 0 ? p.in[9] + DM : nullptr, (bf16_t*)(p.ws + p.hn), 11);
      if (l == 0) phase_wconv(p, 1, ldsf);
    }
    if (step < 21) xcd_barrier(xb, p);
  }
}

extern "C" void kernel_launch(void* const* d_in, const int* in_sizes, int n_in, void* d_out, int out_size, void* d_ws, size_t ws_size, hipStream_t stream) {
  constexpr size_t kDynLds = 131072 + 1024;
  static int grid_blocks = 0;
  if (!grid_blocks) {
    int dev = 0, cus = 0, per_cu = 0;
    (void)hipGetDevice(&dev);
    (void)hipDeviceGetAttribute(&cus, hipDeviceAttributeMultiprocessorCount, dev);
    (void)hipFuncSetAttribute((const void*)mk_forward, hipFuncAttributeMaxDynamicSharedMemorySize, (int)kDynLds);
    (void)hipOccupancyMaxActiveBlocksPerMultiprocessor(&per_cu, mk_forward, 512, kDynLds);
    if (per_cu < 1) per_cu = 1;
    grid_blocks = cus * 1;
  }
  Params p{};
  for (int i = 0; i < 31; ++i) p.in[i] = (const float*)d_in[i];
  p.out = (float*)d_out; p.ws = (unsigned char*)d_ws;
  long o = 0;
  o += 16777216L; p.o_ys = o; o += 524288L;
  p.o_pconv = o; o += 2L * 8 * 3 * 2304; p.o_pgdn = o; o += 2L * 8 * 4 * 16384; p.o_pmc = o; o += 2L * 8 * 4 * 4096; p.o_pmn = o; o += 2L * 8 * 4 * 64;
  p.o_pmm = o; o += 2L * 8 * 4; p.o_pssd = o; o += 2L * 8 * 4 * 8192; p.o_pffn = o; o += 2L * 8 * 2 * 2816;
  p.o_sconv = o; o += 2L * 128 * 3 * 2304; p.o_sgdn = o; o += 2L * 128 * 4 * 16384; p.o_smc = o; o += 2L * 128 * 4 * 4096; p.o_smn = o; o += 2L * 128 * 4 * 64;
  p.o_smm = o; o += 2L * 128 * 4; p.o_sssd = o; o += 2L * 128 * 4 * 8192; p.o_sffn = o; o += 2L * 128 * 2 * 2816;
  size_t w = 0;
  p.w_in = w; w += (size_t)INCP * 1024 * 2; p.w_out = w; w += (size_t)1024 * 1024 * 2; p.w_up = w; w += (size_t)5632 * 1024 * 2; p.w_dn = w; w += (size_t)1024 * DFF * 2;
  p.hn = w; w += (size_t)NTOK * DM * 2; p.gates = w; w += (size_t)NTOK * 32 * 4; p.ctr = w; w += 256 + XCD_BAR_WORDS * 4 + 256; p.big = w; w += SZ_PROJA + SZ_PROJB + SZ_PROJA;
  if (w > ws_size || o != (long)out_size) { fprintf(stderr, "workspace/out size mismatch: need %zu have %zu, out %ld vs %d\n", w, ws_size, o, out_size); return; }
  (void)hipMemsetAsync((unsigned char*)d_ws + p.ctr, 0, 256 + XCD_BAR_WORDS * 4, stream);
  void* args[] = {&p};
  hipError_t e = hipLaunchCooperativeKernel((void*)mk_forward, dim3(grid_blocks), dim3(512), args, kDynLds, stream);
  if (e != hipSuccess) fprintf(stderr, "cooperative launch failed: %s (grid %d)\n", hipGetErrorString(e), grid_blocks);
}
```

```cpp
#include <hip/hip_runtime.h>
#include <hip/hip_cooperative_groups.h>
#include <cstdio>
namespace cg = cooperative_groups;
namespace pg8 {
#define PG8_LAS __attribute__((address_space(3)))
}
__device__ __forceinline__ int otid() { int t = threadIdx.x; asm volatile("" : "+v"(t)); return t; }
__device__ __forceinline__ int obid() { int b = blockIdx.x; asm volatile("" : "+s"(b)); return b; }
namespace pg8 {
typedef unsigned short bf16_t;
typedef short bf16x8 __attribute__((ext_vector_type(8)));
typedef float f32x4 __attribute__((ext_vector_type(4)));
typedef unsigned u32x4 __attribute__((ext_vector_type(4)));
constexpr int BM = 256, BK = 64, HALF = 128, HTB = HALF * BK * 2  , STAGE_BYTES = 8 * HTB, NXCD = 8, WGM = 8;

__host__ __device__ __forceinline__ int lds_byte(int r, int c) { const int st = (r >> 4) * 2 + (c >> 5), rr = r & 15, cc = c & 31, ob = rr * 64 + cc * 2; return st * 1024 + (ob ^ (((ob >> 9) & 1) << 5)); }
__host__ __device__ __forceinline__ void stage_rc(int b, int& R, int& C) { const int st = b / 1024, sb = b % 1024, swz = sb ^ (((sb >> 9) & 1) << 5); R = (st >> 1) * 16 + swz / 64; C = (st & 1) * 32 + (swz % 64) / 2; }
__host__ __device__ __forceinline__ int perm32(int rho) { const int n = rho >> 4, i = rho & 15; return 8 * (i >> 2) + 4 * n + (i & 3); }
struct Unit { int pm, pn, koff; };
struct Gemm { const bf16_t* A; const bf16_t* Bt; int M, N, K, ld; };

struct StaticOrder {
    int nM, nN, nwg, G, c;
    __host__ __device__ void init(int M, int N, int G_, int c_) { nM = M / BM; nN = N / BM; nwg = nM * nN; G = G_; c = c_; }
    __host__ __device__ bool next(int i, Unit& u) const {
        const long L = (long)i * G + c; if (L >= nwg) return false;
        int wgid = (int)L; { const int q = nwg / NXCD, r = nwg % NXCD, xcd = wgid % NXCD, off = wgid / NXCD; wgid = (xcd < r ? xcd * (q + 1) : r * (q + 1) + (xcd - r) * q) + off; }
        const int nig = WGM * nN, gid = wgid / nig, fm = gid * WGM, gsz = (nM - fm) < WGM ? (nM - fm) : WGM;
        u.pm = fm + ((wgid % nig) % gsz); u.pn = (wgid % nig) / gsz; u.koff = 0; return true;
    }
    __device__ __forceinline__ void a_ready(const Unit&) const {}
    __device__ __forceinline__ void done(const Unit&) const {}
};
__device__ __forceinline__ unsigned cvt_pk_bf16(float lo, float hi) { unsigned r; asm volatile("v_cvt_pk_bf16_f32 %0, %1, %2" : "=v"(r) : "v"(lo), "v"(hi)); return r; }
struct SliceOrder {
    int nN, nsl, total, G, c;
    __host__ __device__ void init(int M, int N, int Kfull, int G_, int c_) { nN = N / BM; nsl = Kfull / 256; total = (M / BM) * nN * nsl; G = G_; c = c_; }
    __host__ __device__ bool next(int i, Unit& u) const { const int L = i * G + c; if (L >= total) return false; const int t = L / nsl; u.pm = t / nN; u.pn = t - u.pm * nN; u.koff = (L - t * nsl) * 256; return true; }
    __device__ __forceinline__ void a_ready(const Unit&) const {}
    __device__ __forceinline__ void done(const Unit&) const {}
};
struct MkOrder {
    StaticOrder st; SliceOrder sl; int mode;
    __host__ __device__ bool next(int i, Unit& u) const { return mode ? sl.next(i, u) : st.next(i, u); }
    __device__ __forceinline__ void a_ready(const Unit&) const {}
    __device__ __forceinline__ void done(const Unit&) const {}
};
struct EpiSplit {
    static constexpr bool PERM = true, AFTER_DRAIN = false;
    bf16_t* O1; int ld1; int nt1; bf16_t* O2; int ld2; float* F;
    __device__ __forceinline__ void operator()(const f32x4 (&acc)[2][2][4][2], const Unit& u, int wr, int wc, int fr, int fq) const {
        if (F) {
            const int row0 = u.pm * BM + wr * 64 + fr; const int col0 = u.pn * BM + wc * 32 + 8 * fq;
            float* slab = F + (size_t)(u.koff >> 8) * (512 * 1024);
#pragma unroll
            for (int ai = 0; ai < 2; ++ai)
#pragma unroll
                for (int m = 0; m < 4; ++m) { float* rowp = slab + (size_t)(row0 + ai * HALF + m * 16) * 1024 + col0;
#pragma unroll
                    for (int bj = 0; bj < 2; ++bj)
#pragma unroll
                        for (int n = 0; n < 2; ++n) *(f32x4*)(rowp + bj * HALF + 4 * n) = acc[ai][bj][m][n]; }
            return;
        }
        bf16_t* base; int colt, ld;
        if (u.pn < nt1) { base = O1; colt = u.pn * BM; ld = ld1; } else { base = O2; colt = (u.pn - nt1) * BM; ld = ld2; }
        const int row0 = u.pm * BM + wr * 64 + fr; const int col0 = colt + wc * 32 + 8 * fq;
#pragma unroll
        for (int ai = 0; ai < 2; ++ai)
#pragma unroll
            for (int m = 0; m < 4; ++m) { bf16_t* rowp = base + (size_t)(row0 + ai * HALF + m * 16) * ld + col0;
#pragma unroll
                for (int bj = 0; bj < 2; ++bj) { const f32x4 v0 = acc[ai][bj][m][0], v1 = acc[ai][bj][m][1];
                    u32x4 w; w.x = cvt_pk_bf16(v0[0], v0[1]); w.y = cvt_pk_bf16(v0[2], v0[3]); w.z = cvt_pk_bf16(v1[0], v1[1]); w.w = cvt_pk_bf16(v1[2], v1[3]);
                    *(u32x4*)(rowp + bj * HALF) = w; } }
    }
};
template <class Epi, class Sched, bool STAMP = false>
__device__ __forceinline__ void gemm_phase(PG8_LAS unsigned char* lds, const Gemm g, const Sched& S, const Epi& E, unsigned long long* stamps) {
    const int tid = otid(), wid = __builtin_amdgcn_readfirstlane(tid >> 6), lane = tid & 63, wr = wid >> 2, wc = wid & 3, fr = lane & 15, fq = lane >> 4;
    const int K = g.ld, nt = g.K / BK;
    int ts_lo = 0, ts_hi = 0, nts = 0; const unsigned long long rt_entry = STAMP ? (unsigned long long)wall_clock64() : 0ull;
#define PG8_STAMP() do { if (STAMP && wid == 0 && nts < 64) { const unsigned long long _c = (unsigned long long)clock64(); \
        ts_lo = (lane == nts) ? (int)(unsigned)_c : ts_lo; ts_hi = (lane == nts) ? (int)(unsigned)(_c >> 32) : ts_hi; ++nts; } } while (0)
    PG8_STAMP();
    unsigned voffA[2], voffB[2];
#pragma unroll
    for (int i = 0; i < 2; ++i) { int R, C; stage_rc(tid * 16 + i * 8192, R, C); const int Rb = Epi::PERM ? ((R & ~31) + perm32(R & 31)) : R;
        voffA[i] = (unsigned)(R * K + C) * 2u; voffB[i] = (unsigned)(Rb * K + C) * 2u; }
    const size_t kstep = (size_t)(BK * 2);
    const size_t hstep = (size_t)HALF * K * 2;
    const size_t tstep = 2 * hstep;
    const unsigned ldsw = (unsigned)wid * 1024u;
    const int aoff = lds_byte(wr * 64 + fr, fq * 8), boff = lds_byte(wc * 32 + fr, fq * 8);
#define PG8_SA(b, h) (((b) * 2 + (h)) * HTB)
#define PG8_SB(b, h) ((4 + (b) * 2 + (h)) * HTB)
#define PG8_STAGE(bufoff, gbase, voff) do { _Pragma("unroll") for (int _i = 0; _i < 2; ++_i) \
        __builtin_amdgcn_global_load_lds((const unsigned*)((const char*)(gbase) + (voff)[_i]), (PG8_LAS unsigned*)(lds + (bufoff) + ldsw + _i * 8192), 16, 0, 0); } while (0)
#define PG8_LDA(dst, b, h) do { _Pragma("unroll") for (int m = 0; m < 4; ++m) _Pragma("unroll") for (int k = 0; k < 2; ++k) dst[m][k] = *(const PG8_LAS bf16x8*)(lds + PG8_SA(b, h) + aoff + m * 2048 + k * 1024); } while (0)
#define PG8_LDB(dst, b, h) do { _Pragma("unroll") for (int n = 0; n < 2; ++n) _Pragma("unroll") for (int k = 0; k < 2; ++k) dst[n][k] = *(const PG8_LAS bf16x8*)(lds + PG8_SB(b, h) + boff + n * 2048 + k * 1024); } while (0)
#define PG8_MMA(ai, bj, At, Bt) do { __builtin_amdgcn_s_setprio(1); _Pragma("unroll") for (int m = 0; m < 4; ++m) _Pragma("unroll") for (int n = 0; n < 2; ++n) _Pragma("unroll") for (int k = 0; k < 2; ++k) \
        acc[ai][bj][m][n] = __builtin_amdgcn_mfma_f32_16x16x32_bf16(Bt[n][k], At[m][k], acc[ai][bj][m][n], 0, 0, 0); __builtin_amdgcn_s_setprio(0); } while (0)
#define PG8_WAIT_V(n) asm volatile("s_waitcnt vmcnt(" #n ")" ::: "memory")
#define PG8_WAIT_L(n) asm volatile("s_waitcnt lgkmcnt(" #n ")" ::: "memory")
#define PG8_BAR __builtin_amdgcn_s_barrier()
#define PG8_SCHED __builtin_amdgcn_sched_barrier(0)
    Unit cur, nxt; int ui = 0;
    if (!S.next(0, cur)) return;
    f32x4 acc[2][2][4][2];
#pragma unroll
    for (int a = 0; a < 2; ++a)
#pragma unroll
        for (int b = 0; b < 2; ++b)
#pragma unroll
            for (int m = 0; m < 4; ++m)
#pragma unroll
                for (int n = 0; n < 2; ++n) acc[a][b][m][n] = (f32x4){0.f, 0.f, 0.f, 0.f};
    bf16x8 At[4][2], B0[2][2], B1[2][2];
    const char* cA = (const char*)g.A + (size_t)cur.pm * tstep + (size_t)cur.koff * 2; const char* cB = (const char*)g.Bt + (size_t)cur.pn * tstep + (size_t)cur.koff * 2;
    S.a_ready(cur);
    PG8_STAGE(PG8_SB(0, 0), cB, voffB); PG8_STAGE(PG8_SA(0, 0), cA, voffA); PG8_STAGE(PG8_SB(0, 1), cB + hstep, voffB); PG8_STAGE(PG8_SA(0, 1), cA + hstep, voffA);
    if (wr == 1) PG8_BAR;
    PG8_WAIT_V(4); PG8_BAR;
    PG8_STAGE(PG8_SB(1, 0), cB + kstep, voffB); PG8_STAGE(PG8_SA(1, 0), cA + kstep, voffA); PG8_STAGE(PG8_SB(1, 1), cB + hstep + kstep, voffB);
    PG8_WAIT_V(6); PG8_BAR;
    PG8_STAMP();
    for (;;) {
        const bool has_next = S.next(ui + 1, nxt);
        const char* nA = has_next ? (const char*)g.A + (size_t)nxt.pm * tstep + (size_t)nxt.koff * 2 : cA; const char* nB = has_next ? (const char*)g.Bt + (size_t)nxt.pn * tstep + (size_t)nxt.koff * 2 : cB;
        for (int t = 0; t < nt; t += 2) {
            const bool last = (t == nt - 2);
            const char* a1 = cA + (size_t)(t + 1) * kstep;
            const char* a2 = last ? nA : cA + (size_t)(t + 2) * kstep; const char* b2 = last ? nB : cB + (size_t)(t + 2) * kstep;
            const char* a3 = a2 + kstep; const char* b3 = b2 + kstep;
            if (last && has_next) S.a_ready(nxt);
            PG8_LDB(B0, 0, 0); PG8_SCHED; PG8_LDA(At, 0, 0); PG8_STAGE(PG8_SA(1, 1), a1 + hstep, voffA);
            PG8_WAIT_L(8); PG8_BAR; PG8_WAIT_L(0); PG8_MMA(0, 0, At, B0); PG8_BAR; PG8_SCHED;
            PG8_LDB(B1, 0, 1); PG8_STAGE(PG8_SB(0, 0), b2, voffB);
            PG8_BAR; PG8_WAIT_L(0); PG8_MMA(0, 1, At, B1); PG8_BAR;
            PG8_LDA(At, 0, 1); PG8_STAGE(PG8_SA(0, 0), a2, voffA);
            PG8_BAR; PG8_WAIT_L(0); PG8_MMA(1, 0, At, B0); PG8_BAR; PG8_SCHED;
            PG8_STAGE(PG8_SB(0, 1), b2 + hstep, voffB);
            PG8_WAIT_V(6); PG8_BAR; PG8_MMA(1, 1, At, B1); PG8_BAR;
            PG8_LDB(B0, 1, 0); PG8_SCHED; PG8_LDA(At, 1, 0); PG8_STAGE(PG8_SA(0, 1), a2 + hstep, voffA);
            PG8_WAIT_L(8); PG8_BAR; PG8_WAIT_L(0); PG8_MMA(0, 0, At, B0); PG8_BAR; PG8_SCHED;
            PG8_LDB(B1, 1, 1); PG8_STAGE(PG8_SB(1, 0), b3, voffB);
            PG8_BAR; PG8_WAIT_L(0); PG8_MMA(0, 1, At, B1); PG8_BAR;
            PG8_LDA(At, 1, 1); PG8_STAGE(PG8_SA(1, 0), a3, voffA);
            PG8_BAR; PG8_WAIT_L(0); PG8_MMA(1, 0, At, B0); PG8_BAR; PG8_SCHED;
            PG8_STAGE(PG8_SB(1, 1), b3 + hstep, voffB);
            PG8_WAIT_V(6); PG8_BAR; PG8_MMA(1, 1, At, B1); PG8_BAR;
        }
        PG8_STAMP();
        if constexpr (!Epi::AFTER_DRAIN) { E(acc, cur, wr, wc, fr, fq); S.done(cur); }
        PG8_STAMP();
        if (!has_next) break;
#pragma unroll
        for (int a = 0; a < 2; ++a)
#pragma unroll
            for (int b = 0; b < 2; ++b)
#pragma unroll
                for (int m = 0; m < 4; ++m)
#pragma unroll
                    for (int n = 0; n < 2; ++n) acc[a][b][m][n] = (f32x4){0.f, 0.f, 0.f, 0.f};
        cur = nxt; cA = nA; cB = nB; ++ui;
    }
    PG8_WAIT_V(0);
    if (wr == 0) PG8_BAR;
    PG8_BAR;
    if constexpr (Epi::AFTER_DRAIN) { E.fused(acc, cur, wr, wc, fr, fq, lds, wid, lane); S.done(cur); }
    PG8_STAMP();
    if (STAMP && wid == 0) { stamps[lane] = lane < nts ? (((unsigned long long)(unsigned)ts_hi << 32) | (unsigned)ts_lo) : 0ull;
        if (lane == 62) stamps[62] = rt_entry; if (lane == 63) stamps[63] = (unsigned long long)wall_clock64(); }
#undef PG8_STAMP
#undef PG8_SA
#undef PG8_SB
#undef PG8_STAGE
#undef PG8_LDA
#undef PG8_LDB
#undef PG8_MMA
#undef PG8_WAIT_V
#undef PG8_WAIT_L
#undef PG8_BAR
#undef PG8_SCHED
}
}
using pg8::bf16_t;

constexpr int NTOK = 16896, NPROMPT = 16384, DM = 1024, CONVD = 2304, INC = 4116, INCP = 4352, PBLD = 2048, DFF = 2816;
constexpr int O_GG = 0, O_MQ = 520, O_MK = 776, O_MV = 1032, O_MO = 1288, O_MI = 1544, O_MF = 1548, O_SZ = 1552, O_SDT = 1808, O_GA = 512, O_GB = 516;
constexpr float EPSF = 1e-6f;

struct Params {
  const float* in[31];
  float* out;
  unsigned char* ws;
  long o_ys, o_pconv, o_pgdn, o_pmc, o_pmn, o_pmm, o_pssd, o_pffn, o_sconv, o_sgdn, o_smc, o_smn, o_smm, o_sssd, o_sffn;
  size_t w_in, w_out, w_up, w_dn, hn, gates, ctr, big;
};
constexpr size_t SZ_PROJA = (size_t)NTOK * CONVD * 2, SZ_PROJB = (size_t)NTOK * PBLD * 2, SZ_GV = (size_t)NTOK * DFF * 2;

typedef __bf16 bf16x2_n __attribute__((ext_vector_type(2)));
__device__ __forceinline__ unsigned pk2(float a, float b) { bf16x2_n v = {(__bf16)a, (__bf16)b}; return __builtin_bit_cast(unsigned, v); }
__device__ __forceinline__ float bf2f(unsigned short b) { return __uint_as_float((unsigned)b << 16); }
__device__ __forceinline__ void unpack8(const uint4 u, float (&f)[8]) {
  f[0] = __uint_as_float(u.x << 16); f[1] = __uint_as_float(u.x & 0xffff0000u);
  f[2] = __uint_as_float(u.y << 16); f[3] = __uint_as_float(u.y & 0xffff0000u);
  f[4] = __uint_as_float(u.z << 16); f[5] = __uint_as_float(u.z & 0xffff0000u);
  f[6] = __uint_as_float(u.w << 16); f[7] = __uint_as_float(u.w & 0xffff0000u);
}
__device__ __forceinline__ uint4 pack8(const float (&f)[8]) {
  uint4 r; r.x = pk2(f[0], f[1]); r.y = pk2(f[2], f[3]); r.z = pk2(f[4], f[5]); r.w = pk2(f[6], f[7]); return r;
}
__device__ __forceinline__ void load8f(const float* p, float (&f)[8]) {
  const float4 a = *(const float4*)p, b = *(const float4*)(p + 4);
  f[0] = a.x; f[1] = a.y; f[2] = a.z; f[3] = a.w; f[4] = b.x; f[5] = b.y; f[6] = b.z; f[7] = b.w;
}
__device__ __forceinline__ void store8f(float* p, const float (&f)[8]) {
  *(float4*)p = make_float4(f[0], f[1], f[2], f[3]); *(float4*)(p + 4) = make_float4(f[4], f[5], f[6], f[7]);
}
__device__ __forceinline__ float siluf(float x) { return x * __builtin_amdgcn_rcpf(1.0f + __expf(-x)); }
__device__ __forceinline__ float sigmoidf_(float x) { return __builtin_amdgcn_rcpf(1.0f + __expf(-x)); }
__device__ __forceinline__ float softplusf_(float x) { return x > 20.0f ? x : log1pf(expf(x)); }
__device__ __forceinline__ float dppf(float x, const int ctrl_sel) {
  int v = __float_as_int(x), r;
  if (ctrl_sel == 0) r = __builtin_amdgcn_update_dpp(0, v, 0xB1, 0xf, 0xf, true);
  else if (ctrl_sel == 1) r = __builtin_amdgcn_update_dpp(0, v, 0x4E, 0xf, 0xf, true);
  else if (ctrl_sel == 2) r = __builtin_amdgcn_update_dpp(0, v, 0x141, 0xf, 0xf, true);
  else r = __builtin_amdgcn_update_dpp(0, v, 0x140, 0xf, 0xf, true);
  return __int_as_float(r);
}
__device__ __forceinline__ float sum8(float x) { x += dppf(x, 0); x += dppf(x, 1); x += dppf(x, 2); return x; }
__device__ __forceinline__ float sum16(float x) { x += dppf(x, 0); x += dppf(x, 1); x += dppf(x, 2); x += dppf(x, 3); return x; }
__device__ __forceinline__ float wave_sum(float x) {
  x = sum16(x);
  const int v = __float_as_int(x);
  return __int_as_float(__builtin_amdgcn_readlane(v, 0)) + __int_as_float(__builtin_amdgcn_readlane(v, 16)) + (__int_as_float(__builtin_amdgcn_readlane(v, 32)) + __int_as_float(__builtin_amdgcn_readlane(v, 48)));
}
__device__ __forceinline__ void decode_row(int row, int& isp, int& b, int& pos) {
  if (row < NPROMPT) { isp = 1; b = row >> 11; pos = row & 2047; } else { isp = 0; const int r = row - NPROMPT; b = r >> 2; pos = r & 3; }
}

__device__ __forceinline__ void phase_wconv(const Params& p, int l, float* tile) {
  const int tid = otid();
  const int T0 = 16 * 68 / 4, T1 = T0 + 16 * 16 / 4, T2 = T1 + 16 * 88 / 4, T3 = T2 + 44 * 16 / 4;
  for (int t = obid(); t < T3; t += gridDim.x) {
    const float* src; bf16_t* dst; int K, N, nk, tt;
    if (t < T0) { src = p.in[13] + (size_t)l * 1024 * INC; dst = (bf16_t*)(p.ws + p.w_in); K = 1024; N = INC; nk = 4; tt = t; }
    else if (t < T1) { src = p.in[26] + (size_t)l * 1024 * 1024; dst = (bf16_t*)(p.ws + p.w_out); K = 1024; N = 1024; nk = 4; tt = t - T0; }
    else if (t < T2) { src = p.in[27] + (size_t)l * 1024 * 5632; dst = (bf16_t*)(p.ws + p.w_up); K = 1024; N = 5632; nk = 4; tt = t - T1; }
    else { src = p.in[30] + (size_t)l * DFF * 1024; dst = (bf16_t*)(p.ws + p.w_dn); K = DFF; N = 1024; nk = 11; tt = t - T2; }
    const int k0 = (tt % nk) * 256, n0 = (tt / nk) * 64;
    float v[32];
    { const int nn = tid & 63; const bool ok = n0 + nn < N; const float* sp = src + (size_t)(k0 + (tid >> 6)) * N + n0 + nn;
#pragma unroll
      for (int i = 0; i < 32; ++i) v[i] = ok ? sp[(size_t)(8 * i) * N] : 0.0f;
#pragma unroll
      for (int i = 0; i < 32; ++i) tile[nn * 257 + (tid >> 6) + 8 * i] = v[i]; }
    __syncthreads();
    { const int kp = tid & 127;
#pragma unroll
      for (int i = 0; i < 16; ++i) { const int nn = (tid >> 7) + 4 * i;
        *(unsigned*)(dst + (size_t)(n0 + nn) * K + k0 + 2 * kp) = pk2(tile[nn * 257 + 2 * kp], tile[nn * 257 + 2 * kp + 1]); } }
    __syncthreads();
  }
}

__device__ __forceinline__ void rw_row(const Params& p, int row, float (&x)[2][8], const float (&o)[2][8], bool hasadd, bool hasnorm, const float (&wa)[2][8], const float (&wn)[2][8], bf16_t* hn, int lane) {
  float* xr = p.out + (size_t)row * DM;
  if (hasadd) {
    float ss = 0.f;
#pragma unroll
    for (int j = 0; j < 2; ++j)
#pragma unroll
      for (int e = 0; e < 8; ++e) ss += o[j][e] * o[j][e];
    ss = wave_sum(ss); const float rr = rsqrtf(ss * (1.0f / DM) + EPSF);
#pragma unroll
    for (int j = 0; j < 2; ++j)
#pragma unroll
      for (int e = 0; e < 8; ++e) x[j][e] += o[j][e] * rr * wa[j][e];
    if (hasnorm) {
#pragma unroll
      for (int j = 0; j < 2; ++j) *(uint4*)((bf16_t*)xr + DM + j * 512 + lane * 8) = pack8(x[j]);
    } else {
#pragma unroll
      for (int j = 0; j < 2; ++j) store8f(xr + j * 512 + lane * 8, x[j]);
    }
  }
  if (hasnorm) {
    float ss = 0.f;
#pragma unroll
    for (int j = 0; j < 2; ++j)
#pragma unroll
      for (int e = 0; e < 8; ++e) ss += x[j][e] * x[j][e];
    ss = wave_sum(ss); const float rr = rsqrtf(ss * (1.0f / DM) + EPSF);
#pragma unroll
    for (int j = 0; j < 2; ++j) { float y[8];
#pragma unroll
      for (int e = 0; e < 8; ++e) y[e] = x[j][e] * rr * wn[j][e];
      *(uint4*)(hn + (size_t)row * DM + j * 512 + lane * 8) = pack8(y); }
  }
}
__device__ __forceinline__ void phase_rowwise(const Params& p, bool first, const bf16_t* add, const float* w_add, const float* w_norm, bf16_t* hn, int nsl) {
  constexpr int NR = 2;
  const int lane = otid() & 63, wv = otid() >> 6;
  const int W = gridDim.x * 8, gw = obid() * 8 + wv;
  const bool hasadd = add != nullptr, hasnorm = w_norm != nullptr;
  float wa[2][8], wn[2][8];
#pragma unroll
  for (int j = 0; j < 2; ++j) {
    if (hasadd) load8f(w_add + j * 512 + lane * 8, wa[j]);
    if (hasnorm) load8f(w_norm + j * 512 + lane * 8, wn[j]);
  }
  uint4 cx[NR][4], co[NR][2], nx[NR][4], no[NR][2];
#pragma unroll
  for (int r = 0; r < NR; ++r) { cx[r][0] = cx[r][1] = cx[r][2] = cx[r][3] = co[r][0] = co[r][1] = make_uint4(0u, 0u, 0u, 0u); nx[r][0] = nx[r][1] = nx[r][2] = nx[r][3] = no[r][0] = no[r][1] = make_uint4(0u, 0u, 0u, 0u); }
#define RW_LOAD(X, O, r0_) do { _Pragma("unroll") for (int r = 0; r < NR; ++r) { const int row = (r0_) + r * W; \
      if (row < NPROMPT) { \
        if (first) { const float* xi = p.in[0] + (size_t)row * DM + lane * 8; X[r][0] = *(const uint4*)xi; X[r][1] = *(const uint4*)(xi + 4); X[r][2] = *(const uint4*)(xi + 512); X[r][3] = *(const uint4*)(xi + 516); } \
        else { const bf16_t* xb = (const bf16_t*)(p.out + (size_t)row * DM) + DM + lane * 8; X[r][0] = *(const uint4*)xb; X[r][2] = *(const uint4*)(xb + 512); } \
        if (hasadd) { O[r][0] = *(const uint4*)(add + (size_t)row * DM + lane * 8); O[r][1] = *(const uint4*)(add + (size_t)row * DM + 512 + lane * 8); } } } } while (0)
  RW_LOAD(cx, co, gw);
  for (int row0 = gw; row0 < NPROMPT; row0 += NR * W) {
    if (row0 + NR * W < NPROMPT) RW_LOAD(nx, no, row0 + NR * W);
#pragma unroll
    for (int r = 0; r < NR; ++r) { const int row = row0 + r * W;
      if (row < NPROMPT) {
        float x[2][8], o[2][8];
#pragma unroll
        for (int j = 0; j < 2; ++j) {
          if (first) { x[j][0] = __uint_as_float(cx[r][2 * j].x); x[j][1] = __uint_as_float(cx[r][2 * j].y); x[j][2] = __uint_as_float(cx[r][2 * j].z); x[j][3] = __uint_as_float(cx[r][2 * j].w);
            x[j][4] = __uint_as_float(cx[r][2 * j + 1].x); x[j][5] = __uint_as_float(cx[r][2 * j + 1].y); x[j][6] = __uint_as_float(cx[r][2 * j + 1].z); x[j][7] = __uint_as_float(cx[r][2 * j + 1].w); }
          else unpack8(cx[r][2 * j], x[j]);
          if (hasadd) unpack8(co[r][j], o[j]);
        }
        rw_row(p, row, x, o, hasadd, hasnorm, wa, wn, hn, lane);
      } }
#pragma unroll
    for (int r = 0; r < NR; ++r) { cx[r][0] = nx[r][0]; cx[r][1] = nx[r][1]; cx[r][2] = nx[r][2]; cx[r][3] = nx[r][3]; co[r][0] = no[r][0]; co[r][1] = no[r][1]; }
  }
#undef RW_LOAD
  for (int row = NPROMPT + gw; row < NTOK; row += W) {
    float x[2][8], o[2][8];
#pragma unroll
    for (int j = 0; j < 2; ++j) {
      if (first) load8f(p.in[1] + (size_t)(row - NPROMPT) * DM + j * 512 + lane * 8, x[j]);
      else unpack8(*(const uint4*)((const bf16_t*)(p.out + (size_t)row * DM) + DM + j * 512 + lane * 8), x[j]);
      if (hasadd) { const float* of = (const float*)(p.ws + p.big + ((size_t)40 << 20)) + (size_t)(row - NPROMPT) * DM + j * 512 + lane * 8; load8f(of, o[j]);
        for (int ks = 1; ks < nsl; ++ks) { float t8[8]; load8f(of + (size_t)ks * (512 * 1024), t8);
#pragma unroll
          for (int e = 0; e < 8; ++e) o[j][e] += t8[e]; } }
    }
    rw_row(p, row, x, o, hasadd, hasnorm, wa, wn, hn, lane);
  }
}

__device__ __forceinline__ void phase_prep(const Params& p, int l) {
  const bf16_t* projA = (const bf16_t*)(p.ws + p.big);
  const bf16_t* projB = (const bf16_t*)(p.ws + p.big + SZ_PROJA);
  bf16_t* convo = (bf16_t*)(p.ws + p.big + SZ_PROJA + SZ_PROJB);
  float* gates = (float*)(p.ws + p.gates);
  const float* cw = p.in[14] + (size_t)l * 4 * CONVD; const float* cb = p.in[15] + (size_t)l * CONVD;
  const int gtid = obid() * 512 + otid(), gstride = gridDim.x * 512;
  if (gtid < 455 * 288) {
    const int v = gtid % 288, c0 = v * 8;
    float w[4][8], bias[8]; load8f(cb + c0, bias);
#pragma unroll
    for (int j = 0; j < 4; ++j) load8f(cw + j * CONVD + c0, w[j]);
    uint4 cur[7], nxt[7];
#pragma unroll
    for (int i = 0; i < 7; ++i) cur[i] = nxt[i] = make_uint4(0u, 0u, 0u, 0u);
#define PREP_LOAD(R, ch) do { const int rb_ = (ch) * 4; const bf16_t* q_ = projA + (size_t)rb_ * CONVD + c0; \
      _Pragma("unroll") for (int i = 0; i < 4; ++i) R[3 + i] = *(const uint4*)(q_ + (size_t)i * CONVD); \
      if ((rb_ & 2047) > 0) { _Pragma("unroll") for (int j = 0; j < 3; ++j) R[j] = *(const uint4*)(q_ - (size_t)(3 - j) * CONVD); } } while (0)
    int chunk = gtid / 288;
    PREP_LOAD(cur, chunk);
#pragma unroll 1
    for (; chunk < 4095; chunk += 455) {
      if (chunk + 455 < 4095) PREP_LOAD(nxt, chunk + 455);
      const int rbase = chunk * 4, b = rbase >> 11, pos0 = rbase & 2047;
      float xp[7][8];
#pragma unroll
      for (int i = 0; i < 4; ++i) unpack8(cur[3 + i], xp[3 + i]);
      if (pos0 > 0) {
#pragma unroll
        for (int j = 0; j < 3; ++j) unpack8(cur[j], xp[j]);
      } else {
#pragma unroll
        for (int j = 0; j < 3; ++j)
#pragma unroll
          for (int e = 0; e < 8; ++e) xp[j][e] = 0.f;
      }
#pragma unroll
      for (int i = 0; i < 4; ++i) {
        float y[8];
#pragma unroll
        for (int e = 0; e < 8; ++e) y[e] = siluf(bias[e] + w[0][e] * xp[i][e] + w[1][e] * xp[i + 1][e] + w[2][e] * xp[i + 2][e] + w[3][e] * xp[i + 3][e]);
        if (c0 < 1024) {
          float ss = 0.f;
#pragma unroll
          for (int e = 0; e < 8; ++e) ss += y[e] * y[e];
          ss = sum16(ss);
          const float sc = rsqrtf(ss + EPSF) * (c0 < 512 ? 0.08838834764831845f : 1.0f);
#pragma unroll
          for (int e = 0; e < 8; ++e) y[e] *= sc;
        }
        *(uint4*)(convo + (size_t)(rbase + i) * CONVD + c0) = pack8(y);
        if (pos0 == 2044 && i >= 1) store8f(p.out + p.o_pconv + (((size_t)l * 8 + b) * 3 + (i - 1)) * CONVD + c0, xp[3 + i]);
      }
#pragma unroll
      for (int i = 0; i < 7; ++i) cur[i] = nxt[i];
    }
#undef PREP_LOAD
  }
  for (int it = 4095 * 288 + gtid; it < (NTOK / 4) * 288; it += gstride) {
    const int chunk = it / 288, v = it - chunk * 288, c0 = v * 8, rbase = chunk * 4;
    int isp, b, pos0; decode_row(rbase, isp, b, pos0);
    uint4 rw[4]; float xp[7][8];
#pragma unroll
    for (int i = 0; i < 4; ++i) rw[i] = *(const uint4*)(projA + (size_t)(rbase + i) * CONVD + c0);
    if (isp) {
      if (pos0 > 0) {
#pragma unroll
        for (int j = 0; j < 3; ++j) unpack8(*(const uint4*)(projA + (size_t)(rbase - 3 + j) * CONVD + c0), xp[j]);
      } else {
#pragma unroll
        for (int j = 0; j < 3; ++j)
#pragma unroll
          for (int e = 0; e < 8; ++e) xp[j][e] = 0.f;
      }
    } else {
#pragma unroll
      for (int j = 0; j < 3; ++j) load8f(p.in[2] + (((size_t)l * 128 + b) * 3 + j) * CONVD + c0, xp[j]);
    }
    float w[4][8], bias[8]; load8f(cb + c0, bias);
#pragma unroll
    for (int j = 0; j < 4; ++j) load8f(cw + j * CONVD + c0, w[j]);
#pragma unroll
    for (int i = 0; i < 4; ++i) unpack8(rw[i], xp[3 + i]);
    const bool lastc = isp ? (pos0 == 2044) : true;
#pragma unroll
    for (int i = 0; i < 4; ++i) {
      float y[8];
#pragma unroll
      for (int e = 0; e < 8; ++e) y[e] = siluf(bias[e] + w[0][e] * xp[i][e] + w[1][e] * xp[i + 1][e] + w[2][e] * xp[i + 2][e] + w[3][e] * xp[i + 3][e]);
      if (c0 < 1024) {
        float ss = 0.f;
#pragma unroll
        for (int e = 0; e < 8; ++e) ss += y[e] * y[e];
        ss = sum16(ss);
        const float sc = rsqrtf(ss + EPSF) * (c0 < 512 ? 0.08838834764831845f : 1.0f);
#pragma unroll
        for (int e = 0; e < 8; ++e) y[e] *= sc;
      }
      *(uint4*)(convo + (size_t)(rbase + i) * CONVD + c0) = pack8(y);
      if (lastc && i >= 1) store8f((isp ? p.out + p.o_pconv + (((size_t)l * 8 + b) * 3 + (i - 1)) * CONVD : p.out + p.o_sconv + (((size_t)l * 128 + b) * 3 + (i - 1)) * CONVD) + c0, xp[3 + i]);
    }
  }
  for (int i = (gtid >= 129 * 288 ? gtid - 129 * 288 : gtid - 129 * 288 + gstride); i < NTOK * 4; i += gstride) {
    const int row = i >> 2, h = i & 3;
    const bf16_t* pb = projB + (size_t)row * PBLD;
    const float ga = bf2f(pb[O_GA + h]), gb = bf2f(pb[O_GB + h]), mi = bf2f(pb[O_MI + h]), mf = bf2f(pb[O_MF + h]), sdt = bf2f(pb[O_SDT + h]);
    float* g = gates + (size_t)row * 32;
    g[h] = -expf(p.in[16][l * 4 + h]) * softplusf_(ga + p.in[17][l * 4 + h]);
    g[4 + h] = sigmoidf_(gb);
    g[8 + h] = mi + p.in[19][l * 4 + h];
    g[12 + h] = -softplusf_(-(mf + p.in[20][l * 4 + h]));
    const float dt = softplusf_(sdt + p.in[23][l * 4 + h]);
    g[16 + h] = dt;
    g[20 + h] = dt * (-expf(p.in[22][l * 4 + h]));
  }
}

typedef float f2 __attribute__((ext_vector_type(2)));
typedef float f4 __attribute__((ext_vector_type(4)));
#define LAS __attribute__((address_space(3)))
constexpr int TC = 32;
__device__ __forceinline__ void lds_store8(LAS float* q, const float (&f)[8]) { *(LAS f4*)q = (f4){f[0], f[1], f[2], f[3]}; *(LAS f4*)(q + 4) = (f4){f[4], f[5], f[6], f[7]}; }
__device__ __forceinline__ float hsum(f2 a) { return a.x + a.y; }

__device__ __forceinline__ void gdn_item(const Params& p, LAS float* lds, int row0, int T, int h, int sl, float* sout) {
  const int tid = otid(), cl = tid >> 4, s = tid & 15, col = sl * 32 + cl;
  const bf16_t* convo = (const bf16_t*)(p.ws + p.big + SZ_PROJA + SZ_PROJB);
  const float* gates = (const float*)(p.ws + p.gates);
  bf16_t* raw = (bf16_t*)(p.ws + p.hn);
  constexpr int BUF = 9344;
  LAS float* obuf = lds + 2 * BUF;
  f2 S[4];
#pragma unroll
  for (int i = 0; i < 4; ++i) S[i] = (f2){0.f, 0.f};
  const int nch = T / TC;
  uint4 rq, rk, rv; float ra = 0.f, rb = 0.f;
  rq = rk = rv = make_uint4(0, 0, 0, 0);
  const int tt = tid >> 4, cv = tid & 15;
#define GDN_LOAD(c) do { { const bf16_t* r_ = convo + (size_t)(row0 + (c) * TC + tt) * CONVD + h * 128 + cv * 8; rq = *(const uint4*)r_; rk = *(const uint4*)(r_ + 512); } \
    if (tid < 128) rv = *(const uint4*)(convo + (size_t)(row0 + (c) * TC + (tid >> 2)) * CONVD + 1024 + h * 128 + sl * 32 + (tid & 3) * 8); \
    else if (tid < 160) { const float* g_ = gates + (size_t)(row0 + (c) * TC + (tid - 128)) * 32; ra = __expf(g_[h]); rb = g_[4 + h]; } } while (0)
#define GDN_STORE(buf) do { float fq_[8], fk_[8]; unpack8(rq, fq_); unpack8(rk, fk_); lds_store8((buf) + tt * 128 + cv * 8, fq_); lds_store8((buf) + 4096 + tt * 128 + cv * 8, fk_); \
    float d_ = 0.f; _Pragma("unroll") for (int e = 0; e < 8; ++e) d_ += fq_[e] * fk_[e]; d_ = sum16(d_); if (cv == 0) (buf)[9216 + tt * 4 + 2] = d_; \
    if (tid < 128) { unpack8(rv, fq_); lds_store8((buf) + 8192 + (tid >> 2) * 32 + (tid & 3) * 8, fq_); } \
    else if (tid < 160) { (buf)[9216 + (tid - 128) * 4] = ra; (buf)[9216 + (tid - 128) * 4 + 1] = rb; } } while (0)
  __syncthreads();
  GDN_LOAD(0); GDN_STORE(lds); __syncthreads();
  for (int c = 0; c < nch; ++c) {
    const LAS float* buf = lds + (c & 1) * BUF;
    if (c + 1 < nch) GDN_LOAD(c + 1);
    f4 kA_l, kA_h, qA_l, qA_h, scA, kB_l, kB_h, qB_l, qB_h, scB; float vA, vB;
#define GDN_FETCH(X, t) do { const int t_ = (t); k##X##_l = *(const LAS f4*)(buf + 4096 + t_ * 128 + 8 * s); k##X##_h = *(const LAS f4*)(buf + 4096 + t_ * 128 + 8 * s + 4); \
      q##X##_l = *(const LAS f4*)(buf + t_ * 128 + 8 * s); q##X##_h = *(const LAS f4*)(buf + t_ * 128 + 8 * s + 4); v##X = buf[8192 + t_ * 32 + cl]; sc##X = *(const LAS f4*)(buf + 9216 + t_ * 4); } while (0)
#define GDN_STEP(X, t) do { const f2 k0 = {k##X##_l.x, k##X##_l.y}, k1 = {k##X##_l.z, k##X##_l.w}, k2 = {k##X##_h.x, k##X##_h.y}, k3 = {k##X##_h.z, k##X##_h.w}; \
      const f2 q0 = {q##X##_l.x, q##X##_l.y}, q1 = {q##X##_l.z, q##X##_l.w}, q2 = {q##X##_h.x, q##X##_h.y}, q3 = {q##X##_h.z, q##X##_h.w}; \
      f2 t0 = k0 * S[0], t1 = k2 * S[2], u0 = q0 * S[0], u1 = q2 * S[2]; t0 = k1 * S[1] + t0; t1 = k3 * S[3] + t1; u0 = q1 * S[1] + u0; u1 = q3 * S[3] + u1; \
      float pk = hsum(t0 + t1), pq = hsum(u0 + u1); pk = sum16(pk); pq = sum16(pq); \
      const float a = sc##X.x, r = sc##X.y * (v##X - a * pk), o = a * pq + sc##X.z * r; const f2 a2 = {a, a}, r2 = {r, r}; \
      S[0] = k0 * r2 + a2 * S[0]; S[1] = k1 * r2 + a2 * S[1]; S[2] = k2 * r2 + a2 * S[2]; S[3] = k3 * r2 + a2 * S[3]; \
      if (s == 0) obuf[(t) * 32 + cl] = o; } while (0)
    GDN_FETCH(A, 0);
#pragma unroll 1
    for (int t = 0; t < TC; t += 2) {
      GDN_FETCH(B, t + 1);
      GDN_STEP(A, t);
      GDN_FETCH(A, min(t + 2, TC - 1));
      GDN_STEP(B, t + 1);
    }
    __syncthreads();
    { const int cp = cv * 2; const unsigned w = pk2(obuf[tt * 32 + cp], obuf[tt * 32 + cp + 1]);
      *(unsigned*)(raw + (size_t)(row0 + c * TC + tt) * DM + h * 128 + sl * 32 + cp) = w; }
    if (c + 1 < nch) { LAS float* nb = lds + ((c + 1) & 1) * BUF; GDN_STORE(nb); }
    __syncthreads();
  }
#pragma unroll
  for (int i = 0; i < 4; ++i) { sout[(size_t)(8 * s + 2 * i) * 128 + col] = S[i].x; sout[(size_t)(8 * s + 2 * i + 1) * 128 + col] = S[i].y; }
#undef GDN_LOAD
#undef GDN_STORE
#undef GDN_FETCH
#undef GDN_STEP
}

__device__ __forceinline__ void ssd_item(const Params& p, LAS float* lds, int row0, int T, int h, int half, float* hout) {
  const int tid = otid(), pl = tid >> 4, s = tid & 15, grp = h >> 1;
  const bf16_t* convo = (const bf16_t*)(p.ws + p.big + SZ_PROJA + SZ_PROJB);
  const float* gates = (const float*)(p.ws + p.gates);
  bf16_t* raw = (bf16_t*)(p.ws + p.hn);
  constexpr int BUF = 9344;
  LAS float* obuf = lds + 2 * BUF;
  f2 H[4];
#pragma unroll
  for (int i = 0; i < 4; ++i) H[i] = (f2){0.f, 0.f};
  const int nch = T / TC;
  uint4 rB, rC, rx; float rdt = 0.f, rda = 0.f; rB = rC = rx = make_uint4(0, 0, 0, 0);
  const int tt = tid >> 4, cv = tid & 15;
#define SSD_LOAD(c) do { { const bf16_t* r_ = convo + (size_t)(row0 + (c) * TC + tt) * CONVD + grp * 128 + cv * 8; rB = *(const uint4*)(r_ + 1792); rC = *(const uint4*)(r_ + 2048); } \
    if (tid < 128) rx = *(const uint4*)(convo + (size_t)(row0 + (c) * TC + (tid >> 2)) * CONVD + 1536 + h * 64 + half * 32 + (tid & 3) * 8); \
    else if (tid < 160) { const float* g_ = gates + (size_t)(row0 + (c) * TC + (tid - 128)) * 32; rdt = g_[16 + h]; rda = __expf(g_[20 + h]); } } while (0)
#define SSD_STORE(buf) do { float fb_[8], fc_[8]; unpack8(rB, fb_); unpack8(rC, fc_); lds_store8((buf) + 1024 + tt * 128 + cv * 8, fb_); lds_store8((buf) + 5120 + tt * 128 + cv * 8, fc_); \
    float d_ = 0.f; _Pragma("unroll") for (int e = 0; e < 8; ++e) d_ += fb_[e] * fc_[e]; d_ = sum16(d_); if (cv == 0) (buf)[9216 + tt * 4 + 2] = d_; \
    if (tid < 128) { unpack8(rx, fb_); lds_store8((buf) + (tid >> 2) * 32 + (tid & 3) * 8, fb_); } \
    else if (tid < 160) { (buf)[9216 + (tid - 128) * 4] = rda; (buf)[9216 + (tid - 128) * 4 + 1] = rdt; } } while (0)
  __syncthreads();
  SSD_LOAD(0); SSD_STORE(lds); __syncthreads();
  for (int c = 0; c < nch; ++c) {
    const LAS float* buf = lds + (c & 1) * BUF;
    if (c + 1 < nch) SSD_LOAD(c + 1);
    f4 bA_l, bA_h, cA_l, cA_h, scA, bB_l, bB_h, cB_l, cB_h, scB; float xA, xB;
#define SSD_FETCH(X, t) do { const int t_ = (t); b##X##_l = *(const LAS f4*)(buf + 1024 + t_ * 128 + 8 * s); b##X##_h = *(const LAS f4*)(buf + 1024 + t_ * 128 + 8 * s + 4); \
      c##X##_l = *(const LAS f4*)(buf + 5120 + t_ * 128 + 8 * s); c##X##_h = *(const LAS f4*)(buf + 5120 + t_ * 128 + 8 * s + 4); x##X = buf[t_ * 32 + pl]; sc##X = *(const LAS f4*)(buf + 9216 + t_ * 4); } while (0)
#define SSD_STEP(X, t) do { const f2 b0 = {b##X##_l.x, b##X##_l.y}, b1 = {b##X##_l.z, b##X##_l.w}, b2 = {b##X##_h.x, b##X##_h.y}, b3 = {b##X##_h.z, b##X##_h.w}; \
      const f2 c0 = {c##X##_l.x, c##X##_l.y}, c1 = {c##X##_l.z, c##X##_l.w}, c2 = {c##X##_h.x, c##X##_h.y}, c3 = {c##X##_h.z, c##X##_h.w}; \
      f2 t0 = c0 * H[0], t1 = c2 * H[2]; t0 = c1 * H[1] + t0; t1 = c3 * H[3] + t1; \
      float pc = hsum(t0 + t1); pc = sum16(pc); \
      const float dA = sc##X.x, dtx = sc##X.y * x##X, y = dA * pc + dtx * sc##X.z; const f2 a2 = {dA, dA}, r2 = {dtx, dtx}; \
      H[0] = b0 * r2 + a2 * H[0]; H[1] = b1 * r2 + a2 * H[1]; H[2] = b2 * r2 + a2 * H[2]; H[3] = b3 * r2 + a2 * H[3]; \
      if (s == 0) obuf[(t) * 32 + pl] = y; } while (0)
    SSD_FETCH(A, 0);
#pragma unroll 1
    for (int t = 0; t < TC; t += 2) {
      SSD_FETCH(B, t + 1);
      SSD_STEP(A, t);
      SSD_FETCH(A, min(t + 2, TC - 1));
      SSD_STEP(B, t + 1);
    }
    __syncthreads();
    { const int cp = cv * 2; const unsigned w = pk2(obuf[tt * 32 + cp], obuf[tt * 32 + cp + 1]);
      *(unsigned*)(raw + (size_t)(row0 + c * TC + tt) * DM + 768 + h * 64 + half * 32 + cp) = w; }
    if (c + 1 < nch) { LAS float* nb = lds + ((c + 1) & 1) * BUF; SSD_STORE(nb); }
    __syncthreads();
  }
  { float* ho = hout + (size_t)(half * 32 + pl) * 128 + 8 * s;
    *(float4*)ho = make_float4(H[0].x, H[0].y, H[1].x, H[1].y); *(float4*)(ho + 4) = make_float4(H[2].x, H[2].y, H[3].x, H[3].y); }
#undef SSD_LOAD
#undef SSD_STORE
#undef SSD_FETCH
#undef SSD_STEP
}

__device__ __forceinline__ void mlstm_item(const Params& p, LAS float* lds, int row0, int T, int h, float* cout, float* nout, float* mout) {
  const int tid = otid(), col = tid >> 3, s = tid & 7, lane = tid & 63;
  const bf16_t* projB = (const bf16_t*)(p.ws + p.big + SZ_PROJA);
  const float* gates = (const float*)(p.ws + p.gates);
  bf16_t* raw = (bf16_t*)(p.ws + p.hn);
  constexpr int BUF = 6272;
  LAS float* obuf = lds + 2 * BUF;
  f2 C[4], n[4];
#pragma unroll
  for (int i = 0; i < 4; ++i) { C[i] = (f2){0.f, 0.f}; n[i] = (f2){0.f, 0.f}; }
  float mcar = 0.f;
  const int nch = T / TC;
  uint4 r0, r1; float rli = 0.f, rlf = 0.f; r0 = r1 = make_uint4(0, 0, 0, 0);
  const int u = tid & 255, tt = u >> 3, cv = u & 7;
#define ML_LOAD(c) do { const bf16_t* r_ = projB + (size_t)(row0 + (c) * TC + tt) * PBLD + h * 64 + cv * 8; \
    if (tid < 256) { r0 = *(const uint4*)(r_ + O_MQ); r1 = *(const uint4*)(r_ + O_MK); } else { r0 = *(const uint4*)(r_ + O_MV); \
      if (tid < 288) { const float* g_ = gates + (size_t)(row0 + (c) * TC + (tid - 256)) * 32; rli = g_[8 + h]; rlf = g_[12 + h]; } } } while (0)
#define ML_STORE(buf) do { float f0_[8], f1_[8]; unpack8(r0, f0_); \
    if (tid < 256) { unpack8(r1, f1_); _Pragma("unroll") for (int e = 0; e < 8; ++e) f1_[e] *= 0.125f; lds_store8((buf) + tt * 64 + cv * 8, f0_); lds_store8((buf) + 2048 + tt * 64 + cv * 8, f1_); \
      float d_ = 0.f; _Pragma("unroll") for (int e = 0; e < 8; ++e) d_ += f0_[e] * f1_[e]; d_ = sum8(d_); if (cv == 0) (buf)[6144 + tt * 4 + 2] = d_; } \
    else { lds_store8((buf) + 4096 + tt * 64 + cv * 8, f0_); \
      if (tid < 320) {     \
        float F_ = rlf; _Pragma("unroll") for (int o_ = 1; o_ < 32; o_ <<= 1) { const float t_ = __shfl_up(F_, o_); if (lane >= o_) F_ += t_; } \
        float G_ = rli - F_; _Pragma("unroll") for (int o_ = 1; o_ < 32; o_ <<= 1) { const float t_ = __shfl_up(G_, o_); if (lane >= o_) G_ = fmaxf(G_, t_); } \
        const float m_ = F_ + fmaxf(mcar, G_); float mp_ = __shfl_up(m_, 1); if (lane == 0) mp_ = mcar; \
        if (lane < 32) { (buf)[6144 + lane * 4] = __expf(rlf + mp_ - m_); (buf)[6144 + lane * 4 + 1] = __expf(rli - m_); (buf)[6144 + lane * 4 + 3] = __expf(-m_); } \
        mcar = __shfl(m_, 31); } } } while (0)
  __syncthreads();
  ML_LOAD(0); ML_STORE(lds); __syncthreads();
  for (int c = 0; c < nch; ++c) {
    const LAS float* buf = lds + (c & 1) * BUF;
    if (c + 1 < nch) ML_LOAD(c + 1);
    f4 kA_l, kA_h, qA_l, qA_h, scA, kB_l, kB_h, qB_l, qB_h, scB; float vA, vB;
#define ML_FETCH(X, t) do { const int t_ = (t); k##X##_l = *(const LAS f4*)(buf + 2048 + t_ * 64 + 8 * s); k##X##_h = *(const LAS f4*)(buf + 2048 + t_ * 64 + 8 * s + 4); \
      q##X##_l = *(const LAS f4*)(buf + t_ * 64 + 8 * s); q##X##_h = *(const LAS f4*)(buf + t_ * 64 + 8 * s + 4); v##X = buf[4096 + t_ * 64 + col]; sc##X = *(const LAS f4*)(buf + 6144 + t_ * 4); } while (0)
#define ML_STEP(X, t) do { const f2 k0 = {k##X##_l.x, k##X##_l.y}, k1 = {k##X##_l.z, k##X##_l.w}, k2 = {k##X##_h.x, k##X##_h.y}, k3 = {k##X##_h.z, k##X##_h.w}; \
      const f2 q0 = {q##X##_l.x, q##X##_l.y}, q1 = {q##X##_l.z, q##X##_l.w}, q2 = {q##X##_h.x, q##X##_h.y}, q3 = {q##X##_h.z, q##X##_h.w}; \
      f2 t0 = q0 * C[0], t1 = q2 * C[2], u0 = q0 * n[0], u1 = q2 * n[2]; t0 = q1 * C[1] + t0; t1 = q3 * C[3] + t1; u0 = q1 * n[1] + u0; u1 = q3 * n[3] + u1; \
      float pc = hsum(t0 + t1), pn = hsum(u0 + u1); pc = sum8(pc); pn = sum8(pn); \
      const float fp = sc##X.x, ip = sc##X.y, iqk = ip * sc##X.z, num = fp * pc + iqk * v##X; const float den = fmaxf(fabsf(fp * pn + iqk), sc##X.w); \
      const float iv = ip * v##X; const f2 f2_ = {fp, fp}, iv2 = {iv, iv}, ip2 = {ip, ip}; \
      C[0] = k0 * iv2 + f2_ * C[0]; C[1] = k1 * iv2 + f2_ * C[1]; C[2] = k2 * iv2 + f2_ * C[2]; C[3] = k3 * iv2 + f2_ * C[3]; \
      n[0] = k0 * ip2 + f2_ * n[0]; n[1] = k1 * ip2 + f2_ * n[1]; n[2] = k2 * ip2 + f2_ * n[2]; n[3] = k3 * ip2 + f2_ * n[3]; \
      if (s == 0) obuf[(t) * 64 + col] = num * __builtin_amdgcn_rcpf(den); } while (0)
    ML_FETCH(A, 0);
#pragma unroll 1
    for (int t = 0; t < TC; t += 2) {
      ML_FETCH(B, t + 1);
      ML_STEP(A, t);
      ML_FETCH(A, min(t + 2, TC - 1));
      ML_STEP(B, t + 1);
    }
    __syncthreads();
    { const int t2 = tid >> 4, cp = (tid & 15) * 4;
      uint2 w; w.x = pk2(obuf[t2 * 64 + cp], obuf[t2 * 64 + cp + 1]); w.y = pk2(obuf[t2 * 64 + cp + 2], obuf[t2 * 64 + cp + 3]);
      *(uint2*)(raw + (size_t)(row0 + c * TC + t2) * DM + 512 + h * 64 + cp) = w; }
    if (c + 1 < nch) { LAS float* nb = lds + ((c + 1) & 1) * BUF; ML_STORE(nb); }
    __syncthreads();
  }
#pragma unroll
  for (int i = 0; i < 4; ++i) { cout[(size_t)(8 * s + 2 * i) * 64 + col] = C[i].x; cout[(size_t)(8 * s + 2 * i + 1) * 64 + col] = C[i].y;
    if (col == 0) { nout[8 * s + 2 * i] = n[i].x; nout[8 * s + 2 * i + 1] = n[i].y; } }
  if (tid == 256) mout[0] = mcar;
#undef ML_LOAD
#undef ML_STORE
#undef ML_FETCH
#undef ML_STEP
}

typedef short bf16x8_t __attribute__((ext_vector_type(8)));
typedef unsigned u32x4_t __attribute__((ext_vector_type(4)));
typedef unsigned u32x2_t __attribute__((ext_vector_type(2)));
__device__ __forceinline__ void lds_st16(LAS bf16_t* q, const uint4 v) { *(LAS u32x4_t*)q = (u32x4_t){v.x, v.y, v.z, v.w}; }
__device__ __forceinline__ void lds_st8(LAS bf16_t* q, unsigned a, unsigned b) { *(LAS u32x2_t*)q = (u32x2_t){a, b}; }
__device__ __forceinline__ unsigned short f2bf(float f) { unsigned u = __float_as_uint(f); u += 0x7FFFu + ((u >> 16) & 1u); return (unsigned short)(u >> 16); }
template <int K> __device__ __forceinline__ f4 mma_rows(const LAS bf16_t* A, int lda, const LAS bf16_t* B, int ldb, f4 acc, int lane) {
  const LAS bf16_t* ap = A + (lane & 15) * lda + (lane >> 4) * 8; const LAS bf16_t* bp = B + (lane & 15) * ldb + (lane >> 4) * 8;
#pragma unroll
  for (int k0 = 0; k0 < K; k0 += 32) acc = __builtin_amdgcn_mfma_f32_16x16x32_bf16(*(const LAS bf16x8_t*)(ap + k0), *(const LAS bf16x8_t*)(bp + k0), acc, 0, 0, 0);
  return acc;
}
template <int K, bool SWA, bool SWB> __device__ __forceinline__ f4 mma_rows_sw(const LAS bf16_t* A, int arow0, int lda, const LAS bf16_t* B, int brow0, int ldb, f4 acc, int lane) {
  const int ar = arow0 + (lane & 15), br = brow0 + (lane & 15), g = lane >> 4;
  const LAS bf16_t* ap = A + ar * lda; const LAS bf16_t* bp = B + br * ldb;
  const int sa = SWA ? ((ar >> 3) & 7) : 0, sb = SWB ? ((br >> 3) & 7) : 0;
#pragma unroll
  for (int k0 = 0; k0 < K; k0 += 32) { const int kc = (k0 >> 3) + g;
    acc = __builtin_amdgcn_mfma_f32_16x16x32_bf16(*(const LAS bf16x8_t*)(ap + ((kc ^ sa) << 3)), *(const LAS bf16x8_t*)(bp + ((kc ^ sb) << 3)), acc, 0, 0, 0); }
  return acc;
}
template <int K, int NB, int NTOT, bool SWA, bool SWB> __device__ __forceinline__ void mma_strip(const LAS bf16_t* A, int arow0, int lda, const LAS bf16_t* B, int brow0, int ldb, f4 (&acc)[NTOT], const int off, int lane) {
  const int ar = arow0 + (lane & 15), g = lane >> 4; const LAS bf16_t* ap = A + ar * lda; const int sa = SWA ? ((ar >> 3) & 7) : 0;
  bf16x8_t af[K / 32];
#pragma unroll
  for (int ks = 0; ks < K / 32; ++ks) af[ks] = *(const LAS bf16x8_t*)(ap + (((ks * 4 + g) ^ sa) << 3));
#pragma unroll
  for (int nb = 0; nb < NB; ++nb) { const int br = brow0 + nb * 16 + (lane & 15); const LAS bf16_t* bp = B + br * ldb; const int sb = SWB ? ((br >> 3) & 7) : 0;
#pragma unroll
    for (int ks = 0; ks < K / 32; ++ks) acc[off + nb] = __builtin_amdgcn_mfma_f32_16x16x32_bf16(af[ks], *(const LAS bf16x8_t*)(bp + (((ks * 4 + g) ^ sb) << 3)), acc[off + nb], 0, 0, 0); }
}
__device__ __forceinline__ int swz_col(int row, int col) { return ((((col >> 3) ^ (row >> 3)) & 7) << 3) | (col & 7); }
template <int CTRL, int RMASK> __device__ __forceinline__ float dpp_id(float x, float ident) {
  return __int_as_float(__builtin_amdgcn_update_dpp(__float_as_int(ident), __float_as_int(x), CTRL, RMASK, 0xf, false));
}
__device__ __forceinline__ float wave_scan_add(float x, int lane) {
  (void)lane;
  x += dpp_id<0x111, 0xf>(x, 0.f); x += dpp_id<0x112, 0xf>(x, 0.f); x += dpp_id<0x114, 0xf>(x, 0.f); x += dpp_id<0x118, 0xf>(x, 0.f);
  x += dpp_id<0x142, 0xa>(x, 0.f); x += dpp_id<0x143, 0xc>(x, 0.f);
  return x;
}
__device__ __forceinline__ float wave_scan_max(float x, int lane) {
  (void)lane; const float ninf = -__builtin_inff();
  x = fmaxf(x, dpp_id<0x111, 0xf>(x, ninf)); x = fmaxf(x, dpp_id<0x112, 0xf>(x, ninf)); x = fmaxf(x, dpp_id<0x114, 0xf>(x, ninf)); x = fmaxf(x, dpp_id<0x118, 0xf>(x, ninf));
  x = fmaxf(x, dpp_id<0x142, 0xa>(x, ninf)); x = fmaxf(x, dpp_id<0x143, 0xc>(x, ninf));
  return x;
}

#define LDS_BARRIER() do { asm volatile("s_waitcnt lgkmcnt(0)" ::: "memory"); __builtin_amdgcn_s_barrier(); asm volatile("" ::: "memory"); } while (0)
#define GAS __attribute__((address_space(1)))
__device__ __forceinline__ void unpack8(const u32x4_t u, float (&f)[8]) { unpack8(make_uint4(u.x, u.y, u.z, u.w), f); }
__device__ __forceinline__ void lds_st16(LAS bf16_t* q, const u32x4_t v) { *(LAS u32x4_t*)q = v; }
template <int MODE>
__device__ __forceinline__ void gla_item(const Params& p, LAS unsigned char* ldsb, int l, int b, int h, int sl) {
  constexpr int DQ = (MODE == 1) ? 64 : 128, DVP = (MODE == 1) ? 80 : (MODE == 2) ? 32 : 64, NVT = DVP / 16, NQT = DQ / 16, NVR = (MODE == 2) ? 2 : 4;
  constexpr int LQ = DQ + 8, LJ = 72, NQV = DQ / 64;
  constexpr int STILES = (NQT * NVT + 3) / 4;
  LAS bf16_t* Qs = (LAS bf16_t*)ldsb;
  LAS bf16_t* Ks = Qs + 64 * LQ;
  LAS bf16_t* KwT = Ks + 64 * LQ;
  LAS bf16_t* VT = KwT + DQ * LJ;
  LAS bf16_t* ST = VT + DVP * LJ;
  LAS bf16_t* Ws = ST + DVP * LQ;
  LAS bf16_t* Ts = Ws + 64 * LJ;
  LAS bf16_t* RT = Ts + 64 * LJ;
  LAS float* scal = (LAS float*)(RT + 64 * LJ);
  const int tid = otid(), lane = tid & 63, wv = tid >> 6, j = tid >> 3, fv = tid & 7;
  const int row0 = b * 2048;
  const GAS bf16_t* convo = (const GAS bf16_t*)(p.ws + p.big + SZ_PROJA + SZ_PROJB);
  const GAS bf16_t* projB = (const GAS bf16_t*)(p.ws + p.big + SZ_PROJA);
  const GAS float* gates = (const GAS float*)(p.ws + p.gates);
  GAS bf16_t* raw = (GAS bf16_t*)(p.ws + p.hn);
  const GAS bf16_t* qsrc; const GAS bf16_t* ksrc; const GAS bf16_t* vsrc; int ldsrc, ocol;
  if (MODE == 0) { ldsrc = CONVD; qsrc = convo + 2048 + (h >> 1) * 128; ksrc = convo + 1792 + (h >> 1) * 128; vsrc = convo + 1536 + h * 64; ocol = 768 + h * 64; }
  else if (MODE == 1) { ldsrc = PBLD; qsrc = projB + O_MQ + h * 64; ksrc = projB + O_MK + h * 64; vsrc = projB + O_MV + h * 64; ocol = 512 + h * 64; }
  else { ldsrc = CONVD; qsrc = convo + h * 128; ksrc = convo + 512 + h * 128; vsrc = convo + 1024 + h * 128 + sl * 32; ocol = h * 128 + sl * 32; }
  const GAS bf16_t* tsrc = (const GAS bf16_t*)(p.ws + p.big) + (size_t)(b * 4 + h) * 32 * 4096;
  __syncthreads();
  for (int i = tid; i < DVP * LQ / 2; i += 512) ((LAS unsigned*)ST)[i] = 0u;
  for (int i = tid; i < 64 * LJ / 2; i += 512) ((LAS unsigned*)Ws)[i] = 0u;
  if (MODE == 1) { for (int i = tid; i < 16 * LJ; i += 512) VT[64 * LJ + i] = (i < LJ) ? (bf16_t)0x3F80 : (bf16_t)0; }
  f4 accS[STILES];
#pragma unroll
  for (int t = 0; t < STILES; ++t) accS[t] = (f4){0.f, 0.f, 0.f, 0.f};
  float mprev = 0.f;
  u32x4_t rq[NQV], rk[NQV], rv, rt, rp; float ga = 0.f, gla = 0.f, gbt = 0.f;
  rv = rt = rp = (u32x4_t){0u, 0u, 0u, 0u};
#define GLA_LOAD(c) do { const size_t r_ = (size_t)(row0 + (c) * 64 + j) * ldsrc; \
    _Pragma("unroll") for (int q_ = 0; q_ < NQV; ++q_) { rq[q_] = *(const GAS u32x4_t*)(qsrc + r_ + (fv + 8 * q_) * 8); rk[q_] = *(const GAS u32x4_t*)(ksrc + r_ + (fv + 8 * q_) * 8); } \
    if (MODE != 2 || fv < 4) rv = *(const GAS u32x4_t*)(vsrc + r_ + fv * 8); \
    if (MODE == 2) { rt = *(const GAS u32x4_t*)(tsrc + ((size_t)(c) * 64 + j) * 64 + fv * 8); rp = *(const GAS u32x4_t*)(tsrc + (size_t)1024 * 4096 + ((size_t)(c) * 64 + j) * 64 + fv * 8); } \
    } while (0)
#define GLA_GATES(c) do { if (wv == 0) { const GAS float* g_ = gates + (size_t)(row0 + (c) * 64 + lane) * 32; \
      if (MODE == 0) { ga = g_[20 + h]; gla = __logf(g_[16 + h]); } else if (MODE == 1) { ga = g_[12 + h]; gla = g_[8 + h]; } else { ga = g_[h]; gla = 0.f; gbt = g_[4 + h]; } } } while (0)
#define GLA_SCAN(buf) do { if (wv == 0) { LAS float* s_ = scal + (buf) * 320; const float g_ = wave_scan_add(ga, lane); float m_ = 0.f; \
      if (MODE == 1) { const float pm_ = wave_scan_max(gla - g_, lane); m_ = g_ + fmaxf(mprev, pm_); } \
      const float ri_ = g_ - m_, cj_ = g_ - gla + ((MODE == 1) ? 2.0794415416798357f : 0.f), ri63_ = __shfl(ri_, 63); \
      s_[lane] = ri_; s_[64 + lane] = cj_; s_[128 + lane] = __expf(ri_ + mprev); s_[192 + lane] = __expf(ri63_ - cj_); s_[256 + lane] = (MODE == 2) ? gbt : __expf(-m_); \
      if (MODE == 1) mprev = __shfl(m_, 63); } } while (0)
#define GLA_STORE(buf) do { const LAS float* s_ = scal + (buf) * 320; const float wj_ = s_[192 + j]; const int pj_ = (((j >> 3) ^ fv) << 3) | (j & 7); \
    _Pragma("unroll") for (int q_ = 0; q_ < NQV; ++q_) { lds_st16(Qs + j * LQ + (fv + 8 * q_) * 8, rq[q_]); lds_st16(Ks + j * LQ + (fv + 8 * q_) * 8, rk[q_]); \
      float f_[8]; unpack8(rk[q_], f_); _Pragma("unroll") for (int e = 0; e < 8; e += 2) { const unsigned pr_ = pk2(f_[e] * wj_, f_[e + 1] * wj_); KwT[((fv + 8 * q_) * 8 + e) * LJ + pj_] = (bf16_t)(pr_ & 0xffffu); KwT[((fv + 8 * q_) * 8 + e + 1) * LJ + pj_] = (bf16_t)(pr_ >> 16); } } \
    if (MODE != 2 || fv < 4) { LAS bf16_t* vt_ = VT + fv * 8 * LJ + pj_; vt_[0] = (bf16_t)(rv.x & 0xffffu); vt_[LJ] = (bf16_t)(rv.x >> 16); vt_[2 * LJ] = (bf16_t)(rv.y & 0xffffu); vt_[3 * LJ] = (bf16_t)(rv.y >> 16); \
      vt_[4 * LJ] = (bf16_t)(rv.z & 0xffffu); vt_[5 * LJ] = (bf16_t)(rv.z >> 16); vt_[6 * LJ] = (bf16_t)(rv.w & 0xffffu); vt_[7 * LJ] = (bf16_t)(rv.w >> 16); } \
    if (MODE == 2) { lds_st16(Ts + j * LJ + fv * 8, rt); lds_st16(Ws + j * LJ + fv * 8, rp); } } while (0)
  GLA_GATES(0); GLA_LOAD(0); GLA_SCAN(0); GLA_GATES(1);
  LDS_BARRIER();
  GLA_STORE(0);
  LDS_BARRIER();
#pragma unroll 1
  for (int c = 0; c < 32; ++c) {
    const LAS float* sc = scal + (c & 1) * 320;
    if (c + 1 < 32) GLA_LOAD(c + 1);
    f4 accO[NVT];
#define GLA_O1() do { if (wv < 4) { _Pragma("unroll") for (int nb = 0; nb < NVT; ++nb) accO[nb] = (f4){0.f, 0.f, 0.f, 0.f}; \
      mma_strip<DQ, NVT, NVT, false, false>(Qs, wv * 16, LQ, ST, 0, LQ, accO, 0, lane); \
      const f4 rs4 = *(const LAS f4*)(sc + 128 + wv * 16 + (lane >> 4) * 4); \
      _Pragma("unroll") for (int nb = 0; nb < NVT; ++nb) accO[nb] *= rs4; } } while (0)
    if (MODE == 2) {
      f4 dA[1];
#pragma unroll
      for (int k = 0; k < 1; ++k) { const int t = wv, jb = t >> 1, nb = t & 1;
        dA[k] = mma_rows<DQ>(Ks + jb * 16 * LQ, LQ, ST + nb * 16 * LQ, LQ, (f4){0.f, 0.f, 0.f, 0.f}, lane); }
#pragma unroll
      for (int k = 0; k < 1; ++k) { const int t = wv, jb = t >> 1, nb = t & 1; const f4 d = dA[k];
        const int dv = nb * 16 + (lane & 15), j0 = jb * 16 + (lane >> 4) * 4;
        const u32x2_t vv = *(const LAS u32x2_t*)(VT + dv * LJ + swz_col(dv, j0));
        const f4 bt4 = *(const LAS f4*)(sc + 256 + j0), eg4 = *(const LAS f4*)(sc + 128 + j0);
        const float v0 = __uint_as_float(vv.x << 16), v1 = __uint_as_float(vv.x & 0xffff0000u), v2 = __uint_as_float(vv.y << 16), v3 = __uint_as_float(vv.y & 0xffff0000u);
        const float r0 = bt4.x * (v0 - eg4.x * d[0]), r1 = bt4.y * (v1 - eg4.y * d[1]), r2 = bt4.z * (v2 - eg4.z * d[2]), r3 = bt4.w * (v3 - eg4.w * d[3]);
        lds_st8(RT + dv * LJ + j0, pk2(r0, r1), pk2(r2, r3)); }
      LDS_BARRIER();
      GLA_O1();
      { const int t0 = (wv < 4 ? 0 : (wv - 4) * 2), nt_ = (wv < 4 ? 0 : 2);
        f4 dB[3];
#pragma unroll
        for (int k = 0; k < 3; ++k) if (k < nt_) { const int t = t0 + k, ib = t >> 1, nb = t & 1;
          dB[k] = mma_rows<64>(Ts + ib * 16 * LJ, LJ, RT + nb * 16 * LJ, LJ, (f4){0.f, 0.f, 0.f, 0.f}, lane); }
#pragma unroll
        for (int k = 0; k < 3; ++k) if (k < nt_) { const int t = t0 + k, ib = t >> 1, nb = t & 1; const f4 d = dB[k];
          lds_st8(VT + (nb * 16 + (lane & 15)) * LJ + swz_col(nb * 16 + (lane & 15), ib * 16 + (lane >> 4) * 4), pk2(d[0], d[1]), pk2(d[2], d[3])); } }
    }
    if (MODE != 2) {
      f4 dW[3];
#pragma unroll
      for (int k = 0; k < 3; ++k) { const int t = wv - 4 + 4 * k;
        if (wv >= 4 && t < 10) { const int ib = (t >= 6) ? 3 : (t >= 3) ? 2 : (t >= 1) ? 1 : 0, jb = t - ib * (ib + 1) / 2;
          dW[k] = mma_rows<DQ>(Ks + jb * 16 * LQ, LQ, Qs + ib * 16 * LQ, LQ, (f4){0.f, 0.f, 0.f, 0.f}, lane); } }
#pragma unroll
      for (int k = 0; k < 3; ++k) { const int t = wv - 4 + 4 * k;
        if (wv >= 4 && t < 10) { const int ib = (t >= 6) ? 3 : (t >= 3) ? 2 : (t >= 1) ? 1 : 0, jb = t - ib * (ib + 1) / 2; const f4 d = dW[k];
          const int i = ib * 16 + (lane & 15), j0 = jb * 16 + (lane >> 4) * 4; const float ri = sc[i];
          const f4 cj4 = *(const LAS f4*)(sc + 64 + j0);
          const float w0 = (j0 <= i) ? d[0] * __expf(ri - cj4.x) : 0.f, w1 = (j0 + 1 <= i) ? d[1] * __expf(ri - cj4.y) : 0.f, w2 = (j0 + 2 <= i) ? d[2] * __expf(ri - cj4.z) : 0.f, w3 = (j0 + 3 <= i) ? d[3] * __expf(ri - cj4.w) : 0.f;
          lds_st8(Ws + i * LJ + j0, pk2(w0, w1), pk2(w2, w3)); } }
    }
    if (MODE != 2) GLA_O1();
    LDS_BARRIER();
    if (wv < 4) {
      mma_strip<64, NVT, NVT, false, true>(Ws, wv * 16, LJ, VT, 0, LJ, accO, 0, lane);
      GAS bf16_t* obase = raw + (size_t)(row0 + c * 64 + wv * 16 + (lane >> 4) * 4) * DM + ocol + (lane & 15);
      float inv[4];
      if (MODE == 1) {
        const f4 em4 = *(const LAS f4*)(sc + 256 + wv * 16 + (lane >> 4) * 4);
#pragma unroll
        for (int r = 0; r < 4; ++r) { const float den = __shfl(accO[NVT - 1][r], lane & 48); inv[r] = __builtin_amdgcn_rcpf(fmaxf(fabsf(den), em4[r])); }
      }
#pragma unroll
      for (int nb = 0; nb < NVR; ++nb)
#pragma unroll
        for (int r = 0; r < 4; ++r) { const float o = (MODE == 1) ? accO[nb][r] * inv[r] : accO[nb][r];
          obase[r * DM + nb * 16] = (bf16_t)(pk2(o, 0.f) & 0xffffu); }
      if (c + 1 < 32) { GLA_SCAN((c + 1) & 1); if (c + 2 < 32) GLA_GATES(c + 2); }
    } else {
      const float cs = sc[128 + 63];
#pragma unroll
      for (int t = 0; t < STILES; ++t) accS[t] *= cs;
#pragma unroll
      for (int qq = 0; qq < STILES / NVT; ++qq)
        mma_strip<64, NVT, STILES, true, true>(KwT, ((wv - 4) * (STILES / NVT) + qq) * 16, LJ, VT, 0, LJ, accS, qq * NVT, lane);
#pragma unroll
      for (int t = 0; t < STILES; ++t) { const int ti = (wv - 4) * STILES + t;
        if (ti < NQT * NVT) { const int qb = ti / NVT, nb = ti - qb * NVT;
          lds_st8(ST + (nb * 16 + (lane & 15)) * LQ + qb * 16 + (lane >> 4) * 4, pk2(accS[t][0], accS[t][1]), pk2(accS[t][2], accS[t][3])); } }
    }
    LDS_BARRIER();
    if (c + 1 < 32) GLA_STORE((c + 1) & 1);
    LDS_BARRIER();
  }
  if (wv >= 4) {
    const size_t bh = ((size_t)l * 8 + b) * 4 + h;
#pragma unroll
    for (int t = 0; t < STILES; ++t) { const int ti = (wv - 4) * STILES + t;
      if (ti < NQT * NVT) { const int qb = ti / NVT, nb = ti - qb * NVT; const int dq = qb * 16 + (lane >> 4) * 4, dv = nb * 16 + (lane & 15);
        if (MODE == 0) *(float4*)(p.out + p.o_pssd + bh * 8192 + (size_t)dv * 128 + dq) = make_float4(accS[t][0], accS[t][1], accS[t][2], accS[t][3]);
        else if (MODE == 1) {
          if (dv < 64) {
#pragma unroll
            for (int r = 0; r < 4; ++r) p.out[p.o_pmc + bh * 4096 + (size_t)(dq + r) * 64 + dv] = accS[t][r];
          } else if (dv == 64) {
#pragma unroll
            for (int r = 0; r < 4; ++r) p.out[p.o_pmn + bh * 64 + dq + r] = accS[t][r];
          }
        } else {
#pragma unroll
          for (int r = 0; r < 4; ++r) p.out[p.o_pgdn + bh * 16384 + (size_t)(dq + r) * 128 + sl * 32 + dv] = accS[t][r];
        } } }
  }
  if (MODE == 1 && tid == 0) p.out[p.o_pmm + ((size_t)l * 8 + b) * 4 + h] = mprev;
#undef GLA_LOAD
#undef GLA_O1
#undef GLA_GATES
#undef GLA_SCAN
#undef GLA_STORE
}

__device__ __forceinline__ void phase_gdnT(const Params& p, int l, LAS unsigned char* ldsb) {
  const int tid = otid(), lane = tid & 63, wv = tid >> 6;
  const bf16_t* convo = (const bf16_t*)(p.ws + p.big + SZ_PROJA + SZ_PROJB);
  const float* gates = (const float*)(p.ws + p.gates);
  bf16_t* Tb = (bf16_t*)(p.ws + p.big); bf16_t* Pb = Tb + (size_t)1024 * 4096;
  if (wv < 4) {
    LAS float* Mw = (LAS float*)ldsb + wv * 4096;
    for (int item = obid() + gridDim.x * wv; item < 1024; item += gridDim.x * 4) {
      const int b = item >> 7, h = (item >> 5) & 3, c = item & 31, row0 = b * 2048 + c * 64;
      const float g = gates[(size_t)(row0 + lane) * 32 + h], beta = gates[(size_t)(row0 + lane) * 32 + 4 + h];
      const bf16_t* kbase = convo + (size_t)(row0 + (lane & 15)) * CONVD + 512 + h * 128 + (lane >> 4) * 8;
      const bf16_t* qbase = kbase - 512;
      bf16_t* pbase = Pb + (size_t)item * 4096 + (lane >> 4) * 256 + (lane & 15);
      bf16_t* tbase = Tb + (size_t)item * 4096 + lane;
      LAS float* mbase = Mw + (lane >> 4) * 256 + (lane & 15);
      const float gam = wave_scan_add(g, lane);
      bf16x8_t kf[4][4];
#pragma unroll
      for (int rb = 0; rb < 4; ++rb)
#pragma unroll
        for (int ks = 0; ks < 4; ++ks) kf[rb][ks] = *(const bf16x8_t*)(kbase + rb * 16 * CONVD + ks * 32);
      const float gj0 = __shfl(gam, lane & 15), gj1 = __shfl(gam, 16 + (lane & 15)), gj2 = __shfl(gam, 32 + (lane & 15)), gj3 = __shfl(gam, 48 + (lane & 15));
#pragma unroll
      for (int ib = 0; ib < 4; ++ib) {
        float gi[4], bi[4];
#pragma unroll
        for (int r = 0; r < 4; ++r) { gi[r] = __shfl(gam, ib * 16 + (lane >> 4) * 4 + r); bi[r] = __shfl(beta, ib * 16 + (lane >> 4) * 4 + r); }
#pragma unroll
        for (int jb = 0; jb <= ib; ++jb) {
          f4 d = (f4){0.f, 0.f, 0.f, 0.f};
#pragma unroll
          for (int ks = 0; ks < 4; ++ks) d = __builtin_amdgcn_mfma_f32_16x16x32_bf16(kf[ib][ks], kf[jb][ks], d, 0, 0, 0);
          const float gj = jb == 0 ? gj0 : jb == 1 ? gj1 : jb == 2 ? gj2 : gj3; const int jj = jb * 16 + (lane & 15);
#pragma unroll
          for (int r = 0; r < 4; ++r) { const int ii = ib * 16 + (lane >> 4) * 4 + r; mbase[(ib * 16 + r) * 64 + jb * 16] = (jj < ii) ? d[r] * __expf(gi[r] - gj) * bi[r] : 0.f; }
        }
      }
      {
        bf16x8_t qf[4];
#pragma unroll
        for (int ib = 0; ib < 4; ++ib) {
#pragma unroll
          for (int ks = 0; ks < 4; ++ks) qf[ks] = *(const bf16x8_t*)(qbase + ib * 16 * CONVD + ks * 32);
          float gi[4];
#pragma unroll
          for (int r = 0; r < 4; ++r) gi[r] = __shfl(gam, ib * 16 + (lane >> 4) * 4 + r);
#pragma unroll
          for (int jb = 0; jb < 4; ++jb) {
            f4 d = (f4){0.f, 0.f, 0.f, 0.f};
#pragma unroll
            for (int ks = 0; ks < 4; ++ks) d = __builtin_amdgcn_mfma_f32_16x16x32_bf16(qf[ks], kf[jb][ks], d, 0, 0, 0);
            const float gj = jb == 0 ? gj0 : jb == 1 ? gj1 : jb == 2 ? gj2 : gj3; const int jj = jb * 16 + (lane & 15);
#pragma unroll
            for (int r = 0; r < 4; ++r) { const int ii = ib * 16 + (lane >> 4) * 4 + r; pbase[(ib * 16 + r) * 64 + jb * 16] = (jj <= ii) ? f2bf(d[r] * __expf(gi[r] - gj)) : (bf16_t)0; }
          }
        }
      }
      float t[64];
#pragma unroll
      for (int i = 0; i < 64; ++i) t[i] = 0.f;
#pragma unroll
      for (int i = 0; i < 64; ++i) {
        float a0 = (i == lane) ? 1.0f : 0.0f, a1 = 0.f;
#pragma unroll
        for (int j4 = 0; j4 < (i + 3) / 4; ++j4) { const f4 m = *(const LAS f4*)(Mw + i * 64 + j4 * 4);
          a0 -= m.x * t[j4 * 4]; a1 -= m.y * t[j4 * 4 + 1]; a0 -= m.z * t[j4 * 4 + 2]; a1 -= m.w * t[j4 * 4 + 3]; }
        t[i] = a0 + a1;
        if ((i & 7) == 7) __builtin_amdgcn_sched_barrier(0);
      }
#pragma unroll
      for (int i = 0; i < 64; ++i) tbase[i * 64] = f2bf(t[i]);
    }
  }
}

__device__ __forceinline__ void gdn_sample(const Params& p, LAS float* lds, int l, int item) {
  const int tid = otid(), w2 = tid >> 7, j = tid & 127;
  const int pair = item * 4 + w2, bs = pair >> 2, h = pair & 3;
  const size_t bh = ((size_t)l * 128 + bs) * 4 + h;
  const float* sin = p.in[3] + bh * 16384; float* sout = p.out + p.o_sgdn + bh * 16384;
  const bf16_t* convo = (const bf16_t*)(p.ws + p.big + SZ_PROJA + SZ_PROJB);
  const float* gates = (const float*)(p.ws + p.gates);
  bf16_t* raw = (bf16_t*)(p.ws + p.hn);
  const int row0 = NPROMPT + bs * 4;
  LAS float* lq = lds + w2 * 1536; LAS float* lk = lq + 512; LAS float* lv = lq + 1024;
  __syncthreads();
#pragma unroll
  for (int t = 0; t < 4; ++t) { const bf16_t* r = convo + (size_t)(row0 + t) * CONVD + h * 128 + j; lq[t * 128 + j] = bf2f(r[0]); lk[t * 128 + j] = bf2f(r[512]); lv[t * 128 + j] = bf2f(r[1024]); }
  float S[128];
#pragma unroll
  for (int d = 0; d < 128; ++d) S[d] = sin[(size_t)d * 128 + j];
  __syncthreads();
#pragma unroll 1
  for (int t = 0; t < 4; ++t) {
    const float* g = gates + (size_t)(row0 + t) * 32;
    const float a = __expf(g[h]), bt = g[4 + h], v = lv[t * 128 + j];
    float pk0 = 0.f, pk1 = 0.f, pq0 = 0.f, pq1 = 0.f, qk0 = 0.f, qk1 = 0.f;
#pragma unroll
    for (int d = 0; d < 128; d += 4) { if ((d & 15) == 0) __builtin_amdgcn_sched_barrier(0); const f4 k4 = *(const LAS f4*)(lk + t * 128 + d), q4 = *(const LAS f4*)(lq + t * 128 + d);
      pk0 += k4.x * S[d]; pk1 += k4.y * S[d + 1]; pk0 += k4.z * S[d + 2]; pk1 += k4.w * S[d + 3];
      pq0 += q4.x * S[d]; pq1 += q4.y * S[d + 1]; pq0 += q4.z * S[d + 2]; pq1 += q4.w * S[d + 3];
      qk0 += q4.x * k4.x; qk1 += q4.y * k4.y; qk0 += q4.z * k4.z; qk1 += q4.w * k4.w; }
    const float r = bt * (v - a * (pk0 + pk1)), o = a * (pq0 + pq1) + (qk0 + qk1) * r;
#pragma unroll
    for (int d = 0; d < 128; d += 4) { if ((d & 15) == 0) __builtin_amdgcn_sched_barrier(0); const f4 k4 = *(const LAS f4*)(lk + t * 128 + d);
      S[d] = a * S[d] + k4.x * r; S[d + 1] = a * S[d + 1] + k4.y * r; S[d + 2] = a * S[d + 2] + k4.z * r; S[d + 3] = a * S[d + 3] + k4.w * r; }
    { unsigned uu = __float_as_uint(o); uu += 0x7FFFu + ((uu >> 16) & 1u); raw[(size_t)(row0 + t) * DM + h * 128 + j] = (bf16_t)(uu >> 16); }
  }
#pragma unroll
  for (int d = 0; d < 128; ++d) sout[(size_t)d * 128 + j] = S[d];
}

__device__ __forceinline__ void mlstm_sample(const Params& p, LAS float* lds, int l, int item) {
  const int tid = otid(), wv = tid >> 6, lane = tid & 63;
  const int pair = item * 8 + wv, bs = pair >> 2, h = pair & 3;
  const size_t bh = ((size_t)l * 128 + bs) * 4 + h;
  const float* cin = p.in[4] + bh * 4096; const float* nin = p.in[5] + bh * 64;
  float* cout = p.out + p.o_smc + bh * 4096; float* nout = p.out + p.o_smn + bh * 64;
  const bf16_t* projB = (const bf16_t*)(p.ws + p.big + SZ_PROJA);
  const float* gates = (const float*)(p.ws + p.gates);
  bf16_t* raw = (bf16_t*)(p.ws + p.hn);
  const int row0 = NPROMPT + bs * 4;
  LAS float* lq = lds + wv * 768; LAS float* lk = lq + 256; LAS float* lv = lq + 512;
  __syncthreads();
#pragma unroll
  for (int t = 0; t < 4; ++t) { const bf16_t* r = projB + (size_t)(row0 + t) * PBLD + h * 64 + lane; lq[t * 64 + lane] = bf2f(r[O_MQ]); lk[t * 64 + lane] = 0.125f * bf2f(r[O_MK]); lv[t * 64 + lane] = bf2f(r[O_MV]); }
  float C[64], n[64];
#pragma unroll
  for (int d = 0; d < 64; ++d) { C[d] = cin[(size_t)d * 64 + lane]; n[d] = nin[d]; }
  float m = p.in[6][bh];
  __syncthreads();
#pragma unroll 1
  for (int t = 0; t < 4; ++t) {
    const float* g = gates + (size_t)(row0 + t) * 32;
    const float li = g[8 + h], lf = g[12 + h], v = lv[t * 64 + lane];
    const float mn = fmaxf(lf + m, li), fp = __expf(lf + m - mn), ip = __expf(li - mn);
    float pc0 = 0.f, pc1 = 0.f, pn0 = 0.f, pn1 = 0.f, qk0 = 0.f, qk1 = 0.f;
#pragma unroll
    for (int d = 0; d < 64; d += 4) { if ((d & 15) == 0) __builtin_amdgcn_sched_barrier(0); const f4 k4 = *(const LAS f4*)(lk + t * 64 + d), q4 = *(const LAS f4*)(lq + t * 64 + d);
      pc0 += q4.x * C[d]; pc1 += q4.y * C[d + 1]; pc0 += q4.z * C[d + 2]; pc1 += q4.w * C[d + 3];
      pn0 += q4.x * n[d]; pn1 += q4.y * n[d + 1]; pn0 += q4.z * n[d + 2]; pn1 += q4.w * n[d + 3];
      qk0 += q4.x * k4.x; qk1 += q4.y * k4.y; qk0 += q4.z * k4.z; qk1 += q4.w * k4.w; }
    const float iqk = ip * (qk0 + qk1), num = fp * (pc0 + pc1) + iqk * v, den = fmaxf(fabsf(fp * (pn0 + pn1) + iqk), __expf(-mn)), iv = ip * v;
#pragma unroll
    for (int d = 0; d < 64; d += 4) { if ((d & 15) == 0) __builtin_amdgcn_sched_barrier(0); const f4 k4 = *(const LAS f4*)(lk + t * 64 + d);
      C[d] = fp * C[d] + iv * k4.x; C[d + 1] = fp * C[d + 1] + iv * k4.y; C[d + 2] = fp * C[d + 2] + iv * k4.z; C[d + 3] = fp * C[d + 3] + iv * k4.w;
      n[d] = fp * n[d] + ip * k4.x; n[d + 1] = fp * n[d + 1] + ip * k4.y; n[d + 2] = fp * n[d + 2] + ip * k4.z; n[d + 3] = fp * n[d + 3] + ip * k4.w; }
    m = mn;
    { unsigned uu = __float_as_uint(num / den); uu += 0x7FFFu + ((uu >> 16) & 1u); raw[(size_t)(row0 + t) * DM + 512 + h * 64 + lane] = (bf16_t)(uu >> 16); }
  }
#pragma unroll
  for (int d = 0; d < 64; ++d) { cout[(size_t)d * 64 + lane] = C[d]; if (lane == 0) nout[d] = n[d]; }
  if (lane == 0) p.out[p.o_smm + bh] = m;
}

__device__ __forceinline__ void ssd_sample(const Params& p, LAS float* lds, int l, int item) {
  const int tid = otid(), wv = tid >> 6, lane = tid & 63;
  const int pair = item * 8 + wv, bs = pair >> 2, h = pair & 3, grp = h >> 1;
  const size_t bh = ((size_t)l * 128 + bs) * 4 + h;
  const float* hin = p.in[7] + bh * 8192 + (size_t)lane * 128; float* hout = p.out + p.o_sssd + bh * 8192 + (size_t)lane * 128;
  const bf16_t* convo = (const bf16_t*)(p.ws + p.big + SZ_PROJA + SZ_PROJB);
  const float* gates = (const float*)(p.ws + p.gates);
  bf16_t* raw = (bf16_t*)(p.ws + p.hn);
  const int row0 = NPROMPT + bs * 4;
  LAS float* lb = lds + wv * 1280; LAS float* lc = lb + 512; LAS float* lx = lb + 1024;
  __syncthreads();
#pragma unroll
  for (int t = 0; t < 4; ++t) { const bf16_t* r = convo + (size_t)(row0 + t) * CONVD;
    lb[t * 128 + lane] = bf2f(r[1792 + grp * 128 + lane]); lb[t * 128 + 64 + lane] = bf2f(r[1792 + grp * 128 + 64 + lane]);
    lc[t * 128 + lane] = bf2f(r[2048 + grp * 128 + lane]); lc[t * 128 + 64 + lane] = bf2f(r[2048 + grp * 128 + 64 + lane]);
    lx[t * 64 + lane] = bf2f(r[1536 + h * 64 + lane]); }
  float H[128];
#pragma unroll
  for (int n = 0; n < 128; n += 4) { const float4 t4 = *(const float4*)(hin + n); H[n] = t4.x; H[n + 1] = t4.y; H[n + 2] = t4.z; H[n + 3] = t4.w; }
  __syncthreads();
#pragma unroll 1
  for (int t = 0; t < 4; ++t) {
    const float* g = gates + (size_t)(row0 + t) * 32;
    const float dt = g[16 + h], dA = __expf(g[20 + h]), x = lx[t * 64 + lane];
    float pc0 = 0.f, pc1 = 0.f, bc0 = 0.f, bc1 = 0.f;
#pragma unroll
    for (int n = 0; n < 128; n += 4) { if ((n & 15) == 0) __builtin_amdgcn_sched_barrier(0); const f4 b4 = *(const LAS f4*)(lb + t * 128 + n), c4 = *(const LAS f4*)(lc + t * 128 + n);
      pc0 += c4.x * H[n]; pc1 += c4.y * H[n + 1]; pc0 += c4.z * H[n + 2]; pc1 += c4.w * H[n + 3];
      bc0 += b4.x * c4.x; bc1 += b4.y * c4.y; bc0 += b4.z * c4.z; bc1 += b4.w * c4.w; }
    const float dtx = dt * x, y = dA * (pc0 + pc1) + dtx * (bc0 + bc1);
#pragma unroll
    for (int n = 0; n < 128; n += 4) { if ((n & 15) == 0) __builtin_amdgcn_sched_barrier(0); const f4 b4 = *(const LAS f4*)(lb + t * 128 + n);
      H[n] = dA * H[n] + dtx * b4.x; H[n + 1] = dA * H[n + 1] + dtx * b4.y; H[n + 2] = dA * H[n + 2] + dtx * b4.z; H[n + 3] = dA * H[n + 3] + dtx * b4.w; }
    { unsigned uu = __float_as_uint(y); uu += 0x7FFFu + ((uu >> 16) & 1u); raw[(size_t)(row0 + t) * DM + 768 + h * 64 + lane] = (bf16_t)(uu >> 16); }
  }
#pragma unroll
  for (int n = 0; n < 128; n += 4) *(float4*)(hout + n) = make_float4(H[n], H[n + 1], H[n + 2], H[n + 3]);
}

__device__ __forceinline__ void phase_mixers(const Params& p, int l, LAS float* lds, int rep = 0) {
  for (int it = obid(); it < 192; it += gridDim.x) {
    if (it < 128) gla_item<2>(p, (LAS unsigned char*)lds, l, it >> 4, (it >> 2) & 3, it & 3);
    else if (it < 160) { const int i = it - 128; gla_item<1>(p, (LAS unsigned char*)lds, l, i >> 2, i & 3, 0); }
    else { const int i = it - 160; gla_item<0>(p, (LAS unsigned char*)lds, l, i >> 2, i & 3, 0); }
  }
  unsigned* ctr = (unsigned*)(p.ws + p.ctr) + l + 2 * rep;
  LAS int* slot = (LAS int*)(lds + 32000);
  for (;;) {
    __syncthreads();
    if (otid() == 0) *slot = (int)atomicAdd(ctr, 1u);
    __syncthreads();
    const int it = *slot;
    if (it >= 256) break;
    if (it < 128) gdn_sample(p, lds, l, it);
    else if (it < 192) mlstm_sample(p, lds, l, it - 128);
    else ssd_sample(p, lds, l, it - 192);
  }
}

__device__ __forceinline__ void phase_mixout(const Params& p, int l) {
  constexpr int NR = 3;
  const bf16_t* projB = (const bf16_t*)(p.ws + p.big + SZ_PROJA);
  const bf16_t* convo = (const bf16_t*)(p.ws + p.big + SZ_PROJA + SZ_PROJB);
  const bf16_t* raw = (const bf16_t*)(p.ws + p.hn);
  bf16_t* mix = (bf16_t*)(p.ws + p.big);
  const int lane = otid() & 63, wv = otid() >> 6, c0 = lane * 16;
  const int W = gridDim.x * 8;
  float wn[2][8]; float dd = 0.f; int auxc;
  if (lane < 32) { load8f(p.in[18] + l * 128 + (c0 & 127), wn[0]); load8f(p.in[18] + l * 128 + (c0 & 127) + 8, wn[1]); auxc = O_GG + c0; }
  else if (lane < 48) { load8f(p.in[21] + l * 64 + (c0 & 63), wn[0]); load8f(p.in[21] + l * 64 + (c0 & 63) + 8, wn[1]); auxc = O_MO + (c0 - 512); }
  else { load8f(p.in[25] + l * 256 + (c0 - 768), wn[0]); load8f(p.in[25] + l * 256 + (c0 - 768) + 8, wn[1]); auxc = O_SZ + (c0 - 768); dd = p.in[24][l * 4 + ((c0 - 768) >> 6)]; }
  uint4 rv[NR][2], ra[NR][2], rx[NR][2], nv[NR][2], na[NR][2], nx[NR][2];
#define MIXO_LOAD(RV, RA, RX, r0_) do { _Pragma("unroll") for (int r = 0; r < NR; ++r) { const int row = (r0_) + r * W; \
      if (row < NTOK) { _Pragma("unroll") for (int j = 0; j < 2; ++j) { RV[r][j] = *(const uint4*)(raw + (size_t)row * DM + c0 + j * 8); RA[r][j] = *(const uint4*)(projB + (size_t)row * PBLD + auxc + j * 8); \
          if (lane >= 48) RX[r][j] = *(const uint4*)(convo + (size_t)row * CONVD + 1536 + (c0 - 768) + j * 8); } } } } while (0)
#pragma unroll
  for (int r = 0; r < NR; ++r)
#pragma unroll
    for (int j = 0; j < 2; ++j) rv[r][j] = ra[r][j] = rx[r][j] = nv[r][j] = na[r][j] = nx[r][j] = make_uint4(0u, 0u, 0u, 0u);
  MIXO_LOAD(rv, ra, rx, obid() * 8 + wv);
  for (int row0 = obid() * 8 + wv; row0 < NTOK; row0 += NR * W) {
    if (row0 + NR * W < NTOK) MIXO_LOAD(nv, na, nx, row0 + NR * W);
#pragma unroll
    for (int r = 0; r < NR; ++r) { const int row = row0 + r * W;
      if (row < NTOK) {
        float v[2][8], g[2][8]; float ss = 0.f;
#pragma unroll
        for (int j = 0; j < 2; ++j) { unpack8(rv[r][j], v[j]); unpack8(ra[r][j], g[j]); }
        if (lane >= 48) {
#pragma unroll
          for (int j = 0; j < 2; ++j) { float x[8]; unpack8(rx[r][j], x);
#pragma unroll
            for (int e = 0; e < 8; ++e) v[j][e] = (v[j][e] + dd * x[e]) * siluf(g[j][e]); }
        } else if (lane >= 32) {
#pragma unroll
          for (int j = 0; j < 2; ++j)
#pragma unroll
            for (int e = 0; e < 8; ++e) v[j][e] *= sigmoidf_(g[j][e]);
        }
#pragma unroll
        for (int j = 0; j < 2; ++j)
#pragma unroll
          for (int e = 0; e < 8; ++e) ss += v[j][e] * v[j][e];
        const float s2 = ss + dppf(ss, 0), s4 = s2 + dppf(s2, 1), s8 = s4 + dppf(s4, 2), s16 = s8 + dppf(s8, 3);
        const float rr = lane < 32 ? rsqrtf(s8 * (1.0f / 128.0f) + EPSF) : (lane < 48 ? rsqrtf(s4 * (1.0f / 64.0f) + EPSF) : rsqrtf(s16 * (1.0f / 256.0f) + EPSF));
        float y[2][8];
#pragma unroll
        for (int j = 0; j < 2; ++j)
#pragma unroll
          for (int e = 0; e < 8; ++e) { y[j][e] = v[j][e] * rr * wn[j][e]; if (lane < 32) y[j][e] *= siluf(g[j][e]); }
        *(uint4*)(mix + (size_t)row * DM + c0) = pack8(y[0]); *(uint4*)(mix + (size_t)row * DM + c0 + 8) = pack8(y[1]);
      } }
#pragma unroll
    for (int r = 0; r < NR; ++r)
#pragma unroll
      for (int j = 0; j < 2; ++j) { rv[r][j] = nv[r][j]; ra[r][j] = na[r][j]; rx[r][j] = nx[r][j]; }
  }
#undef MIXO_LOAD
}

__device__ __forceinline__ void phase_act(const Params& p, int l) {
  const bf16_t* G = (const bf16_t*)(p.ws + p.big);
  bf16_t* V = (bf16_t*)(p.ws + p.big + SZ_GV);
  const float* cw = p.in[28] + (size_t)l * 3 * DFF; const float* cb = p.in[29] + (size_t)l * DFF;
  const int gtid = obid() * 512 + otid(), gstride = gridDim.x * 512;
  if (gtid < 372 * 352) {
    const int c0 = (gtid % 352) * 8;
    float w[3][8], bias[8]; load8f(cb + c0, bias);
#pragma unroll
    for (int j = 0; j < 3; ++j) load8f(cw + j * DFF + c0, w[j]);
    uint4 cur[10], nxt[10];
#pragma unroll
    for (int i = 0; i < 10; ++i) cur[i] = nxt[i] = make_uint4(0u, 0u, 0u, 0u);
#define ACT_LOAD(R, ch) do { const int rb_ = (ch) * 4; const bf16_t* q_ = G + (size_t)rb_ * DFF + c0; const bf16_t* v_ = V + (size_t)rb_ * DFF + c0; \
      _Pragma("unroll") for (int i = 0; i < 4; ++i) { R[2 + i] = *(const uint4*)(q_ + (size_t)i * DFF); R[6 + i] = *(const uint4*)(v_ + (size_t)i * DFF); } \
      if ((rb_ & 2047) > 0) { R[0] = *(const uint4*)(q_ - (size_t)2 * DFF); R[1] = *(const uint4*)(q_ - (size_t)DFF); } } while (0)
    int chunk = gtid / 352;
    ACT_LOAD(cur, chunk);
#pragma unroll 1
    for (; chunk < 4092; chunk += 372) {
      if (chunk + 372 < 4092) ACT_LOAD(nxt, chunk + 372);
      const int rbase = chunk * 4, b = rbase >> 11, pos0 = rbase & 2047;
      float g[6][8];
#pragma unroll
      for (int i = 0; i < 4; ++i) unpack8(cur[2 + i], g[2 + i]);
      if (pos0 > 0) { unpack8(cur[0], g[0]); unpack8(cur[1], g[1]); }
      else {
#pragma unroll
        for (int e = 0; e < 8; ++e) { g[0][e] = 0.f; g[1][e] = 0.f; }
      }
#pragma unroll
      for (int i = 0; i < 4; ++i) {
        float y[8], val[8]; unpack8(cur[6 + i], val);
#pragma unroll
        for (int e = 0; e < 8; ++e) { const float t = bias[e] + w[0][e] * g[i][e] + w[1][e] * g[i + 1][e] + w[2][e] * g[i + 2][e];
          const float uu = 0.7978845608028654f * (t + 0.044715f * t * t * t);
          y[e] = (t - t * __builtin_amdgcn_rcpf(1.0f + __expf(2.0f * uu))) * val[e]; }
        *(uint4*)(V + (size_t)(rbase + i) * DFF + c0) = pack8(y);
        if (pos0 == 2044 && i >= 2) store8f(p.out + p.o_pffn + (((size_t)l * 8 + b) * 2 + (i - 2)) * DFF + c0, g[2 + i]);
      }
#pragma unroll
      for (int i = 0; i < 10; ++i) cur[i] = nxt[i];
    }
#undef ACT_LOAD
  }
  for (int it = 4092 * 352 + gtid; it < (NTOK / 4) * 352; it += gstride) {
    const int chunk = it / 352, c0 = (it - chunk * 352) * 8, rbase = chunk * 4;
    int isp, b, pos0; decode_row(rbase, isp, b, pos0);
    uint4 rg[4], rv[4]; float g[6][8];
#pragma unroll
    for (int i = 0; i < 4; ++i) { rg[i] = *(const uint4*)(G + (size_t)(rbase + i) * DFF + c0); rv[i] = *(const uint4*)(V + (size_t)(rbase + i) * DFF + c0); }
    if (isp) {
      if (pos0 > 0) {
#pragma unroll
        for (int j = 0; j < 2; ++j) unpack8(*(const uint4*)(G + (size_t)(rbase - 2 + j) * DFF + c0), g[j]);
      } else {
#pragma unroll
        for (int j = 0; j < 2; ++j)
#pragma unroll
          for (int e = 0; e < 8; ++e) g[j][e] = 0.f;
      }
    } else {
#pragma unroll
      for (int j = 0; j < 2; ++j) load8f(p.in[8] + (((size_t)l * 128 + b) * 2 + j) * DFF + c0, g[j]);
    }
    float w[3][8], bias[8]; load8f(cb + c0, bias);
#pragma unroll
    for (int j = 0; j < 3; ++j) load8f(cw + j * DFF + c0, w[j]);
#pragma unroll
    for (int i = 0; i < 4; ++i) unpack8(rg[i], g[2 + i]);
    const bool lastc = isp ? (pos0 == 2044) : true;
#pragma unroll
    for (int i = 0; i < 4; ++i) {
      float y[8], val[8]; unpack8(rv[i], val);
#pragma unroll
      for (int e = 0; e < 8; ++e) { const float t = bias[e] + w[0][e] * g[i][e] + w[1][e] * g[i + 1][e] + w[2][e] * g[i + 2][e];
        const float uu = 0.7978845608028654f * (t + 0.044715f * t * t * t);
        y[e] = (t - t * __builtin_amdgcn_rcpf(1.0f + __expf(2.0f * uu))) * val[e]; }
      *(uint4*)(V + (size_t)(rbase + i) * DFF + c0) = pack8(y);
      if (lastc && i >= 2) store8f((isp ? p.out + p.o_pffn + (((size_t)l * 8 + b) * 2 + (i - 2)) * DFF : p.out + p.o_sffn + (((size_t)l * 128 + b) * 2 + (i - 2)) * DFF) + c0, g[2 + i]);
    }
  }
}

#define XB_TMO      128
#define XB_XCNT(j)  (256  + 64 * (j))
#define XB_XSUB(j)  (1280 + 64 * (j))
#define XB_XGEN(j)  (2304 + 64 * (j))
#define XB_TOP      3328
#define XB_TOPGEN   3392
#define XCD_BAR_WORDS 3456
#define XB_SPIN_CAP (1u << 22)
__device__ __forceinline__ unsigned xb_ld(unsigned* q)              { return __hip_atomic_load(q, __ATOMIC_RELAXED, __HIP_MEMORY_SCOPE_AGENT); }
__device__ __forceinline__ unsigned xb_add(unsigned* q, unsigned v) { return __hip_atomic_fetch_add(q, v, __ATOMIC_RELAXED, __HIP_MEMORY_SCOPE_AGENT); }
__device__ __forceinline__ unsigned xb_xcc_id() { return (unsigned)__builtin_amdgcn_s_getreg((3 << 11) | 20) & 0xFu; }
#define XB_SPIN(cond, bar) do { unsigned _sp = 0; while (cond) { __builtin_amdgcn_s_sleep(1); \
    if ((++_sp & 255u) == 0u) { if (xb_ld(&(bar)[XB_TMO])) break; if (_sp > XB_SPIN_CAP) { atomicAdd(&(bar)[XB_TMO], 1u); break; } } } } while (0)
struct XcdBarrier { unsigned* bar; unsigned x; volatile LAS unsigned* st; };
__device__ __forceinline__ XcdBarrier xcd_barrier_post(unsigned* bar, volatile LAS unsigned* st) {
  XcdBarrier b; b.bar = bar; b.x = xb_xcc_id(); b.st = st;
  if (threadIdx.x == 0) (void)xb_add(&bar[XB_XCNT(b.x)], 1u);
  return b;
}
__device__ __forceinline__ void xcd_barrier_complete(unsigned* bar, unsigned x, unsigned& nloc, unsigned& nx) {
  const unsigned G = gridDim.x * gridDim.y * gridDim.z;
  unsigned sum, cnt, mine, sp = 0u;
  for (;;) {
    sum = 0u; cnt = 0u; mine = 0u;
#pragma unroll
    for (unsigned j = 0; j < 16; ++j) { const unsigned c = xb_ld(&bar[XB_XCNT(j)]); sum += c; cnt += (c > 0u) ? 1u : 0u; mine = (j == x) ? c : mine; }
    if (sum == G) break;
    __builtin_amdgcn_s_sleep(1);
    if ((++sp & 255u) == 0u) { if (xb_ld(&bar[XB_TMO])) break; if (sp > XB_SPIN_CAP) { atomicAdd(&bar[XB_TMO], 1u); break; } }
  }
  nloc = mine > 0u ? mine : 1u; nx = cnt > 0u ? cnt : 1u;
}
__device__ __forceinline__ void xcd_barrier(const XcdBarrier& b0, const Params& p) {
  XcdBarrier b; b.st = b0.st; b.bar = (unsigned*)(p.ws + p.ctr) + 64; b.x = b0.st[2];
  asm volatile("s_waitcnt vmcnt(0)" ::: "memory");
  __syncthreads();
  if (threadIdx.x == 0) {
    unsigned* bar = b.bar;
    __builtin_amdgcn_s_waitcnt(0);
    unsigned nloc = b.st[0], nx = b.st[1];
    if (nloc == 0u) { xcd_barrier_complete(bar, b.x, nloc, nx); b.st[0] = nloc; b.st[1] = nx; }
    const unsigned old = xb_add(&bar[XB_XSUB(b.x)], 1u);
    const unsigned gen = old / nloc;
    if (old + 1u == (gen + 1u) * nloc) {
      __builtin_amdgcn_fence(__ATOMIC_RELEASE, "agent");
      asm volatile("s_waitcnt vmcnt(0)" ::: "memory");
      const unsigned og = xb_add(&bar[XB_TOP], 1u);
      const unsigned tg = og / nx;
      if (og + 1u == (tg + 1u) * nx) xb_add(&bar[XB_TOPGEN], 1u);
      else XB_SPIN(xb_ld(&bar[XB_TOPGEN]) == tg, bar);
      __builtin_amdgcn_fence(__ATOMIC_ACQUIRE, "agent");
      xb_add(&bar[XB_XGEN(b.x)], 1u);
      asm volatile("s_waitcnt vmcnt(0)" ::: "memory");
    } else {
      XB_SPIN(xb_ld(&bar[XB_XGEN(b.x)]) == gen, bar);
      __builtin_amdgcn_fence(__ATOMIC_ACQUIRE, "agent");
      asm volatile("s_waitcnt vmcnt(0)" ::: "memory");
    }
  }
  __syncthreads();
}

template <class T> __device__ __forceinline__ T* uni(T* q) {
  const unsigned long long v = (unsigned long long)q;
  const unsigned lo = __builtin_amdgcn_readfirstlane((unsigned)v), hi = __builtin_amdgcn_readfirstlane((unsigned)(v >> 32));
  return (T*)(((unsigned long long)hi << 32) | lo);
}
__global__ void __launch_bounds__(512, 2) mk_forward(Params pk) {
  extern __shared__ __attribute__((aligned(16))) unsigned char shm[];
  cg::grid_group grid = cg::this_grid();
  float* ldsf = (float*)shm;
  Params* lp = (Params*)(shm + 131072);
  volatile LAS unsigned* xst = (volatile LAS unsigned*)((LAS unsigned char*)shm + 131072 + 768);
  if (otid() == 0) { *lp = pk; xst[0] = 0u; xst[1] = 0u; xst[2] = 0u; xst[3] = 0u; }
  __syncthreads();
  const Params& p = *lp;
  XcdBarrier xb = xcd_barrier_post((unsigned*)(pk.ws + pk.ctr) + 64, xst);
  if (otid() == 0) xst[2] = xb.x;
  xb.bar = nullptr; xb.x = 0;
  phase_wconv(p, 0, ldsf);
  phase_rowwise(p, true, nullptr, nullptr, p.in[9], (bf16_t*)(p.ws + p.hn), 0);
  if (gridDim.x == 0x7fffffffu) grid.sync();
  xcd_barrier(xb, p);
#pragma unroll 1
  for (int step = 0; step < 22; ++step) {
    const int l = step / 11, s = step - l * 11;
    if (s == 0 || s == 5 || s == 7 || s == 9) {
      pg8::Gemm g; pg8::EpiSplit e;
      bf16_t* big = (bf16_t*)(p.ws + p.big);
      if (s == 0) { g.A = (const bf16_t*)(p.ws + p.hn); g.Bt = (const bf16_t*)(p.ws + p.w_in); g.M = NTOK; g.N = INCP; g.K = 1024;
        e.O1 = big; e.ld1 = CONVD; e.nt1 = 9; e.O2 = (bf16_t*)(p.ws + p.big + SZ_PROJA); e.ld2 = PBLD; }
      else if (s == 5) { g.A = big; g.Bt = (const bf16_t*)(p.ws + p.w_out); g.M = NTOK; g.N = 1024; g.K = 1024;
        e.O1 = (bf16_t*)(p.ws + p.big + SZ_PROJA + SZ_PROJB); e.ld1 = DM; e.nt1 = 1000; e.O2 = e.O1; e.ld2 = DM; }
      else if (s == 7) { g.A = (const bf16_t*)(p.ws + p.hn); g.Bt = (const bf16_t*)(p.ws + p.w_up); g.M = NTOK; g.N = 5632; g.K = 1024;
        e.O1 = big; e.ld1 = DFF; e.nt1 = 11; e.O2 = (bf16_t*)(p.ws + p.big + SZ_GV); e.ld2 = DFF; }
      else { g.A = (const bf16_t*)(p.ws + p.big + SZ_GV); g.Bt = (const bf16_t*)(p.ws + p.w_dn); g.M = NTOK; g.N = 1024; g.K = DFF;
        e.O1 = (bf16_t*)(p.ws + p.hn); e.ld1 = DM; e.nt1 = 1000; e.O2 = e.O1; e.ld2 = DM; }
      g.ld = g.K; e.F = nullptr;
      const bool split = (s == 5 || s == 9);
      if (split) g.M = NPROMPT;
      g.A = uni(g.A); g.Bt = uni(g.Bt); e.O1 = uni(e.O1); e.O2 = uni(e.O2);
      float* outs = uni((float*)(p.ws + p.big + ((size_t)40 << 20)));
#pragma unroll 1
      for (int pass = 0; pass < (split ? 2 : 1); ++pass) {
        pg8::MkOrder S; S.mode = pass;
        if (pass == 0) S.st.init(g.M, g.N, (int)gridDim.x, (int)obid());
        else { S.sl.init(NTOK - NPROMPT, g.N, g.K, (int)gridDim.x, (int)obid()); g.A += (size_t)NPROMPT * g.ld; g.M = NTOK - NPROMPT; g.K = 256; e.F = outs; }
        pg8::gemm_phase<pg8::EpiSplit, pg8::MkOrder, false>((PG8_LAS unsigned char*)shm, g, S, e, nullptr);
      }
    } else if (s == 1) phase_prep(p, l);
    else if (s == 2) phase_gdnT(p, l, (LAS unsigned char*)shm);
    else if (s == 3) phase_mixers(p, l, (LAS float*)shm);
    else if (s == 4) phase_mixout(p, l);
    else if (s == 6) phase_rowwise(p, l == 0, (const bf16_t*)(p.ws + p.big + SZ_PROJA + SZ_PROJB), p.in[10] + l * DM, p.in[11] + l * DM, (bf16_t*)(p.ws + p.hn), 4);
    else if (s == 8) phase_act(p, l);
    else {
      phase_rowwise(p, false, (const bf16_t*)(p.ws + p.hn), p.in[12] + l * DM, l == 0 ? p.in[9] + DM : nullptr, (bf16_t*)(p.ws + p.hn), 11);
      if (l == 0) phase_wconv(p, 1, ldsf);
    }
    if (step < 21) xcd_barrier(xb, p);
  }
}

extern "C" void kernel_launch(void* const* d_in, const int* in_sizes, int n_in, void* d_out, int out_size, void* d_ws, size_t ws_size, hipStream_t stream) {
  constexpr size_t kDynLds = 131072 + 1024;
  static int grid_blocks = 0;
  if (!grid_blocks) {
    int dev = 0, cus = 0, per_cu = 0;
    (void)hipGetDevice(&dev);
    (void)hipDeviceGetAttribute(&cus, hipDeviceAttributeMultiprocessorCount, dev);
    (void)hipFuncSetAttribute((const void*)mk_forward, hipFuncAttributeMaxDynamicSharedMemorySize, (int)kDynLds);
    (void)hipOccupancyMaxActiveBlocksPerMultiprocessor(&per_cu, mk_forward, 512, kDynLds);
    if (per_cu < 1) per_cu = 1;
    grid_blocks = cus * 1;
  }
  Params p{};
  for (int i = 0; i < 31; ++i) p.in[i] = (const float*)d_in[i];
  p.out = (float*)d_out; p.ws = (unsigned char*)d_ws;
  long o = 0;
  o += 16777216L; p.o_ys = o; o += 524288L;
  p.o_pconv = o; o += 2L * 8 * 3 * 2304; p.o_pgdn = o; o += 2L * 8 * 4 * 16384; p.o_pmc = o; o += 2L * 8 * 4 * 4096; p.o_pmn = o; o += 2L * 8 * 4 * 64;
  p.o_pmm = o; o += 2L * 8 * 4; p.o_pssd = o; o += 2L * 8 * 4 * 8192; p.o_pffn = o; o += 2L * 8 * 2 * 2816;
  p.o_sconv = o; o += 2L * 128 * 3 * 2304; p.o_sgdn = o; o += 2L * 128 * 4 * 16384; p.o_smc = o; o += 2L * 128 * 4 * 4096; p.o_smn = o; o += 2L * 128 * 4 * 64;
  p.o_smm = o; o += 2L * 128 * 4; p.o_sssd = o; o += 2L * 128 * 4 * 8192; p.o_sffn = o; o += 2L * 128 * 2 * 2816;
  size_t w = 0;
  p.w_in = w; w += (size_t)INCP * 1024 * 2; p.w_out = w; w += (size_t)1024 * 1024 * 2; p.w_up = w; w += (size_t)5632 * 1024 * 2; p.w_dn = w; w += (size_t)1024 * DFF * 2;
  p.hn = w; w += (size_t)NTOK * DM * 2; p.gates = w; w += (size_t)NTOK * 32 * 4; p.ctr = w; w += 256 + XCD_BAR_WORDS * 4 + 256; p.big = w; w += SZ_PROJA + SZ_PROJB + SZ_PROJA;
  if (w > ws_size || o != (long)out_size) { fprintf(stderr, "workspace/out size mismatch: need %zu have %zu, out %ld vs %d\n", w, ws_size, o, out_size); return; }
  (void)hipMemsetAsync((unsigned char*)d_ws + p.ctr, 0, 256 + XCD_BAR_WORDS * 4, stream);
  void* args[] = {&p};
  hipError_t e = hipLaunchCooperativeKernel((void*)mk_forward, dim3(grid_blocks), dim3(512), args, kDynLds, stream);
  if (e != hipSuccess) fprintf(stderr, "cooperative launch failed: %s (grid %d)\n", hipGetErrorString(e), grid_blocks);
}
```

```cpp
#include <hip/hip_runtime.h>
#include <hip/hip_cooperative_groups.h>
#include <cstdio>
namespace cg = cooperative_groups;
namespace pg8 {
#define PG8_LAS __attribute__((address_space(3)))
}
__device__ __forceinline__ int otid() { int t = threadIdx.x; asm volatile("" : "+v"(t)); return t; }
__device__ __forceinline__ int obid() { int b = blockIdx.x; asm volatile("" : "+s"(b)); return b; }
namespace pg8 {
typedef unsigned short bf16_t;
typedef short bf16x8 __attribute__((ext_vector_type(8)));
typedef float f32x4 __attribute__((ext_vector_type(4)));
typedef unsigned u32x4 __attribute__((ext_vector_type(4)));
constexpr int BM = 256, BK = 64, HALF = 128, HTB = HALF * BK * 2  , STAGE_BYTES = 8 * HTB, NXCD = 8, WGM = 4;

__host__ __device__ __forceinline__ int lds_byte(int r, int c) { const int st = (r >> 4) * 2 + (c >> 5), rr = r & 15, cc = c & 31, ob = rr * 64 + cc * 2; return st * 1024 + (ob ^ (((ob >> 9) & 1) << 5)); }
__host__ __device__ __forceinline__ void stage_rc(int b, int& R, int& C) { const int st = b / 1024, sb = b % 1024, swz = sb ^ (((sb >> 9) & 1) << 5); R = (st >> 1) * 16 + swz / 64; C = (st & 1) * 32 + (swz % 64) / 2; }
__host__ __device__ __forceinline__ int perm32(int rho) { const int n = rho >> 4, i = rho & 15; return 8 * (i >> 2) + 4 * n + (i & 3); }
struct Unit { int pm, pn, koff; };
struct Gemm { const bf16_t* A; const bf16_t* Bt; int M, N, K, ld; };

struct StaticOrder {
    int nM, nN, nwg, G, c;
    __host__ __device__ void init(int M, int N, int G_, int c_) { nM = M / BM; nN = N / BM; nwg = nM * nN; G = G_; c = c_; }
    __host__ __device__ bool next(int i, Unit& u) const {
        const long L = (long)i * G + c; if (L >= nwg) return false;
        int wgid = (int)L; { const int q = nwg / NXCD, r = nwg % NXCD, xcd = wgid % NXCD, off = wgid / NXCD; wgid = (xcd < r ? xcd * (q + 1) : r * (q + 1) + (xcd - r) * q) + off; }
        const int nig = WGM * nN, gid = wgid / nig, fm = gid * WGM, gsz = (nM - fm) < WGM ? (nM - fm) : WGM;
        u.pm = fm + ((wgid % nig) % gsz); u.pn = (wgid % nig) / gsz; u.koff = 0; return true;
    }
    __device__ __forceinline__ void a_ready(const Unit&) const {}
    __device__ __forceinline__ void done(const Unit&) const {}
};
__device__ __forceinline__ unsigned cvt_pk_bf16(float lo, float hi) { unsigned r; asm volatile("v_cvt_pk_bf16_f32 %0, %1, %2" : "=v"(r) : "v"(lo), "v"(hi)); return r; }
struct SliceOrder {
    int nN, nsl, total, G, c;
    __host__ __device__ void init(int M, int N, int Kfull, int G_, int c_) { nN = N / BM; nsl = Kfull / 256; total = (M / BM) * nN * nsl; G = G_; c = c_; }
    __host__ __device__ bool next(int i, Unit& u) const { const int L = i * G + c; if (L >= total) return false; const int t = L / nsl; u.pm = t / nN; u.pn = t - u.pm * nN; u.koff = (L - t * nsl) * 256; return true; }
    __device__ __forceinline__ void a_ready(const Unit&) const {}
    __device__ __forceinline__ void done(const Unit&) const {}
};
struct MkOrder {
    StaticOrder st; SliceOrder sl; int mode;
    __host__ __device__ bool next(int i, Unit& u) const { return mode ? sl.next(i, u) : st.next(i, u); }
    __device__ __forceinline__ void a_ready(const Unit&) const {}
    __device__ __forceinline__ void done(const Unit&) const {}
};
struct EpiSplit {
    static constexpr bool PERM = true, AFTER_DRAIN = false;
    bf16_t* O1; int ld1; int nt1; bf16_t* O2; int ld2; float* F;
    __device__ __forceinline__ void operator()(const f32x4 (&acc)[2][2][4][2], const Unit& u, int wr, int wc, int fr, int fq) const {
        if (F) {
            const int row0 = u.pm * BM + wr * 64 + fr; const int col0 = u.pn * BM + wc * 32 + 8 * fq;
            float* slab = F + (size_t)(u.koff >> 8) * (512 * 1024);
#pragma unroll
            for (int ai = 0; ai < 2; ++ai)
#pragma unroll
                for (int m = 0; m < 4; ++m) { float* rowp = slab + (size_t)(row0 + ai * HALF + m * 16) * 1024 + col0;
#pragma unroll
                    for (int bj = 0; bj < 2; ++bj)
#pragma unroll
                        for (int n = 0; n < 2; ++n) *(f32x4*)(rowp + bj * HALF + 4 * n) = acc[ai][bj][m][n]; }
            return;
        }
        bf16_t* base; int colt, ld;
        if (u.pn < nt1) { base = O1; colt = u.pn * BM; ld = ld1; } else { base = O2; colt = (u.pn - nt1) * BM; ld = ld2; }
        const int row0 = u.pm * BM + wr * 64 + fr; const int col0 = colt + wc * 32 + 8 * fq;
#pragma unroll
        for (int ai = 0; ai < 2; ++ai)
#pragma unroll
            for (int m = 0; m < 4; ++m) { bf16_t* rowp = base + (size_t)(row0 + ai * HALF + m * 16) * ld + col0;
#pragma unroll
                for (int bj = 0; bj < 2; ++bj) { const f32x4 v0 = acc[ai][bj][m][0], v1 = acc[ai][bj][m][1];
                    u32x4 w; w.x = cvt_pk_bf16(v0[0], v0[1]); w.y = cvt_pk_bf16(v0[2], v0[3]); w.z = cvt_pk_bf16(v1[0], v1[1]); w.w = cvt_pk_bf16(v1[2], v1[3]);
                    *(u32x4*)(rowp + bj * HALF) = w; } }
    }
};
template <class Epi, class Sched, bool STAMP = false>
__device__ __forceinline__ void gemm_phase(PG8_LAS unsigned char* lds, const Gemm g, const Sched& S, const Epi& E, unsigned long long* stamps) {
    const int tid = otid(), wid = __builtin_amdgcn_readfirstlane(tid >> 6), lane = tid & 63, wr = wid >> 2, wc = wid & 3, fr = lane & 15, fq = lane >> 4;
    const int K = g.ld, nt = g.K / BK;
    int ts_lo = 0, ts_hi = 0, nts = 0; const unsigned long long rt_entry = STAMP ? (unsigned long long)wall_clock64() : 0ull;
#define PG8_STAMP() do { if (STAMP && wid == 0 && nts < 64) { const unsigned long long _c = (unsigned long long)clock64(); \
        ts_lo = (lane == nts) ? (int)(unsigned)_c : ts_lo; ts_hi = (lane == nts) ? (int)(unsigned)(_c >> 32) : ts_hi; ++nts; } } while (0)
    PG8_STAMP();
    unsigned voffA[2], voffB[2];
#pragma unroll
    for (int i = 0; i < 2; ++i) { int R, C; stage_rc(tid * 16 + i * 8192, R, C); const int Rb = Epi::PERM ? ((R & ~31) + perm32(R & 31)) : R;
        voffA[i] = (unsigned)(R * K + C) * 2u; voffB[i] = (unsigned)(Rb * K + C) * 2u; }
    const size_t kstep = (size_t)(BK * 2);
    const size_t hstep = (size_t)HALF * K * 2;
    const size_t tstep = 2 * hstep;
    const unsigned ldsw = (unsigned)wid * 1024u;
    const int aoff = lds_byte(wr * 64 + fr, fq * 8), boff = lds_byte(wc * 32 + fr, fq * 8);
#define PG8_SA(b, h) (((b) * 2 + (h)) * HTB)
#define PG8_SB(b, h) ((4 + (b) * 2 + (h)) * HTB)
#define PG8_STAGE(bufoff, gbase, voff) do { _Pragma("unroll") for (int _i = 0; _i < 2; ++_i) \
        __builtin_amdgcn_global_load_lds((const unsigned*)((const char*)(gbase) + (voff)[_i]), (PG8_LAS unsigned*)(lds + (bufoff) + ldsw + _i * 8192), 16, 0, 0); } while (0)
#define PG8_LDA(dst, b, h) do { _Pragma("unroll") for (int m = 0; m < 4; ++m) _Pragma("unroll") for (int k = 0; k < 2; ++k) dst[m][k] = *(const PG8_LAS bf16x8*)(lds + PG8_SA(b, h) + aoff + m * 2048 + k * 1024); } while (0)
#define PG8_LDB(dst, b, h) do { _Pragma("unroll") for (int n = 0; n < 2; ++n) _Pragma("unroll") for (int k = 0; k < 2; ++k) dst[n][k] = *(const PG8_LAS bf16x8*)(lds + PG8_SB(b, h) + boff + n * 2048 + k * 1024); } while (0)
#define PG8_MMA(ai, bj, At, Bt) do { __builtin_amdgcn_s_setprio(1); _Pragma("unroll") for (int m = 0; m < 4; ++m) _Pragma("unroll") for (int n = 0; n < 2; ++n) _Pragma("unroll") for (int k = 0; k < 2; ++k) \
        acc[ai][bj][m][n] = __builtin_amdgcn_mfma_f32_16x16x32_bf16(Bt[n][k], At[m][k], acc[ai][bj][m][n], 0, 0, 0); __builtin_amdgcn_s_setprio(0); } while (0)
#define PG8_WAIT_V(n) asm volatile("s_waitcnt vmcnt(" #n ")" ::: "memory")
#define PG8_WAIT_L(n) asm volatile("s_waitcnt lgkmcnt(" #n ")" ::: "memory")
#define PG8_BAR __builtin_amdgcn_s_barrier()
#define PG8_SCHED __builtin_amdgcn_sched_barrier(0)
    Unit cur, nxt; int ui = 0;
    if (!S.next(0, cur)) return;
    f32x4 acc[2][2][4][2];
#pragma unroll
    for (int a = 0; a < 2; ++a)
#pragma unroll
        for (int b = 0; b < 2; ++b)
#pragma unroll
            for (int m = 0; m < 4; ++m)
#pragma unroll
                for (int n = 0; n < 2; ++n) acc[a][b][m][n] = (f32x4){0.f, 0.f, 0.f, 0.f};
    bf16x8 At[4][2], B0[2][2], B1[2][2];
    const char* cA = (const char*)g.A + (size_t)cur.pm * tstep + (size_t)cur.koff * 2; const char* cB = (const char*)g.Bt + (size_t)cur.pn * tstep + (size_t)cur.koff * 2;
    S.a_ready(cur);
    PG8_STAGE(PG8_SB(0, 0), cB, voffB); PG8_STAGE(PG8_SA(0, 0), cA, voffA); PG8_STAGE(PG8_SB(0, 1), cB + hstep, voffB); PG8_STAGE(PG8_SA(0, 1), cA + hstep, voffA);
    if (wr == 1) PG8_BAR;
    PG8_WAIT_V(4); PG8_BAR;
    PG8_STAGE(PG8_SB(1, 0), cB + kstep, voffB); PG8_STAGE(PG8_SA(1, 0), cA + kstep, voffA); PG8_STAGE(PG8_SB(1, 1), cB + hstep + kstep, voffB);
    PG8_WAIT_V(6); PG8_BAR;
    PG8_STAMP();
    for (;;) {
        const bool has_next = S.next(ui + 1, nxt);
        const char* nA = has_next ? (const char*)g.A + (size_t)nxt.pm * tstep + (size_t)nxt.koff * 2 : cA; const char* nB = has_next ? (const char*)g.Bt + (size_t)nxt.pn * tstep + (size_t)nxt.koff * 2 : cB;
        for (int t = 0; t < nt; t += 2) {
            const bool last = (t == nt - 2);
            const char* a1 = cA + (size_t)(t + 1) * kstep;
            const char* a2 = last ? nA : cA + (size_t)(t + 2) * kstep; const char* b2 = last ? nB : cB + (size_t)(t + 2) * kstep;
            const char* a3 = a2 + kstep; const char* b3 = b2 + kstep;
            if (last && has_next) S.a_ready(nxt);
            PG8_LDB(B0, 0, 0); PG8_SCHED; PG8_LDA(At, 0, 0); PG8_STAGE(PG8_SA(1, 1), a1 + hstep, voffA);
            PG8_WAIT_L(8); PG8_BAR; PG8_WAIT_L(0); PG8_MMA(0, 0, At, B0); PG8_BAR; PG8_SCHED;
            PG8_LDB(B1, 0, 1); PG8_STAGE(PG8_SB(0, 0), b2, voffB);
            PG8_BAR; PG8_WAIT_L(0); PG8_MMA(0, 1, At, B1); PG8_BAR;
            PG8_LDA(At, 0, 1); PG8_STAGE(PG8_SA(0, 0), a2, voffA);
            PG8_BAR; PG8_WAIT_L(0); PG8_MMA(1, 0, At, B0); PG8_BAR; PG8_SCHED;
            PG8_STAGE(PG8_SB(0, 1), b2 + hstep, voffB);
            PG8_WAIT_V(6); PG8_BAR; PG8_MMA(1, 1, At, B1); PG8_BAR;
            PG8_LDB(B0, 1, 0); PG8_SCHED; PG8_LDA(At, 1, 0); PG8_STAGE(PG8_SA(0, 1), a2 + hstep, voffA);
            PG8_WAIT_L(8); PG8_BAR; PG8_WAIT_L(0); PG8_MMA(0, 0, At, B0); PG8_BAR; PG8_SCHED;
            PG8_LDB(B1, 1, 1); PG8_STAGE(PG8_SB(1, 0), b3, voffB);
            PG8_BAR; PG8_WAIT_L(0); PG8_MMA(0, 1, At, B1); PG8_BAR;
            PG8_LDA(At, 1, 1); PG8_STAGE(PG8_SA(1, 0), a3, voffA);
            PG8_BAR; PG8_WAIT_L(0); PG8_MMA(1, 0, At, B0); PG8_BAR; PG8_SCHED;
            PG8_STAGE(PG8_SB(1, 1), b3 + hstep, voffB);
            PG8_WAIT_V(6); PG8_BAR; PG8_MMA(1, 1, At, B1); PG8_BAR;
        }
        PG8_STAMP();
        if constexpr (!Epi::AFTER_DRAIN) { E(acc, cur, wr, wc, fr, fq); S.done(cur); }
        PG8_STAMP();
        if (!has_next) break;
#pragma unroll
        for (int a = 0; a < 2; ++a)
#pragma unroll
            for (int b = 0; b < 2; ++b)
#pragma unroll
                for (int m = 0; m < 4; ++m)
#pragma unroll
                    for (int n = 0; n < 2; ++n) acc[a][b][m][n] = (f32x4){0.f, 0.f, 0.f, 0.f};
        cur = nxt; cA = nA; cB = nB; ++ui;
    }
    PG8_WAIT_V(0);
    if (wr == 0) PG8_BAR;
    PG8_BAR;
    if constexpr (Epi::AFTER_DRAIN) { E.fused(acc, cur, wr, wc, fr, fq, lds, wid, lane); S.done(cur); }
    PG8_STAMP();
    if (STAMP && wid == 0) { stamps[lane] = lane < nts ? (((unsigned long long)(unsigned)ts_hi << 32) | (unsigned)ts_lo) : 0ull;
        if (lane == 62) stamps[62] = rt_entry; if (lane == 63) stamps[63] = (unsigned long long)wall_clock64(); }
#undef PG8_STAMP
#undef PG8_SA
#undef PG8_SB
#undef PG8_STAGE
#undef PG8_LDA
#undef PG8_LDB
#undef PG8_MMA
#undef PG8_WAIT_V
#undef PG8_WAIT_L
#undef PG8_BAR
#undef PG8_SCHED
}
}
using pg8::bf16_t;

constexpr int NTOK = 16896, NPROMPT = 16384, DM = 1024, CONVD = 2304, INC = 4116, INCP = 4352, PBLD = 2048, DFF = 2816;
constexpr int O_GG = 0, O_MQ = 520, O_MK = 776, O_MV = 1032, O_MO = 1288, O_MI = 1544, O_MF = 1548, O_SZ = 1552, O_SDT = 1808, O_GA = 512, O_GB = 516;
constexpr float EPSF = 1e-6f;

struct Params {
  const float* in[31];
  float* out;
  unsigned char* ws;
  long o_ys, o_pconv, o_pgdn, o_pmc, o_pmn, o_pmm, o_pssd, o_pffn, o_sconv, o_sgdn, o_smc, o_smn, o_smm, o_sssd, o_sffn;
  size_t w_in, w_out, w_up, w_dn, hn, gates, ctr, big;
};
constexpr size_t SZ_PROJA = (size_t)NTOK * CONVD * 2, SZ_PROJB = (size_t)NTOK * PBLD * 2, SZ_GV = (size_t)NTOK * DFF * 2;

typedef __bf16 bf16x2_n __attribute__((ext_vector_type(2)));
__device__ __forceinline__ unsigned pk2(float a, float b) { bf16x2_n v = {(__bf16)a, (__bf16)b}; return __builtin_bit_cast(unsigned, v); }
__device__ __forceinline__ float bf2f(unsigned short b) { return __uint_as_float((unsigned)b << 16); }
__device__ __forceinline__ void unpack8(const uint4 u, float (&f)[8]) {
  f[0] = __uint_as_float(u.x << 16); f[1] = __uint_as_float(u.x & 0xffff0000u);
  f[2] = __uint_as_float(u.y << 16); f[3] = __uint_as_float(u.y & 0xffff0000u);
  f[4] = __uint_as_float(u.z << 16); f[5] = __uint_as_float(u.z & 0xffff0000u);
  f[6] = __uint_as_float(u.w << 16); f[7] = __uint_as_float(u.w & 0xffff0000u);
}
__device__ __forceinline__ uint4 pack8(const float (&f)[8]) {
  uint4 r; r.x = pk2(f[0], f[1]); r.y = pk2(f[2], f[3]); r.z = pk2(f[4], f[5]); r.w = pk2(f[6], f[7]); return r;
}
__device__ __forceinline__ void load8f(const float* p, float (&f)[8]) {
  const float4 a = *(const float4*)p, b = *(const float4*)(p + 4);
  f[0] = a.x; f[1] = a.y; f[2] = a.z; f[3] = a.w; f[4] = b.x; f[5] = b.y; f[6] = b.z; f[7] = b.w;
}
__device__ __forceinline__ void store8f(float* p, const float (&f)[8]) {
  *(float4*)p = make_float4(f[0], f[1], f[2], f[3]); *(float4*)(p + 4) = make_float4(f[4], f[5], f[6], f[7]);
}
__device__ __forceinline__ float siluf(float x) { return x * __builtin_amdgcn_rcpf(1.0f + __expf(-x)); }
__device__ __forceinline__ float sigmoidf_(float x) { return __builtin_amdgcn_rcpf(1.0f + __expf(-x)); }
__device__ __forceinline__ float softplusf_(float x) { return x > 20.0f ? x : log1pf(expf(x)); }
__device__ __forceinline__ float dppf(float x, const int ctrl_sel) {
  int v = __float_as_int(x), r;
  if (ctrl_sel == 0) r = __builtin_amdgcn_update_dpp(0, v, 0xB1, 0xf, 0xf, true);
  else if (ctrl_sel == 1) r = __builtin_amdgcn_update_dpp(0, v, 0x4E, 0xf, 0xf, true);
  else if (ctrl_sel == 2) r = __builtin_amdgcn_update_dpp(0, v, 0x141, 0xf, 0xf, true);
  else r = __builtin_amdgcn_update_dpp(0, v, 0x140, 0xf, 0xf, true);
  return __int_as_float(r);
}
__device__ __forceinline__ float sum8(float x) { x += dppf(x, 0); x += dppf(x, 1); x += dppf(x, 2); return x; }
__device__ __forceinline__ float sum16(float x) { x += dppf(x, 0); x += dppf(x, 1); x += dppf(x, 2); x += dppf(x, 3); return x; }
__device__ __forceinline__ float wave_sum(float x) {
  x = sum16(x);
  const int v = __float_as_int(x);
  return __int_as_float(__builtin_amdgcn_readlane(v, 0)) + __int_as_float(__builtin_amdgcn_readlane(v, 16)) + (__int_as_float(__builtin_amdgcn_readlane(v, 32)) + __int_as_float(__builtin_amdgcn_readlane(v, 48)));
}
__device__ __forceinline__ void decode_row(int row, int& isp, int& b, int& pos) {
  if (row < NPROMPT) { isp = 1; b = row >> 11; pos = row & 2047; } else { isp = 0; const int r = row - NPROMPT; b = r >> 2; pos = r & 3; }
}

__device__ __forceinline__ void phase_wconv(const Params& p, int l, float* tile) {
  const int tid = otid();
  const int T0 = 16 * 68 / 4, T1 = T0 + 16 * 16 / 4, T2 = T1 + 16 * 88 / 4, T3 = T2 + 44 * 16 / 4;
  for (int t = obid(); t < T3; t += gridDim.x) {
    const float* src; bf16_t* dst; int K, N, nk, tt;
    if (t < T0) { src = p.in[13] + (size_t)l * 1024 * INC; dst = (bf16_t*)(p.ws + p.w_in); K = 1024; N = INC; nk = 4; tt = t; }
    else if (t < T1) { src = p.in[26] + (size_t)l * 1024 * 1024; dst = (bf16_t*)(p.ws + p.w_out); K = 1024; N = 1024; nk = 4; tt = t - T0; }
    else if (t < T2) { src = p.in[27] + (size_t)l * 1024 * 5632; dst = (bf16_t*)(p.ws + p.w_up); K = 1024; N = 5632; nk = 4; tt = t - T1; }
    else { src = p.in[30] + (size_t)l * DFF * 1024; dst = (bf16_t*)(p.ws + p.w_dn); K = DFF; N = 1024; nk = 11; tt = t - T2; }
    const int k0 = (tt % nk) * 256, n0 = (tt / nk) * 64;
    float v[32];
    { const int nn = tid & 63; const bool ok = n0 + nn < N; const float* sp = src + (size_t)(k0 + (tid >> 6)) * N + n0 + nn;
#pragma unroll
      for (int i = 0; i < 32; ++i) v[i] = ok ? sp[(size_t)(8 * i) * N] : 0.0f;
#pragma unroll
      for (int i = 0; i < 32; ++i) tile[nn * 257 + (tid >> 6) + 8 * i] = v[i]; }
    __syncthreads();
    { const int kp = tid & 127;
#pragma unroll
      for (int i = 0; i < 16; ++i) { const int nn = (tid >> 7) + 4 * i;
        *(unsigned*)(dst + (size_t)(n0 + nn) * K + k0 + 2 * kp) = pk2(tile[nn * 257 + 2 * kp], tile[nn * 257 + 2 * kp + 1]); } }
    __syncthreads();
  }
}

__device__ __forceinline__ void rw_row(const Params& p, int row, float (&x)[2][8], const float (&o)[2][8], bool hasadd, bool hasnorm, const float (&wa)[2][8], const float (&wn)[2][8], bf16_t* hn, int lane) {
  float* xr = p.out + (size_t)row * DM;
  if (hasadd) {
    float ss = 0.f;
#pragma unroll
    for (int j = 0; j < 2; ++j)
#pragma unroll
      for (int e = 0; e < 8; ++e) ss += o[j][e] * o[j][e];
    ss = wave_sum(ss); const float rr = rsqrtf(ss * (1.0f / DM) + EPSF);
#pragma unroll
    for (int j = 0; j < 2; ++j)
#pragma unroll
      for (int e = 0; e < 8; ++e) x[j][e] += o[j][e] * rr * wa[j][e];
    if (hasnorm) {
#pragma unroll
      for (int j = 0; j < 2; ++j) *(uint4*)((bf16_t*)xr + DM + j * 512 + lane * 8) = pack8(x[j]);
    } else {
#pragma unroll
      for (int j = 0; j < 2; ++j) store8f(xr + j * 512 + lane * 8, x[j]);
    }
  }
  if (hasnorm) {
    float ss = 0.f;
#pragma unroll
    for (int j = 0; j < 2; ++j)
#pragma unroll
      for (int e = 0; e < 8; ++e) ss += x[j][e] * x[j][e];
    ss = wave_sum(ss); const float rr = rsqrtf(ss * (1.0f / DM) + EPSF);
#pragma unroll
    for (int j = 0; j < 2; ++j) { float y[8];
#pragma unroll
      for (int e = 0; e < 8; ++e) y[e] = x[j][e] * rr * wn[j][e];
      *(uint4*)(hn + (size_t)row * DM + j * 512 + lane * 8) = pack8(y); }
  }
}
__device__ __forceinline__ void phase_rowwise(const Params& p, bool first, const bf16_t* add, const float* w_add, const float* w_norm, bf16_t* hn, int nsl) {
  constexpr int NR = 2;
  const int lane = otid() & 63, wv = otid() >> 6;
  const int W = gridDim.x * 8, gw = obid() * 8 + wv;
  const bool hasadd = add != nullptr, hasnorm = w_norm != nullptr;
  float wa[2][8], wn[2][8];
#pragma unroll
  for (int j = 0; j < 2; ++j) {
    if (hasadd) load8f(w_add + j * 512 + lane * 8, wa[j]);
    if (hasnorm) load8f(w_norm + j * 512 + lane * 8, wn[j]);
  }
  uint4 cx[NR][4], co[NR][2], nx[NR][4], no[NR][2];
#pragma unroll
  for (int r = 0; r < NR; ++r) { cx[r][0] = cx[r][1] = cx[r][2] = cx[r][3] = co[r][0] = co[r][1] = make_uint4(0u, 0u, 0u, 0u); nx[r][0] = nx[r][1] = nx[r][2] = nx[r][3] = no[r][0] = no[r][1] = make_uint4(0u, 0u, 0u, 0u); }
#define RW_LOAD(X, O, r0_) do { _Pragma("unroll") for (int r = 0; r < NR; ++r) { const int row = (r0_) + r * W; \
      if (row < NPROMPT) { \
        if (first) { const float* xi = p.in[0] + (size_t)row * DM + lane * 8; X[r][0] = *(const uint4*)xi; X[r][1] = *(const uint4*)(xi + 4); X[r][2] = *(const uint4*)(xi + 512); X[r][3] = *(const uint4*)(xi + 516); } \
        else { const bf16_t* xb = (const bf16_t*)(p.out + (size_t)row * DM) + DM + lane * 8; X[r][0] = *(const uint4*)xb; X[r][2] = *(const uint4*)(xb + 512); } \
        if (hasadd) { O[r][0] = *(const uint4*)(add + (size_t)row * DM + lane * 8); O[r][1] = *(const uint4*)(add + (size_t)row * DM + 512 + lane * 8); } } } } while (0)
  RW_LOAD(cx, co, gw);
  for (int row0 = gw; row0 < NPROMPT; row0 += NR * W) {
    if (row0 + NR * W < NPROMPT) RW_LOAD(nx, no, row0 + NR * W);
#pragma unroll
    for (int r = 0; r < NR; ++r) { const int row = row0 + r * W;
      if (row < NPROMPT) {
        float x[2][8], o[2][8];
#pragma unroll
        for (int j = 0; j < 2; ++j) {
          if (first) { x[j][0] = __uint_as_float(cx[r][2 * j].x); x[j][1] = __uint_as_float(cx[r][2 * j].y); x[j][2] = __uint_as_float(cx[r][2 * j].z); x[j][3] = __uint_as_float(cx[r][2 * j].w);
            x[j][4] = __uint_as_float(cx[r][2 * j + 1].x); x[j][5] = __uint_as_float(cx[r][2 * j + 1].y); x[j][6] = __uint_as_float(cx[r][2 * j + 1].z); x[j][7] = __uint_as_float(cx[r][2 * j + 1].w); }
          else unpack8(cx[r][2 * j], x[j]);
          if (hasadd) unpack8(co[r][j], o[j]);
        }
        rw_row(p, row, x, o, hasadd, hasnorm, wa, wn, hn, lane);
      } }
#pragma unroll
    for (int r = 0; r < NR; ++r) { cx[r][0] = nx[r][0]; cx[r][1] = nx[r][1]; cx[r][2] = nx[r][2]; cx[r][3] = nx[r][3]; co[r][0] = no[r][0]; co[r][1] = no[r][1]; }
  }
#undef RW_LOAD
  for (int row = NPROMPT + gw; row < NTOK; row += W) {
    float x[2][8], o[2][8];
#pragma unroll
    for (int j = 0; j < 2; ++j) {
      if (first) load8f(p.in[1] + (size_t)(row - NPROMPT) * DM + j * 512 + lane * 8, x[j]);
      else unpack8(*(const uint4*)((const bf16_t*)(p.out + (size_t)row * DM) + DM + j * 512 + lane * 8), x[j]);
      if (hasadd) { const float* of = (const float*)(p.ws + p.big + ((size_t)40 << 20)) + (size_t)(row - NPROMPT) * DM + j * 512 + lane * 8; load8f(of, o[j]);
        for (int ks = 1; ks < nsl; ++ks) { float t8[8]; load8f(of + (size_t)ks * (512 * 1024), t8);
#pragma unroll
          for (int e = 0; e < 8; ++e) o[j][e] += t8[e]; } }
    }
    rw_row(p, row, x, o, hasadd, hasnorm, wa, wn, hn, lane);
  }
}

__device__ __forceinline__ void phase_prep(const Params& p, int l) {
  const bf16_t* projA = (const bf16_t*)(p.ws + p.big);
  const bf16_t* projB = (const bf16_t*)(p.ws + p.big + SZ_PROJA);
  bf16_t* convo = (bf16_t*)(p.ws + p.big + SZ_PROJA + SZ_PROJB);
  float* gates = (float*)(p.ws + p.gates);
  const float* cw = p.in[14] + (size_t)l * 4 * CONVD; const float* cb = p.in[15] + (size_t)l * CONVD;
  const int gtid = obid() * 512 + otid(), gstride = gridDim.x * 512;
  if (gtid < 455 * 288) {
    const int v = gtid % 288, c0 = v * 8;
    float w[4][8], bias[8]; load8f(cb + c0, bias);
#pragma unroll
    for (int j = 0; j < 4; ++j) load8f(cw + j * CONVD + c0, w[j]);
    uint4 cur[7], nxt[7];
#pragma unroll
    for (int i = 0; i < 7; ++i) cur[i] = nxt[i] = make_uint4(0u, 0u, 0u, 0u);
#define PREP_LOAD(R, ch) do { const int rb_ = (ch) * 4; const bf16_t* q_ = projA + (size_t)rb_ * CONVD + c0; \
      _Pragma("unroll") for (int i = 0; i < 4; ++i) R[3 + i] = *(const uint4*)(q_ + (size_t)i * CONVD); \
      if ((rb_ & 2047) > 0) { _Pragma("unroll") for (int j = 0; j < 3; ++j) R[j] = *(const uint4*)(q_ - (size_t)(3 - j) * CONVD); } } while (0)
    int chunk = gtid / 288;
    PREP_LOAD(cur, chunk);
#pragma unroll 1
    for (; chunk < 4095; chunk += 455) {
      if (chunk + 455 < 4095) PREP_LOAD(nxt, chunk + 455);
      const int rbase = chunk * 4, b = rbase >> 11, pos0 = rbase & 2047;
      float xp[7][8];
#pragma unroll
      for (int i = 0; i < 4; ++i) unpack8(cur[3 + i], xp[3 + i]);
      if (pos0 > 0) {
#pragma unroll
        for (int j = 0; j < 3; ++j) unpack8(cur[j], xp[j]);
      } else {
#pragma unroll
        for (int j = 0; j < 3; ++j)
#pragma unroll
          for (int e = 0; e < 8; ++e) xp[j][e] = 0.f;
      }
#pragma unroll
      for (int i = 0; i < 4; ++i) {
        float y[8];
#pragma unroll
        for (int e = 0; e < 8; ++e) y[e] = siluf(bias[e] + w[0][e] * xp[i][e] + w[1][e] * xp[i + 1][e] + w[2][e] * xp[i + 2][e] + w[3][e] * xp[i + 3][e]);
        if (c0 < 1024) {
          float ss = 0.f;
#pragma unroll
          for (int e = 0; e < 8; ++e) ss += y[e] * y[e];
          ss = sum16(ss);
          const float sc = rsqrtf(ss + EPSF) * (c0 < 512 ? 0.08838834764831845f : 1.0f);
#pragma unroll
          for (int e = 0; e < 8; ++e) y[e] *= sc;
        }
        *(uint4*)(convo + (size_t)(rbase + i) * CONVD + c0) = pack8(y);
        if (pos0 == 2044 && i >= 1) store8f(p.out + p.o_pconv + (((size_t)l * 8 + b) * 3 + (i - 1)) * CONVD + c0, xp[3 + i]);
      }
#pragma unroll
      for (int i = 0; i < 7; ++i) cur[i] = nxt[i];
    }
#undef PREP_LOAD
  }
  for (int it = 4095 * 288 + gtid; it < (NTOK / 4) * 288; it += gstride) {
    const int chunk = it / 288, v = it - chunk * 288, c0 = v * 8, rbase = chunk * 4;
    int isp, b, pos0; decode_row(rbase, isp, b, pos0);
    uint4 rw[4]; float xp[7][8];
#pragma unroll
    for (int i = 0; i < 4; ++i) rw[i] = *(const uint4*)(projA + (size_t)(rbase + i) * CONVD + c0);
    if (isp) {
      if (pos0 > 0) {
#pragma unroll
        for (int j = 0; j < 3; ++j) unpack8(*(const uint4*)(projA + (size_t)(rbase - 3 + j) * CONVD + c0), xp[j]);
      } else {
#pragma unroll
        for (int j = 0; j < 3; ++j)
#pragma unroll
          for (int e = 0; e < 8; ++e) xp[j][e] = 0.f;
      }
    } else {
#pragma unroll
      for (int j = 0; j < 3; ++j) load8f(p.in[2] + (((size_t)l * 128 + b) * 3 + j) * CONVD + c0, xp[j]);
    }
    float w[4][8], bias[8]; load8f(cb + c0, bias);
#pragma unroll
    for (int j = 0; j < 4; ++j) load8f(cw + j * CONVD + c0, w[j]);
#pragma unroll
    for (int i = 0; i < 4; ++i) unpack8(rw[i], xp[3 + i]);
    const bool lastc = isp ? (pos0 == 2044) : true;
#pragma unroll
    for (int i = 0; i < 4; ++i) {
      float y[8];
#pragma unroll
      for (int e = 0; e < 8; ++e) y[e] = siluf(bias[e] + w[0][e] * xp[i][e] + w[1][e] * xp[i + 1][e] + w[2][e] * xp[i + 2][e] + w[3][e] * xp[i + 3][e]);
      if (c0 < 1024) {
        float ss = 0.f;
#pragma unroll
        for (int e = 0; e < 8; ++e) ss += y[e] * y[e];
        ss = sum16(ss);
        const float sc = rsqrtf(ss + EPSF) * (c0 < 512 ? 0.08838834764831845f : 1.0f);
#pragma unroll
        for (int e = 0; e < 8; ++e) y[e] *= sc;
      }
      *(uint4*)(convo + (size_t)(rbase + i) * CONVD + c0) = pack8(y);
      if (lastc && i >= 1) store8f((isp ? p.out + p.o_pconv + (((size_t)l * 8 + b) * 3 + (i - 1)) * CONVD : p.out + p.o_sconv + (((size_t)l * 128 + b) * 3 + (i - 1)) * CONVD) + c0, xp[3 + i]);
    }
  }
  for (int i = (gtid >= 129 * 288 ? gtid - 129 * 288 : gtid - 129 * 288 + gstride); i < NTOK * 4; i += gstride) {
    const int row = i >> 2, h = i & 3;
    const bf16_t* pb = projB + (size_t)row * PBLD;
    const float ga = bf2f(pb[O_GA + h]), gb = bf2f(pb[O_GB + h]), mi = bf2f(pb[O_MI + h]), mf = bf2f(pb[O_MF + h]), sdt = bf2f(pb[O_SDT + h]);
    float* g = gates + (size_t)row * 32;
    g[h] = -expf(p.in[16][l * 4 + h]) * softplusf_(ga + p.in[17][l * 4 + h]);
    g[4 + h] = sigmoidf_(gb);
    g[8 + h] = mi + p.in[19][l * 4 + h];
    g[12 + h] = -softplusf_(-(mf + p.in[20][l * 4 + h]));
    const float dt = softplusf_(sdt + p.in[23][l * 4 + h]);
    g[16 + h] = dt;
    g[20 + h] = dt * (-expf(p.in[22][l * 4 + h]));
  }
}

typedef float f2 __attribute__((ext_vector_type(2)));
typedef float f4 __attribute__((ext_vector_type(4)));
#define LAS __attribute__((address_space(3)))
constexpr int TC = 32;
__device__ __forceinline__ void lds_store8(LAS float* q, const float (&f)[8]) { *(LAS f4*)q = (f4){f[0], f[1], f[2], f[3]}; *(LAS f4*)(q + 4) = (f4){f[4], f[5], f[6], f[7]}; }
__device__ __forceinline__ float hsum(f2 a) { return a.x + a.y; }

__device__ __forceinline__ void gdn_item(const Params& p, LAS float* lds, int row0, int T, int h, int sl, float* sout) {
  const int tid = otid(), cl = tid >> 4, s = tid & 15, col = sl * 32 + cl;
  const bf16_t* convo = (const bf16_t*)(p.ws + p.big + SZ_PROJA + SZ_PROJB);
  const float* gates = (const float*)(p.ws + p.gates);
  bf16_t* raw = (bf16_t*)(p.ws + p.hn);
  constexpr int BUF = 9344;
  LAS float* obuf = lds + 2 * BUF;
  f2 S[4];
#pragma unroll
  for (int i = 0; i < 4; ++i) S[i] = (f2){0.f, 0.f};
  const int nch = T / TC;
  uint4 rq, rk, rv; float ra = 0.f, rb = 0.f;
  rq = rk = rv = make_uint4(0, 0, 0, 0);
  const int tt = tid >> 4, cv = tid & 15;
#define GDN_LOAD(c) do { { const bf16_t* r_ = convo + (size_t)(row0 + (c) * TC + tt) * CONVD + h * 128 + cv * 8; rq = *(const uint4*)r_; rk = *(const uint4*)(r_ + 512); } \
    if (tid < 128) rv = *(const uint4*)(convo + (size_t)(row0 + (c) * TC + (tid >> 2)) * CONVD + 1024 + h * 128 + sl * 32 + (tid & 3) * 8); \
    else if (tid < 160) { const float* g_ = gates + (size_t)(row0 + (c) * TC + (tid - 128)) * 32; ra = __expf(g_[h]); rb = g_[4 + h]; } } while (0)
#define GDN_STORE(buf) do { float fq_[8], fk_[8]; unpack8(rq, fq_); unpack8(rk, fk_); lds_store8((buf) + tt * 128 + cv * 8, fq_); lds_store8((buf) + 4096 + tt * 128 + cv * 8, fk_); \
    float d_ = 0.f; _Pragma("unroll") for (int e = 0; e < 8; ++e) d_ += fq_[e] * fk_[e]; d_ = sum16(d_); if (cv == 0) (buf)[9216 + tt * 4 + 2] = d_; \
    if (tid < 128) { unpack8(rv, fq_); lds_store8((buf) + 8192 + (tid >> 2) * 32 + (tid & 3) * 8, fq_); } \
    else if (tid < 160) { (buf)[9216 + (tid - 128) * 4] = ra; (buf)[9216 + (tid - 128) * 4 + 1] = rb; } } while (0)
  __syncthreads();
  GDN_LOAD(0); GDN_STORE(lds); __syncthreads();
  for (int c = 0; c < nch; ++c) {
    const LAS float* buf = lds + (c & 1) * BUF;
    if (c + 1 < nch) GDN_LOAD(c + 1);
    f4 kA_l, kA_h, qA_l, qA_h, scA, kB_l, kB_h, qB_l, qB_h, scB; float vA, vB;
#define GDN_FETCH(X, t) do { const int t_ = (t); k##X##_l = *(const LAS f4*)(buf + 4096 + t_ * 128 + 8 * s); k##X##_h = *(const LAS f4*)(buf + 4096 + t_ * 128 + 8 * s + 4); \
      q##X##_l = *(const LAS f4*)(buf + t_ * 128 + 8 * s); q##X##_h = *(const LAS f4*)(buf + t_ * 128 + 8 * s + 4); v##X = buf[8192 + t_ * 32 + cl]; sc##X = *(const LAS f4*)(buf + 9216 + t_ * 4); } while (0)
#define GDN_STEP(X, t) do { const f2 k0 = {k##X##_l.x, k##X##_l.y}, k1 = {k##X##_l.z, k##X##_l.w}, k2 = {k##X##_h.x, k##X##_h.y}, k3 = {k##X##_h.z, k##X##_h.w}; \
      const f2 q0 = {q##X##_l.x, q##X##_l.y}, q1 = {q##X##_l.z, q##X##_l.w}, q2 = {q##X##_h.x, q##X##_h.y}, q3 = {q##X##_h.z, q##X##_h.w}; \
      f2 t0 = k0 * S[0], t1 = k2 * S[2], u0 = q0 * S[0], u1 = q2 * S[2]; t0 = k1 * S[1] + t0; t1 = k3 * S[3] + t1; u0 = q1 * S[1] + u0; u1 = q3 * S[3] + u1; \
      float pk = hsum(t0 + t1), pq = hsum(u0 + u1); pk = sum16(pk); pq = sum16(pq); \
      const float a = sc##X.x, r = sc##X.y * (v##X - a * pk), o = a * pq + sc##X.z * r; const f2 a2 = {a, a}, r2 = {r, r}; \
      S[0] = k0 * r2 + a2 * S[0]; S[1] = k1 * r2 + a2 * S[1]; S[2] = k2 * r2 + a2 * S[2]; S[3] = k3 * r2 + a2 * S[3]; \
      if (s == 0) obuf[(t) * 32 + cl] = o; } while (0)
    GDN_FETCH(A, 0);
#pragma unroll 1
    for (int t = 0; t < TC; t += 2) {
      GDN_FETCH(B, t + 1);
      GDN_STEP(A, t);
      GDN_FETCH(A, min(t + 2, TC - 1));
      GDN_STEP(B, t + 1);
    }
    __syncthreads();
    { const int cp = cv * 2; const unsigned w = pk2(obuf[tt * 32 + cp], obuf[tt * 32 + cp + 1]);
      *(unsigned*)(raw + (size_t)(row0 + c * TC + tt) * DM + h * 128 + sl * 32 + cp) = w; }
    if (c + 1 < nch) { LAS float* nb = lds + ((c + 1) & 1) * BUF; GDN_STORE(nb); }
    __syncthreads();
  }
#pragma unroll
  for (int i = 0; i < 4; ++i) { sout[(size_t)(8 * s + 2 * i) * 128 + col] = S[i].x; sout[(size_t)(8 * s + 2 * i + 1) * 128 + col] = S[i].y; }
#undef GDN_LOAD
#undef GDN_STORE
#undef GDN_FETCH
#undef GDN_STEP
}

__device__ __forceinline__ void ssd_item(const Params& p, LAS float* lds, int row0, int T, int h, int half, float* hout) {
  const int tid = otid(), pl = tid >> 4, s = tid & 15, grp = h >> 1;
  const bf16_t* convo = (const bf16_t*)(p.ws + p.big + SZ_PROJA + SZ_PROJB);
  const float* gates = (const float*)(p.ws + p.gates);
  bf16_t* raw = (bf16_t*)(p.ws + p.hn);
  constexpr int BUF = 9344;
  LAS float* obuf = lds + 2 * BUF;
  f2 H[4];
#pragma unroll
  for (int i = 0; i < 4; ++i) H[i] = (f2){0.f, 0.f};
  const int nch = T / TC;
  uint4 rB, rC, rx; float rdt = 0.f, rda = 0.f; rB = rC = rx = make_uint4(0, 0, 0, 0);
  const int tt = tid >> 4, cv = tid & 15;
#define SSD_LOAD(c) do { { const bf16_t* r_ = convo + (size_t)(row0 + (c) * TC + tt) * CONVD + grp * 128 + cv * 8; rB = *(const uint4*)(r_ + 1792); rC = *(const uint4*)(r_ + 2048); } \
    if (tid < 128) rx = *(const uint4*)(convo + (size_t)(row0 + (c) * TC + (tid >> 2)) * CONVD + 1536 + h * 64 + half * 32 + (tid & 3) * 8); \
    else if (tid < 160) { const float* g_ = gates + (size_t)(row0 + (c) * TC + (tid - 128)) * 32; rdt = g_[16 + h]; rda = __expf(g_[20 + h]); } } while (0)
#define SSD_STORE(buf) do { float fb_[8], fc_[8]; unpack8(rB, fb_); unpack8(rC, fc_); lds_store8((buf) + 1024 + tt * 128 + cv * 8, fb_); lds_store8((buf) + 5120 + tt * 128 + cv * 8, fc_); \
    float d_ = 0.f; _Pragma("unroll") for (int e = 0; e < 8; ++e) d_ += fb_[e] * fc_[e]; d_ = sum16(d_); if (cv == 0) (buf)[9216 + tt * 4 + 2] = d_; \
    if (tid < 128) { unpack8(rx, fb_); lds_store8((buf) + (tid >> 2) * 32 + (tid & 3) * 8, fb_); } \
    else if (tid < 160) { (buf)[9216 + (tid - 128) * 4] = rda; (buf)[9216 + (tid - 128) * 4 + 1] = rdt; } } while (0)
  __syncthreads();
  SSD_LOAD(0); SSD_STORE(lds); __syncthreads();
  for (int c = 0; c < nch; ++c) {
    const LAS float* buf = lds + (c & 1) * BUF;
    if (c + 1 < nch) SSD_LOAD(c + 1);
    f4 bA_l, bA_h, cA_l, cA_h, scA, bB_l, bB_h, cB_l, cB_h, scB; float xA, xB;
#define SSD_FETCH(X, t) do { const int t_ = (t); b##X##_l = *(const LAS f4*)(buf + 1024 + t_ * 128 + 8 * s); b##X##_h = *(const LAS f4*)(buf + 1024 + t_ * 128 + 8 * s + 4); \
      c##X##_l = *(const LAS f4*)(buf + 5120 + t_ * 128 + 8 * s); c##X##_h = *(const LAS f4*)(buf + 5120 + t_ * 128 + 8 * s + 4); x##X = buf[t_ * 32 + pl]; sc##X = *(const LAS f4*)(buf + 9216 + t_ * 4); } while (0)
#define SSD_STEP(X, t) do { const f2 b0 = {b##X##_l.x, b##X##_l.y}, b1 = {b##X##_l.z, b##X##_l.w}, b2 = {b##X##_h.x, b##X##_h.y}, b3 = {b##X##_h.z, b##X##_h.w}; \
      const f2 c0 = {c##X##_l.x, c##X##_l.y}, c1 = {c##X##_l.z, c##X##_l.w}, c2 = {c##X##_h.x, c##X##_h.y}, c3 = {c##X##_h.z, c##X##_h.w}; \
      f2 t0 = c0 * H[0], t1 = c2 * H[2]; t0 = c1 * H[1] + t0; t1 = c3 * H[3] + t1; \
      float pc = hsum(t0 + t1); pc = sum16(pc); \
      const float dA = sc##X.x, dtx = sc##X.y * x##X, y = dA * pc + dtx * sc##X.z; const f2 a2 = {dA, dA}, r2 = {dtx, dtx}; \
      H[0] = b0 * r2 + a2 * H[0]; H[1] = b1 * r2 + a2 * H[1]; H[2] = b2 * r2 + a2 * H[2]; H[3] = b3 * r2 + a2 * H[3]; \
      if (s == 0) obuf[(t) * 32 + pl] = y; } while (0)
    SSD_FETCH(A, 0);
#pragma unroll 1
    for (int t = 0; t < TC; t += 2) {
      SSD_FETCH(B, t + 1);
      SSD_STEP(A, t);
      SSD_FETCH(A, min(t + 2, TC - 1));
      SSD_STEP(B, t + 1);
    }
    __syncthreads();
    { const int cp = cv * 2; const unsigned w = pk2(obuf[tt * 32 + cp], obuf[tt * 32 + cp + 1]);
      *(unsigned*)(raw + (size_t)(row0 + c * TC + tt) * DM + 768 + h * 64 + half * 32 + cp) = w; }
    if (c + 1 < nch) { LAS float* nb = lds + ((c + 1) & 1) * BUF; SSD_STORE(nb); }
    __syncthreads();
  }
  { float* ho = hout + (size_t)(half * 32 + pl) * 128 + 8 * s;
    *(float4*)ho = make_float4(H[0].x, H[0].y, H[1].x, H[1].y); *(float4*)(ho + 4) = make_float4(H[2].x, H[2].y, H[3].x, H[3].y); }
#undef SSD_LOAD
#undef SSD_STORE
#undef SSD_FETCH
#undef SSD_STEP
}

__device__ __forceinline__ void mlstm_item(const Params& p, LAS float* lds, int row0, int T, int h, float* cout, float* nout, float* mout) {
  const int tid = otid(), col = tid >> 3, s = tid & 7, lane = tid & 63;
  const bf16_t* projB = (const bf16_t*)(p.ws + p.big + SZ_PROJA);
  const float* gates = (const float*)(p.ws + p.gates);
  bf16_t* raw = (bf16_t*)(p.ws + p.hn);
  constexpr int BUF = 6272;
  LAS float* obuf = lds + 2 * BUF;
  f2 C[4], n[4];
#pragma unroll
  for (int i = 0; i < 4; ++i) { C[i] = (f2){0.f, 0.f}; n[i] = (f2){0.f, 0.f}; }
  float mcar = 0.f;
  const int nch = T / TC;
  uint4 r0, r1; float rli = 0.f, rlf = 0.f; r0 = r1 = make_uint4(0, 0, 0, 0);
  const int u = tid & 255, tt = u >> 3, cv = u & 7;
#define ML_LOAD(c) do { const bf16_t* r_ = projB + (size_t)(row0 + (c) * TC + tt) * PBLD + h * 64 + cv * 8; \
    if (tid < 256) { r0 = *(const uint4*)(r_ + O_MQ); r1 = *(const uint4*)(r_ + O_MK); } else { r0 = *(const uint4*)(r_ + O_MV); \
      if (tid < 288) { const float* g_ = gates + (size_t)(row0 + (c) * TC + (tid - 256)) * 32; rli = g_[8 + h]; rlf = g_[12 + h]; } } } while (0)
#define ML_STORE(buf) do { float f0_[8], f1_[8]; unpack8(r0, f0_); \
    if (tid < 256) { unpack8(r1, f1_); _Pragma("unroll") for (int e = 0; e < 8; ++e) f1_[e] *= 0.125f; lds_store8((buf) + tt * 64 + cv * 8, f0_); lds_store8((buf) + 2048 + tt * 64 + cv * 8, f1_); \
      float d_ = 0.f; _Pragma("unroll") for (int e = 0; e < 8; ++e) d_ += f0_[e] * f1_[e]; d_ = sum8(d_); if (cv == 0) (buf)[6144 + tt * 4 + 2] = d_; } \
    else { lds_store8((buf) + 4096 + tt * 64 + cv * 8, f0_); \
      if (tid < 320) {     \
        float F_ = rlf; _Pragma("unroll") for (int o_ = 1; o_ < 32; o_ <<= 1) { const float t_ = __shfl_up(F_, o_); if (lane >= o_) F_ += t_; } \
        float G_ = rli - F_; _Pragma("unroll") for (int o_ = 1; o_ < 32; o_ <<= 1) { const float t_ = __shfl_up(G_, o_); if (lane >= o_) G_ = fmaxf(G_, t_); } \
        const float m_ = F_ + fmaxf(mcar, G_); float mp_ = __shfl_up(m_, 1); if (lane == 0) mp_ = mcar; \
        if (lane < 32) { (buf)[6144 + lane * 4] = __expf(rlf + mp_ - m_); (buf)[6144 + lane * 4 + 1] = __expf(rli - m_); (buf)[6144 + lane * 4 + 3] = __expf(-m_); } \
        mcar = __shfl(m_, 31); } } } while (0)
  __syncthreads();
  ML_LOAD(0); ML_STORE(lds); __syncthreads();
  for (int c = 0; c < nch; ++c) {
    const LAS float* buf = lds + (c & 1) * BUF;
    if (c + 1 < nch) ML_LOAD(c + 1);
    f4 kA_l, kA_h, qA_l, qA_h, scA, kB_l, kB_h, qB_l, qB_h, scB; float vA, vB;
#define ML_FETCH(X, t) do { const int t_ = (t); k##X##_l = *(const LAS f4*)(buf + 2048 + t_ * 64 + 8 * s); k##X##_h = *(const LAS f4*)(buf + 2048 + t_ * 64 + 8 * s + 4); \
      q##X##_l = *(const LAS f4*)(buf + t_ * 64 + 8 * s); q##X##_h = *(const LAS f4*)(buf + t_ * 64 + 8 * s + 4); v##X = buf[4096 + t_ * 64 + col]; sc##X = *(const LAS f4*)(buf + 6144 + t_ * 4); } while (0)
#define ML_STEP(X, t) do { const f2 k0 = {k##X##_l.x, k##X##_l.y}, k1 = {k##X##_l.z, k##X##_l.w}, k2 = {k##X##_h.x, k##X##_h.y}, k3 = {k##X##_h.z, k##X##_h.w}; \
      const f2 q0 = {q##X##_l.x, q##X##_l.y}, q1 = {q##X##_l.z, q##X##_l.w}, q2 = {q##X##_h.x, q##X##_h.y}, q3 = {q##X##_h.z, q##X##_h.w}; \
      f2 t0 = q0 * C[0], t1 = q2 * C[2], u0 = q0 * n[0], u1 = q2 * n[2]; t0 = q1 * C[1] + t0; t1 = q3 * C[3] + t1; u0 = q1 * n[1] + u0; u1 = q3 * n[3] + u1; \
      float pc = hsum(t0 + t1), pn = hsum(u0 + u1); pc = sum8(pc); pn = sum8(pn); \
      const float fp = sc##X.x, ip = sc##X.y, iqk = ip * sc##X.z, num = fp * pc + iqk * v##X; const float den = fmaxf(fabsf(fp * pn + iqk), sc##X.w); \
      const float iv = ip * v##X; const f2 f2_ = {fp, fp}, iv2 = {iv, iv}, ip2 = {ip, ip}; \
      C[0] = k0 * iv2 + f2_ * C[0]; C[1] = k1 * iv2 + f2_ * C[1]; C[2] = k2 * iv2 + f2_ * C[2]; C[3] = k3 * iv2 + f2_ * C[3]; \
      n[0] = k0 * ip2 + f2_ * n[0]; n[1] = k1 * ip2 + f2_ * n[1]; n[2] = k2 * ip2 + f2_ * n[2]; n[3] = k3 * ip2 + f2_ * n[3]; \
      if (s == 0) obuf[(t) * 64 + col] = num * __builtin_amdgcn_rcpf(den); } while (0)
    ML_FETCH(A, 0);
#pragma unroll 1
    for (int t = 0; t < TC; t += 2) {
      ML_FETCH(B, t + 1);
      ML_STEP(A, t);
      ML_FETCH(A, min(t + 2, TC - 1));
      ML_STEP(B, t + 1);
    }
    __syncthreads();
    { const int t2 = tid >> 4, cp = (tid & 15) * 4;
      uint2 w; w.x = pk2(obuf[t2 * 64 + cp], obuf[t2 * 64 + cp + 1]); w.y = pk2(obuf[t2 * 64 + cp + 2], obuf[t2 * 64 + cp + 3]);
      *(uint2*)(raw + (size_t)(row0 + c * TC + t2) * DM + 512 + h * 64 + cp) = w; }
    if (c + 1 < nch) { LAS float* nb = lds + ((c + 1) & 1) * BUF; ML_STORE(nb); }
    __syncthreads();
  }
#pragma unroll
  for (int i = 0; i < 4; ++i) { cout[(size_t)(8 * s + 2 * i) * 64 + col] = C[i].x; cout[(size_t)(8 * s + 2 * i + 1) * 64 + col] = C[i].y;
    if (col == 0) { nout[8 * s + 2 * i] = n[i].x; nout[8 * s + 2 * i + 1] = n[i].y; } }
  if (tid == 256) mout[0] = mcar;
#undef ML_LOAD
#undef ML_STORE
#undef ML_FETCH
#undef ML_STEP
}

typedef short bf16x8_t __attribute__((ext_vector_type(8)));
typedef unsigned u32x4_t __attribute__((ext_vector_type(4)));
typedef unsigned u32x2_t __attribute__((ext_vector_type(2)));
__device__ __forceinline__ void lds_st16(LAS bf16_t* q, const uint4 v) { *(LAS u32x4_t*)q = (u32x4_t){v.x, v.y, v.z, v.w}; }
__device__ __forceinline__ void lds_st8(LAS bf16_t* q, unsigned a, unsigned b) { *(LAS u32x2_t*)q = (u32x2_t){a, b}; }
__device__ __forceinline__ unsigned short f2bf(float f) { unsigned u = __float_as_uint(f); u += 0x7FFFu + ((u >> 16) & 1u); return (unsigned short)(u >> 16); }
template <int K> __device__ __forceinline__ f4 mma_rows(const LAS bf16_t* A, int lda, const LAS bf16_t* B, int ldb, f4 acc, int lane) {
  const LAS bf16_t* ap = A + (lane & 15) * lda + (lane >> 4) * 8; const LAS bf16_t* bp = B + (lane & 15) * ldb + (lane >> 4) * 8;
#pragma unroll
  for (int k0 = 0; k0 < K; k0 += 32) acc = __builtin_amdgcn_mfma_f32_16x16x32_bf16(*(const LAS bf16x8_t*)(ap + k0), *(const LAS bf16x8_t*)(bp + k0), acc, 0, 0, 0);
  return acc;
}
template <int K, bool SWA, bool SWB> __device__ __forceinline__ f4 mma_rows_sw(const LAS bf16_t* A, int arow0, int lda, const LAS bf16_t* B, int brow0, int ldb, f4 acc, int lane) {
  const int ar = arow0 + (lane & 15), br = brow0 + (lane & 15), g = lane >> 4;
  const LAS bf16_t* ap = A + ar * lda; const LAS bf16_t* bp = B + br * ldb;
  const int sa = SWA ? ((ar >> 3) & 7) : 0, sb = SWB ? ((br >> 3) & 7) : 0;
#pragma unroll
  for (int k0 = 0; k0 < K; k0 += 32) { const int kc = (k0 >> 3) + g;
    acc = __builtin_amdgcn_mfma_f32_16x16x32_bf16(*(const LAS bf16x8_t*)(ap + ((kc ^ sa) << 3)), *(const LAS bf16x8_t*)(bp + ((kc ^ sb) << 3)), acc, 0, 0, 0); }
  return acc;
}
template <int K, int NB, int NTOT, bool SWA, bool SWB> __device__ __forceinline__ void mma_strip(const LAS bf16_t* A, int arow0, int lda, const LAS bf16_t* B, int brow0, int ldb, f4 (&acc)[NTOT], const int off, int lane) {
  const int ar = arow0 + (lane & 15), g = lane >> 4; const LAS bf16_t* ap = A + ar * lda; const int sa = SWA ? ((ar >> 3) & 7) : 0;
  bf16x8_t af[K / 32];
#pragma unroll
  for (int ks = 0; ks < K / 32; ++ks) af[ks] = *(const LAS bf16x8_t*)(ap + (((ks * 4 + g) ^ sa) << 3));
#pragma unroll
  for (int nb = 0; nb < NB; ++nb) { const int br = brow0 + nb * 16 + (lane & 15); const LAS bf16_t* bp = B + br * ldb; const int sb = SWB ? ((br >> 3) & 7) : 0;
#pragma unroll
    for (int ks = 0; ks < K / 32; ++ks) acc[off + nb] = __builtin_amdgcn_mfma_f32_16x16x32_bf16(af[ks], *(const LAS bf16x8_t*)(bp + (((ks * 4 + g) ^ sb) << 3)), acc[off + nb], 0, 0, 0); }
}
__device__ __forceinline__ int swz_col(int row, int col) { return ((((col >> 3) ^ (row >> 3)) & 7) << 3) | (col & 7); }
template <int CTRL, int RMASK> __device__ __forceinline__ float dpp_id(float x, float ident) {
  return __int_as_float(__builtin_amdgcn_update_dpp(__float_as_int(ident), __float_as_int(x), CTRL, RMASK, 0xf, false));
}
__device__ __forceinline__ float wave_scan_add(float x, int lane) {
  (void)lane;
  x += dpp_id<0x111, 0xf>(x, 0.f); x += dpp_id<0x112, 0xf>(x, 0.f); x += dpp_id<0x114, 0xf>(x, 0.f); x += dpp_id<0x118, 0xf>(x, 0.f);
  x += dpp_id<0x142, 0xa>(x, 0.f); x += dpp_id<0x143, 0xc>(x, 0.f);
  return x;
}
__device__ __forceinline__ float wave_scan_max(float x, int lane) {
  (void)lane; const float ninf = -__builtin_inff();
  x = fmaxf(x, dpp_id<0x111, 0xf>(x, ninf)); x = fmaxf(x, dpp_id<0x112, 0xf>(x, ninf)); x = fmaxf(x, dpp_id<0x114, 0xf>(x, ninf)); x = fmaxf(x, dpp_id<0x118, 0xf>(x, ninf));
  x = fmaxf(x, dpp_id<0x142, 0xa>(x, ninf)); x = fmaxf(x, dpp_id<0x143, 0xc>(x, ninf));
  return x;
}

#define LDS_BARRIER() do { asm volatile("s_waitcnt lgkmcnt(0)" ::: "memory"); __builtin_amdgcn_s_barrier(); asm volatile("" ::: "memory"); } while (0)
#define GAS __attribute__((address_space(1)))
__device__ __forceinline__ void unpack8(const u32x4_t u, float (&f)[8]) { unpack8(make_uint4(u.x, u.y, u.z, u.w), f); }
__device__ __forceinline__ void lds_st16(LAS bf16_t* q, const u32x4_t v) { *(LAS u32x4_t*)q = v; }
template <int MODE>
__device__ __forceinline__ void gla_item(const Params& p, LAS unsigned char* ldsb, int l, int b, int h, int sl) {
  constexpr int DQ = (MODE == 1) ? 64 : 128, DVP = (MODE == 1) ? 80 : (MODE == 2) ? 32 : 64, NVT = DVP / 16, NQT = DQ / 16, NVR = (MODE == 2) ? 2 : 4;
  constexpr int LQ = DQ + 8, LJ = 72, NQV = DQ / 64;
  constexpr int STILES = (NQT * NVT + 3) / 4;
  LAS bf16_t* Qs = (LAS bf16_t*)ldsb;
  LAS bf16_t* Ks = Qs + 64 * LQ;
  LAS bf16_t* KwT = Ks + 64 * LQ;
  LAS bf16_t* VT = KwT + DQ * LJ;
  LAS bf16_t* ST = VT + DVP * LJ;
  LAS bf16_t* Ws = ST + DVP * LQ;
  LAS bf16_t* Ts = Ws + 64 * LJ;
  LAS bf16_t* RT = Ts + 64 * LJ;
  LAS float* scal = (LAS float*)(RT + 64 * LJ);
  const int tid = otid(), lane = tid & 63, wv = tid >> 6, j = tid >> 3, fv = tid & 7;
  const int row0 = b * 2048;
  const GAS bf16_t* convo = (const GAS bf16_t*)(p.ws + p.big + SZ_PROJA + SZ_PROJB);
  const GAS bf16_t* projB = (const GAS bf16_t*)(p.ws + p.big + SZ_PROJA);
  const GAS float* gates = (const GAS float*)(p.ws + p.gates);
  GAS bf16_t* raw = (GAS bf16_t*)(p.ws + p.hn);
  const GAS bf16_t* qsrc; const GAS bf16_t* ksrc; const GAS bf16_t* vsrc; int ldsrc, ocol;
  if (MODE == 0) { ldsrc = CONVD; qsrc = convo + 2048 + (h >> 1) * 128; ksrc = convo + 1792 + (h >> 1) * 128; vsrc = convo + 1536 + h * 64; ocol = 768 + h * 64; }
  else if (MODE == 1) { ldsrc = PBLD; qsrc = projB + O_MQ + h * 64; ksrc = projB + O_MK + h * 64; vsrc = projB + O_MV + h * 64; ocol = 512 + h * 64; }
  else { ldsrc = CONVD; qsrc = convo + h * 128; ksrc = convo + 512 + h * 128; vsrc = convo + 1024 + h * 128 + sl * 32; ocol = h * 128 + sl * 32; }
  const GAS bf16_t* tsrc = (const GAS bf16_t*)(p.ws + p.big) + (size_t)(b * 4 + h) * 32 * 4096;
  __syncthreads();
  for (int i = tid; i < DVP * LQ / 2; i += 512) ((LAS unsigned*)ST)[i] = 0u;
  for (int i = tid; i < 64 * LJ / 2; i += 512) ((LAS unsigned*)Ws)[i] = 0u;
  if (MODE == 1) { for (int i = tid; i < 16 * LJ; i += 512) VT[64 * LJ + i] = (i < LJ) ? (bf16_t)0x3F80 : (bf16_t)0; }
  f4 accS[STILES];
#pragma unroll
  for (int t = 0; t < STILES; ++t) accS[t] = (f4){0.f, 0.f, 0.f, 0.f};
  float mprev = 0.f;
  u32x4_t rq[NQV], rk[NQV], rv, rt, rp; float ga = 0.f, gla = 0.f, gbt = 0.f;
  rv = rt = rp = (u32x4_t){0u, 0u, 0u, 0u};
#define GLA_LOAD(c) do { const size_t r_ = (size_t)(row0 + (c) * 64 + j) * ldsrc; \
    _Pragma("unroll") for (int q_ = 0; q_ < NQV; ++q_) { rq[q_] = *(const GAS u32x4_t*)(qsrc + r_ + (fv + 8 * q_) * 8); rk[q_] = *(const GAS u32x4_t*)(ksrc + r_ + (fv + 8 * q_) * 8); } \
    if (MODE != 2 || fv < 4) rv = *(const GAS u32x4_t*)(vsrc + r_ + fv * 8); \
    if (MODE == 2) { rt = *(const GAS u32x4_t*)(tsrc + ((size_t)(c) * 64 + j) * 64 + fv * 8); rp = *(const GAS u32x4_t*)(tsrc + (size_t)1024 * 4096 + ((size_t)(c) * 64 + j) * 64 + fv * 8); } \
    } while (0)
#define GLA_GATES(c) do { if (wv == 0) { const GAS float* g_ = gates + (size_t)(row0 + (c) * 64 + lane) * 32; \
      if (MODE == 0) { ga = g_[20 + h]; gla = __logf(g_[16 + h]); } else if (MODE == 1) { ga = g_[12 + h]; gla = g_[8 + h]; } else { ga = g_[h]; gla = 0.f; gbt = g_[4 + h]; } } } while (0)
#define GLA_SCAN(buf) do { if (wv == 0) { LAS float* s_ = scal + (buf) * 320; const float g_ = wave_scan_add(ga, lane); float m_ = 0.f; \
      if (MODE == 1) { const float pm_ = wave_scan_max(gla - g_, lane); m_ = g_ + fmaxf(mprev, pm_); } \
      const float ri_ = g_ - m_, cj_ = g_ - gla + ((MODE == 1) ? 2.0794415416798357f : 0.f), ri63_ = __shfl(ri_, 63); \
      s_[lane] = ri_; s_[64 + lane] = cj_; s_[128 + lane] = __expf(ri_ + mprev); s_[192 + lane] = __expf(ri63_ - cj_); s_[256 + lane] = (MODE == 2) ? gbt : __expf(-m_); \
      if (MODE == 1) mprev = __shfl(m_, 63); } } while (0)
#define GLA_STORE(buf) do { const LAS float* s_ = scal + (buf) * 320; const float wj_ = s_[192 + j]; const int pj_ = (((j >> 3) ^ fv) << 3) | (j & 7); \
    _Pragma("unroll") for (int q_ = 0; q_ < NQV; ++q_) { lds_st16(Qs + j * LQ + (fv + 8 * q_) * 8, rq[q_]); lds_st16(Ks + j * LQ + (fv + 8 * q_) * 8, rk[q_]); \
      float f_[8]; unpack8(rk[q_], f_); _Pragma("unroll") for (int e = 0; e < 8; e += 2) { const unsigned pr_ = pk2(f_[e] * wj_, f_[e + 1] * wj_); KwT[((fv + 8 * q_) * 8 + e) * LJ + pj_] = (bf16_t)(pr_ & 0xffffu); KwT[((fv + 8 * q_) * 8 + e + 1) * LJ + pj_] = (bf16_t)(pr_ >> 16); } } \
    if (MODE != 2 || fv < 4) { LAS bf16_t* vt_ = VT + fv * 8 * LJ + pj_; vt_[0] = (bf16_t)(rv.x & 0xffffu); vt_[LJ] = (bf16_t)(rv.x >> 16); vt_[2 * LJ] = (bf16_t)(rv.y & 0xffffu); vt_[3 * LJ] = (bf16_t)(rv.y >> 16); \
      vt_[4 * LJ] = (bf16_t)(rv.z & 0xffffu); vt_[5 * LJ] = (bf16_t)(rv.z >> 16); vt_[6 * LJ] = (bf16_t)(rv.w & 0xffffu); vt_[7 * LJ] = (bf16_t)(rv.w >> 16); } \
    if (MODE == 2) { lds_st16(Ts + j * LJ + fv * 8, rt); lds_st16(Ws + j * LJ + fv * 8, rp); } } while (0)
  GLA_GATES(0); GLA_LOAD(0); GLA_SCAN(0); GLA_GATES(1);
  LDS_BARRIER();
  GLA_STORE(0);
  LDS_BARRIER();
#pragma unroll 1
  for (int c = 0; c < 32; ++c) {
    const LAS float* sc = scal + (c & 1) * 320;
    if (c + 1 < 32) GLA_LOAD(c + 1);
    f4 accO[NVT];
#define GLA_O1() do { if (wv < 4) { _Pragma("unroll") for (int nb = 0; nb < NVT; ++nb) accO[nb] = (f4){0.f, 0.f, 0.f, 0.f}; \
      mma_strip<DQ, NVT, NVT, false, false>(Qs, wv * 16, LQ, ST, 0, LQ, accO, 0, lane); \
      const f4 rs4 = *(const LAS f4*)(sc + 128 + wv * 16 + (lane >> 4) * 4); \
      _Pragma("unroll") for (int nb = 0; nb < NVT; ++nb) accO[nb] *= rs4; } } while (0)
    if (MODE == 2) {
      f4 dA[1];
#pragma unroll
      for (int k = 0; k < 1; ++k) { const int t = wv, jb = t >> 1, nb = t & 1;
        dA[k] = mma_rows<DQ>(Ks + jb * 16 * LQ, LQ, ST + nb * 16 * LQ, LQ, (f4){0.f, 0.f, 0.f, 0.f}, lane); }
#pragma unroll
      for (int k = 0; k < 1; ++k) { const int t = wv, jb = t >> 1, nb = t & 1; const f4 d = dA[k];
        const int dv = nb * 16 + (lane & 15), j0 = jb * 16 + (lane >> 4) * 4;
        const u32x2_t vv = *(const LAS u32x2_t*)(VT + dv * LJ + swz_col(dv, j0));
        const f4 bt4 = *(const LAS f4*)(sc + 256 + j0), eg4 = *(const LAS f4*)(sc + 128 + j0);
        const float v0 = __uint_as_float(vv.x << 16), v1 = __uint_as_float(vv.x & 0xffff0000u), v2 = __uint_as_float(vv.y << 16), v3 = __uint_as_float(vv.y & 0xffff0000u);
        const float r0 = bt4.x * (v0 - eg4.x * d[0]), r1 = bt4.y * (v1 - eg4.y * d[1]), r2 = bt4.z * (v2 - eg4.z * d[2]), r3 = bt4.w * (v3 - eg4.w * d[3]);
        lds_st8(RT + dv * LJ + j0, pk2(r0, r1), pk2(r2, r3)); }
      LDS_BARRIER();
      GLA_O1();
      { const int t0 = (wv < 4 ? 0 : (wv - 4) * 2), nt_ = (wv < 4 ? 0 : 2);
        f4 dB[3];
#pragma unroll
        for (int k = 0; k < 3; ++k) if (k < nt_) { const int t = t0 + k, ib = t >> 1, nb = t & 1;
          dB[k] = mma_rows<64>(Ts + ib * 16 * LJ, LJ, RT + nb * 16 * LJ, LJ, (f4){0.f, 0.f, 0.f, 0.f}, lane); }
#pragma unroll
        for (int k = 0; k < 3; ++k) if (k < nt_) { const int t = t0 + k, ib = t >> 1, nb = t & 1; const f4 d = dB[k];
          lds_st8(VT + (nb * 16 + (lane & 15)) * LJ + swz_col(nb * 16 + (lane & 15), ib * 16 + (lane >> 4) * 4), pk2(d[0], d[1]), pk2(d[2], d[3])); } }
    }
    if (MODE != 2) {
      f4 dW[3];
#pragma unroll
      for (int k = 0; k < 3; ++k) { const int t = wv - 4 + 4 * k;
        if (wv >= 4 && t < 10) { const int ib = (t >= 6) ? 3 : (t >= 3) ? 2 : (t >= 1) ? 1 : 0, jb = t - ib * (ib + 1) / 2;
          dW[k] = mma_rows<DQ>(Ks + jb * 16 * LQ, LQ, Qs + ib * 16 * LQ, LQ, (f4){0.f, 0.f, 0.f, 0.f}, lane); } }
#pragma unroll
      for (int k = 0; k < 3; ++k) { const int t = wv - 4 + 4 * k;
        if (wv >= 4 && t < 10) { const int ib = (t >= 6) ? 3 : (t >= 3) ? 2 : (t >= 1) ? 1 : 0, jb = t - ib * (ib + 1) / 2; const f4 d = dW[k];
          const int i = ib * 16 + (lane & 15), j0 = jb * 16 + (lane >> 4) * 4; const float ri = sc[i];
          const f4 cj4 = *(const LAS f4*)(sc + 64 + j0);
          const float w0 = (j0 <= i) ? d[0] * __expf(ri - cj4.x) : 0.f, w1 = (j0 + 1 <= i) ? d[1] * __expf(ri - cj4.y) : 0.f, w2 = (j0 + 2 <= i) ? d[2] * __expf(ri - cj4.z) : 0.f, w3 = (j0 + 3 <= i) ? d[3] * __expf(ri - cj4.w) : 0.f;
          lds_st8(Ws + i * LJ + j0, pk2(w0, w1), pk2(w2, w3)); } }
    }
    if (MODE != 2) GLA_O1();
    LDS_BARRIER();
    if (wv < 4) {
      mma_strip<64, NVT, NVT, false, true>(Ws, wv * 16, LJ, VT, 0, LJ, accO, 0, lane);
      GAS bf16_t* obase = raw + (size_t)(row0 + c * 64 + wv * 16 + (lane >> 4) * 4) * DM + ocol + (lane & 15);
      float inv[4];
      if (MODE == 1) {
        const f4 em4 = *(const LAS f4*)(sc + 256 + wv * 16 + (lane >> 4) * 4);
#pragma unroll
        for (int r = 0; r < 4; ++r) { const float den = __shfl(accO[NVT - 1][r], lane & 48); inv[r] = __builtin_amdgcn_rcpf(fmaxf(fabsf(den), em4[r])); }
      }
#pragma unroll
      for (int nb = 0; nb < NVR; ++nb)
#pragma unroll
        for (int r = 0; r < 4; ++r) { const float o = (MODE == 1) ? accO[nb][r] * inv[r] : accO[nb][r];
          obase[r * DM + nb * 16] = (bf16_t)(pk2(o, 0.f) & 0xffffu); }
      if (c + 1 < 32) { GLA_SCAN((c + 1) & 1); if (c + 2 < 32) GLA_GATES(c + 2); }
    } else {
      const float cs = sc[128 + 63];
#pragma unroll
      for (int t = 0; t < STILES; ++t) accS[t] *= cs;
#pragma unroll
      for (int qq = 0; qq < STILES / NVT; ++qq)
        mma_strip<64, NVT, STILES, true, true>(KwT, ((wv - 4) * (STILES / NVT) + qq) * 16, LJ, VT, 0, LJ, accS, qq * NVT, lane);
#pragma unroll
      for (int t = 0; t < STILES; ++t) { const int ti = (wv - 4) * STILES + t;
        if (ti < NQT * NVT) { const int qb = ti / NVT, nb = ti - qb * NVT;
          lds_st8(ST + (nb * 16 + (lane & 15)) * LQ + qb * 16 + (lane >> 4) * 4, pk2(accS[t][0], accS[t][1]), pk2(accS[t][2], accS[t][3])); } }
    }
    LDS_BARRIER();
    if (c + 1 < 32) GLA_STORE((c + 1) & 1);
    LDS_BARRIER();
  }
  if (wv >= 4) {
    const size_t bh = ((size_t)l * 8 + b) * 4 + h;
#pragma unroll
    for (int t = 0; t < STILES; ++t) { const int ti = (wv - 4) * STILES + t;
      if (ti < NQT * NVT) { const int qb = ti / NVT, nb = ti - qb * NVT; const int dq = qb * 16 + (lane >> 4) * 4, dv = nb * 16 + (lane & 15);
        if (MODE == 0) *(float4*)(p.out + p.o_pssd + bh * 8192 + (size_t)dv * 128 + dq) = make_float4(accS[t][0], accS[t][1], accS[t][2], accS[t][3]);
        else if (MODE == 1) {
          if (dv < 64) {
#pragma unroll
            for (int r = 0; r < 4; ++r) p.out[p.o_pmc + bh * 4096 + (size_t)(dq + r) * 64 + dv] = accS[t][r];
          } else if (dv == 64) {
#pragma unroll
            for (int r = 0; r < 4; ++r) p.out[p.o_pmn + bh * 64 + dq + r] = accS[t][r];
          }
        } else {
#pragma unroll
          for (int r = 0; r < 4; ++r) p.out[p.o_pgdn + bh * 16384 + (size_t)(dq + r) * 128 + sl * 32 + dv] = accS[t][r];
        } } }
  }
  if (MODE == 1 && tid == 0) p.out[p.o_pmm + ((size_t)l * 8 + b) * 4 + h] = mprev;
#undef GLA_LOAD
#undef GLA_O1
#undef GLA_GATES
#undef GLA_SCAN
#undef GLA_STORE
}

__device__ __forceinline__ void phase_gdnT(const Params& p, int l, LAS unsigned char* ldsb) {
  const int tid = otid(), lane = tid & 63, wv = tid >> 6;
  const bf16_t* convo = (const bf16_t*)(p.ws + p.big + SZ_PROJA + SZ_PROJB);
  const float* gates = (const float*)(p.ws + p.gates);
  bf16_t* Tb = (bf16_t*)(p.ws + p.big); bf16_t* Pb = Tb + (size_t)1024 * 4096;
  if (wv < 4) {
    LAS float* Mw = (LAS float*)ldsb + wv * 4096;
    for (int item = obid() + gridDim.x * wv; item < 1024; item += gridDim.x * 4) {
      const int b = item >> 7, h = (item >> 5) & 3, c = item & 31, row0 = b * 2048 + c * 64;
      const float g = gates[(size_t)(row0 + lane) * 32 + h], beta = gates[(size_t)(row0 + lane) * 32 + 4 + h];
      const bf16_t* kbase = convo + (size_t)(row0 + (lane & 15)) * CONVD + 512 + h * 128 + (lane >> 4) * 8;
      const bf16_t* qbase = kbase - 512;
      bf16_t* pbase = Pb + (size_t)item * 4096 + (lane >> 4) * 256 + (lane & 15);
      bf16_t* tbase = Tb + (size_t)item * 4096 + lane;
      LAS float* mbase = Mw + (lane >> 4) * 256 + (lane & 15);
      const float gam = wave_scan_add(g, lane);
      bf16x8_t kf[4][4];
#pragma unroll
      for (int rb = 0; rb < 4; ++rb)
#pragma unroll
        for (int ks = 0; ks < 4; ++ks) kf[rb][ks] = *(const bf16x8_t*)(kbase + rb * 16 * CONVD + ks * 32);
      const float gj0 = __shfl(gam, lane & 15), gj1 = __shfl(gam, 16 + (lane & 15)), gj2 = __shfl(gam, 32 + (lane & 15)), gj3 = __shfl(gam, 48 + (lane & 15));
#pragma unroll
      for (int ib = 0; ib < 4; ++ib) {
        float gi[4], bi[4];
#pragma unroll
        for (int r = 0; r < 4; ++r) { gi[r] = __shfl(gam, ib * 16 + (lane >> 4) * 4 + r); bi[r] = __shfl(beta, ib * 16 + (lane >> 4) * 4 + r); }
#pragma unroll
        for (int jb = 0; jb <= ib; ++jb) {
          f4 d = (f4){0.f, 0.f, 0.f, 0.f};
#pragma unroll
          for (int ks = 0; ks < 4; ++ks) d = __builtin_amdgcn_mfma_f32_16x16x32_bf16(kf[ib][ks], kf[jb][ks], d, 0, 0, 0);
          const float gj = jb == 0 ? gj0 : jb == 1 ? gj1 : jb == 2 ? gj2 : gj3; const int jj = jb * 16 + (lane & 15);
#pragma unroll
          for (int r = 0; r < 4; ++r) { const int ii = ib * 16 + (lane >> 4) * 4 + r; mbase[(ib * 16 + r) * 64 + jb * 16] = (jj < ii) ? d[r] * __expf(gi[r] - gj) * bi[r] : 0.f; }
        }
      }
      {
        bf16x8_t qf[4];
#pragma unroll
        for (int ib = 0; ib < 4; ++ib) {
#pragma unroll
          for (int ks = 0; ks < 4; ++ks) qf[ks] = *(const bf16x8_t*)(qbase + ib * 16 * CONVD + ks * 32);
          float gi[4];
#pragma unroll
          for (int r = 0; r < 4; ++r) gi[r] = __shfl(gam, ib * 16 + (lane >> 4) * 4 + r);
#pragma unroll
          for (int jb = 0; jb < 4; ++jb) {
            f4 d = (f4){0.f, 0.f, 0.f, 0.f};
#pragma unroll
            for (int ks = 0; ks < 4; ++ks) d = __builtin_amdgcn_mfma_f32_16x16x32_bf16(qf[ks], kf[jb][ks], d, 0, 0, 0);
            const float gj = jb == 0 ? gj0 : jb == 1 ? gj1 : jb == 2 ? gj2 : gj3; const int jj = jb * 16 + (lane & 15);
#pragma unroll
            for (int r = 0; r < 4; ++r) { const int ii = ib * 16 + (lane >> 4) * 4 + r; pbase[(ib * 16 + r) * 64 + jb * 16] = (jj <= ii) ? f2bf(d[r] * __expf(gi[r] - gj)) : (bf16_t)0; }
          }
        }
      }
      float t[64];
#pragma unroll
      for (int i = 0; i < 64; ++i) t[i] = 0.f;
#pragma unroll
      for (int i = 0; i < 64; ++i) {
        float a0 = (i == lane) ? 1.0f : 0.0f, a1 = 0.f;
#pragma unroll
        for (int j4 = 0; j4 < (i + 3) / 4; ++j4) { const f4 m = *(const LAS f4*)(Mw + i * 64 + j4 * 4);
          a0 -= m.x * t[j4 * 4]; a1 -= m.y * t[j4 * 4 + 1]; a0 -= m.z * t[j4 * 4 + 2]; a1 -= m.w * t[j4 * 4 + 3]; }
        t[i] = a0 + a1;
        if ((i & 7) == 7) __builtin_amdgcn_sched_barrier(0);
      }
#pragma unroll
      for (int i = 0; i < 64; ++i) tbase[i * 64] = f2bf(t[i]);
    }
  }
}

__device__ __forceinline__ void gdn_sample(const Params& p, LAS float* lds, int l, int item) {
  const int tid = otid(), w2 = tid >> 7, j = tid & 127;
  const int pair = item * 4 + w2, bs = pair >> 2, h = pair & 3;
  const size_t bh = ((size_t)l * 128 + bs) * 4 + h;
  const float* sin = p.in[3] + bh * 16384; float* sout = p.out + p.o_sgdn + bh * 16384;
  const bf16_t* convo = (const bf16_t*)(p.ws + p.big + SZ_PROJA + SZ_PROJB);
  const float* gates = (const float*)(p.ws + p.gates);
  bf16_t* raw = (bf16_t*)(p.ws + p.hn);
  const int row0 = NPROMPT + bs * 4;
  LAS float* lq = lds + w2 * 1536; LAS float* lk = lq + 512; LAS float* lv = lq + 1024;
  __syncthreads();
#pragma unroll
  for (int t = 0; t < 4; ++t) { const bf16_t* r = convo + (size_t)(row0 + t) * CONVD + h * 128 + j; lq[t * 128 + j] = bf2f(r[0]); lk[t * 128 + j] = bf2f(r[512]); lv[t * 128 + j] = bf2f(r[1024]); }
  float S[128];
#pragma unroll
  for (int d = 0; d < 128; ++d) S[d] = sin[(size_t)d * 128 + j];
  __syncthreads();
#pragma unroll 1
  for (int t = 0; t < 4; ++t) {
    const float* g = gates + (size_t)(row0 + t) * 32;
    const float a = __expf(g[h]), bt = g[4 + h], v = lv[t * 128 + j];
    float pk0 = 0.f, pk1 = 0.f, pq0 = 0.f, pq1 = 0.f, qk0 = 0.f, qk1 = 0.f;
#pragma unroll
    for (int d = 0; d < 128; d += 4) { if ((d & 15) == 0) __builtin_amdgcn_sched_barrier(0); const f4 k4 = *(const LAS f4*)(lk + t * 128 + d), q4 = *(const LAS f4*)(lq + t * 128 + d);
      pk0 += k4.x * S[d]; pk1 += k4.y * S[d + 1]; pk0 += k4.z * S[d + 2]; pk1 += k4.w * S[d + 3];
      pq0 += q4.x * S[d]; pq1 += q4.y * S[d + 1]; pq0 += q4.z * S[d + 2]; pq1 += q4.w * S[d + 3];
      qk0 += q4.x * k4.x; qk1 += q4.y * k4.y; qk0 += q4.z * k4.z; qk1 += q4.w * k4.w; }
    const float r = bt * (v - a * (pk0 + pk1)), o = a * (pq0 + pq1) + (qk0 + qk1) * r;
#pragma unroll
    for (int d = 0; d < 128; d += 4) { if ((d & 15) == 0) __builtin_amdgcn_sched_barrier(0); const f4 k4 = *(const LAS f4*)(lk + t * 128 + d);
      S[d] = a * S[d] + k4.x * r; S[d + 1] = a * S[d + 1] + k4.y * r; S[d + 2] = a * S[d + 2] + k4.z * r; S[d + 3] = a * S[d + 3] + k4.w * r; }
    { unsigned uu = __float_as_uint(o); uu += 0x7FFFu + ((uu >> 16) & 1u); raw[(size_t)(row0 + t) * DM + h * 128 + j] = (bf16_t)(uu >> 16); }
  }
#pragma unroll
  for (int d = 0; d < 128; ++d) sout[(size_t)d * 128 + j] = S[d];
}

__device__ __forceinline__ void mlstm_sample(const Params& p, LAS float* lds, int l, int item) {
  const int tid = otid(), wv = tid >> 6, lane = tid & 63;
  const int pair = item * 8 + wv, bs = pair >> 2, h = pair & 3;
  const size_t bh = ((size_t)l * 128 + bs) * 4 + h;
  const float* cin = p.in[4] + bh * 4096; const float* nin = p.in[5] + bh * 64;
  float* cout = p.out + p.o_smc + bh * 4096; float* nout = p.out + p.o_smn + bh * 64;
  const bf16_t* projB = (const bf16_t*)(p.ws + p.big + SZ_PROJA);
  const float* gates = (const float*)(p.ws + p.gates);
  bf16_t* raw = (bf16_t*)(p.ws + p.hn);
  const int row0 = NPROMPT + bs * 4;
  LAS float* lq = lds + wv * 768; LAS float* lk = lq + 256; LAS float* lv = lq + 512;
  __syncthreads();
#pragma unroll
  for (int t = 0; t < 4; ++t) { const bf16_t* r = projB + (size_t)(row0 + t) * PBLD + h * 64 + lane; lq[t * 64 + lane] = bf2f(r[O_MQ]); lk[t * 64 + lane] = 0.125f * bf2f(r[O_MK]); lv[t * 64 + lane] = bf2f(r[O_MV]); }
  float C[64], n[64];
#pragma unroll
  for (int d = 0; d < 64; ++d) { C[d] = cin[(size_t)d * 64 + lane]; n[d] = nin[d]; }
  float m = p.in[6][bh];
  __syncthreads();
#pragma unroll 1
  for (int t = 0; t < 4; ++t) {
    const float* g = gates + (size_t)(row0 + t) * 32;
    const float li = g[8 + h], lf = g[12 + h], v = lv[t * 64 + lane];
    const float mn = fmaxf(lf + m, li), fp = __expf(lf + m - mn), ip = __expf(li - mn);
    float pc0 = 0.f, pc1 = 0.f, pn0 = 0.f, pn1 = 0.f, qk0 = 0.f, qk1 = 0.f;
#pragma unroll
    for (int d = 0; d < 64; d += 4) { if ((d & 15) == 0) __builtin_amdgcn_sched_barrier(0); const f4 k4 = *(const LAS f4*)(lk + t * 64 + d), q4 = *(const LAS f4*)(lq + t * 64 + d);
      pc0 += q4.x * C[d]; pc1 += q4.y * C[d + 1]; pc0 += q4.z * C[d + 2]; pc1 += q4.w * C[d + 3];
      pn0 += q4.x * n[d]; pn1 += q4.y * n[d + 1]; pn0 += q4.z * n[d + 2]; pn1 += q4.w * n[d + 3];
      qk0 += q4.x * k4.x; qk1 += q4.y * k4.y; qk0 += q4.z * k4.z; qk1 += q4.w * k4.w; }
    const float iqk = ip * (qk0 + qk1), num = fp * (pc0 + pc1) + iqk * v, den = fmaxf(fabsf(fp * (pn0 + pn1) + iqk), __expf(-mn)), iv = ip * v;
#pragma unroll
    for (int d = 0; d < 64; d += 4) { if ((d & 15) == 0) __builtin_amdgcn_sched_barrier(0); const f4 k4 = *(const LAS f4*)(lk + t * 64 + d);
      C[d] = fp * C[d] + iv * k4.x; C[d + 1] = fp * C[d + 1] + iv * k4.y; C[d + 2] = fp * C[d + 2] + iv * k4.z; C[d + 3] = fp * C[d + 3] + iv * k4.w;
      n[d] = fp * n[d] + ip * k4.x; n[d + 1] = fp * n[d + 1] + ip * k4.y; n[d + 2] = fp * n[d + 2] + ip * k4.z; n[d + 3] = fp * n[d + 3] + ip * k4.w; }
    m = mn;
    { unsigned uu = __float_as_uint(num / den); uu += 0x7FFFu + ((uu >> 16) & 1u); raw[(size_t)(row0 + t) * DM + 512 + h * 64 + lane] = (bf16_t)(uu >> 16); }
  }
#pragma unroll
  for (int d = 0; d < 64; ++d) { cout[(size_t)d * 64 + lane] = C[d]; if (lane == 0) nout[d] = n[d]; }
  if (lane == 0) p.out[p.o_smm + bh] = m;
}

__device__ __forceinline__ void ssd_sample(const Params& p, LAS float* lds, int l, int item) {
  const int tid = otid(), wv = tid >> 6, lane = tid & 63;
  const int pair = item * 8 + wv, bs = pair >> 2, h = pair & 3, grp = h >> 1;
  const size_t bh = ((size_t)l * 128 + bs) * 4 + h;
  const float* hin = p.in[7] + bh * 8192 + (size_t)lane * 128; float* hout = p.out + p.o_sssd + bh * 8192 + (size_t)lane * 128;
  const bf16_t* convo = (const bf16_t*)(p.ws + p.big + SZ_PROJA + SZ_PROJB);
  const float* gates = (const float*)(p.ws + p.gates);
  bf16_t* raw = (bf16_t*)(p.ws + p.hn);
  const int row0 = NPROMPT + bs * 4;
  LAS float* lb = lds + wv * 1280; LAS float* lc = lb + 512; LAS float* lx = lb + 1024;
  __syncthreads();
#pragma unroll
  for (int t = 0; t < 4; ++t) { const bf16_t* r = convo + (size_t)(row0 + t) * CONVD;
    lb[t * 128 + lane] = bf2f(r[1792 + grp * 128 + lane]); lb[t * 128 + 64 + lane] = bf2f(r[1792 + grp * 128 + 64 + lane]);
    lc[t * 128 + lane] = bf2f(r[2048 + grp * 128 + lane]); lc[t * 128 + 64 + lane] = bf2f(r[2048 + grp * 128 + 64 + lane]);
    lx[t * 64 + lane] = bf2f(r[1536 + h * 64 + lane]); }
  float H[128];
#pragma unroll
  for (int n = 0; n < 128; n += 4) { const float4 t4 = *(const float4*)(hin + n); H[n] = t4.x; H[n + 1] = t4.y; H[n + 2] = t4.z; H[n + 3] = t4.w; }
  __syncthreads();
#pragma unroll 1
  for (int t = 0; t < 4; ++t) {
    const float* g = gates + (size_t)(row0 + t) * 32;
    const float dt = g[16 + h], dA = __expf(g[20 + h]), x = lx[t * 64 + lane];
    float pc0 = 0.f, pc1 = 0.f, bc0 = 0.f, bc1 = 0.f;
#pragma unroll
    for (int n = 0; n < 128; n += 4) { if ((n & 15) == 0) __builtin_amdgcn_sched_barrier(0); const f4 b4 = *(const LAS f4*)(lb + t * 128 + n), c4 = *(const LAS f4*)(lc + t * 128 + n);
      pc0 += c4.x * H[n]; pc1 += c4.y * H[n + 1]; pc0 += c4.z * H[n + 2]; pc1 += c4.w * H[n + 3];
      bc0 += b4.x * c4.x; bc1 += b4.y * c4.y; bc0 += b4.z * c4.z; bc1 += b4.w * c4.w; }
    const float dtx = dt * x, y = dA * (pc0 + pc1) + dtx * (bc0 + bc1);
#pragma unroll
    for (int n = 0; n < 128; n += 4) { if ((n & 15) == 0) __builtin_amdgcn_sched_barrier(0); const f4 b4 = *(const LAS f4*)(lb + t * 128 + n);
      H[n] = dA * H[n] + dtx * b4.x; H[n + 1] = dA * H[n + 1] + dtx * b4.y; H[n + 2] = dA * H[n + 2] + dtx * b4.z; H[n + 3] = dA * H[n + 3] + dtx * b4.w; }
    { unsigned uu = __float_as_uint(y); uu += 0x7FFFu + ((uu >> 16) & 1u); raw[(size_t)(row0 + t) * DM + 768 + h * 64 + lane] = (bf16_t)(uu >> 16); }
  }
#pragma unroll
  for (int n = 0; n < 128; n += 4) *(float4*)(hout + n) = make_float4(H[n], H[n + 1], H[n + 2], H[n + 3]);
}

__device__ __forceinline__ void phase_mixers(const Params& p, int l, LAS float* lds, int rep = 0) {
  for (int it = obid(); it < 192; it += gridDim.x) {
    if (it < 128) gla_item<2>(p, (LAS unsigned char*)lds, l, it >> 4, (it >> 2) & 3, it & 3);
    else if (it < 160) { const int i = it - 128; gla_item<1>(p, (LAS unsigned char*)lds, l, i >> 2, i & 3, 0); }
    else { const int i = it - 160; gla_item<0>(p, (LAS unsigned char*)lds, l, i >> 2, i & 3, 0); }
  }
  unsigned* ctr = (unsigned*)(p.ws + p.ctr) + l + 2 * rep;
  LAS int* slot = (LAS int*)(lds + 32000);
  for (;;) {
    __syncthreads();
    if (otid() == 0) *slot = (int)atomicAdd(ctr, 1u);
    __syncthreads();
    const int it = *slot;
    if (it >= 256) break;
    if (it < 128) gdn_sample(p, lds, l, it);
    else if (it < 192) mlstm_sample(p, lds, l, it - 128);
    else ssd_sample(p, lds, l, it - 192);
  }
}

__device__ __forceinline__ void phase_mixout(const Params& p, int l) {
  constexpr int NR = 3;
  const bf16_t* projB = (const bf16_t*)(p.ws + p.big + SZ_PROJA);
  const bf16_t* convo = (const bf16_t*)(p.ws + p.big + SZ_PROJA + SZ_PROJB);
  const bf16_t* raw = (const bf16_t*)(p.ws + p.hn);
  bf16_t* mix = (bf16_t*)(p.ws + p.big);
  const int lane = otid() & 63, wv = otid() >> 6, c0 = lane * 16;
  const int W = gridDim.x * 8;
  float wn[2][8]; float dd = 0.f; int auxc;
  if (lane < 32) { load8f(p.in[18] + l * 128 + (c0 & 127), wn[0]); load8f(p.in[18] + l * 128 + (c0 & 127) + 8, wn[1]); auxc = O_GG + c0; }
  else if (lane < 48) { load8f(p.in[21] + l * 64 + (c0 & 63), wn[0]); load8f(p.in[21] + l * 64 + (c0 & 63) + 8, wn[1]); auxc = O_MO + (c0 - 512); }
  else { load8f(p.in[25] + l * 256 + (c0 - 768), wn[0]); load8f(p.in[25] + l * 256 + (c0 - 768) + 8, wn[1]); auxc = O_SZ + (c0 - 768); dd = p.in[24][l * 4 + ((c0 - 768) >> 6)]; }
  uint4 rv[NR][2], ra[NR][2], rx[NR][2], nv[NR][2], na[NR][2], nx[NR][2];
#define MIXO_LOAD(RV, RA, RX, r0_) do { _Pragma("unroll") for (int r = 0; r < NR; ++r) { const int row = (r0_) + r * W; \
      if (row < NTOK) { _Pragma("unroll") for (int j = 0; j < 2; ++j) { RV[r][j] = *(const uint4*)(raw + (size_t)row * DM + c0 + j * 8); RA[r][j] = *(const uint4*)(projB + (size_t)row * PBLD + auxc + j * 8); \
          if (lane >= 48) RX[r][j] = *(const uint4*)(convo + (size_t)row * CONVD + 1536 + (c0 - 768) + j * 8); } } } } while (0)
#pragma unroll
  for (int r = 0; r < NR; ++r)
#pragma unroll
    for (int j = 0; j < 2; ++j) rv[r][j] = ra[r][j] = rx[r][j] = nv[r][j] = na[r][j] = nx[r][j] = make_uint4(0u, 0u, 0u, 0u);
  MIXO_LOAD(rv, ra, rx, obid() * 8 + wv);
  for (int row0 = obid() * 8 + wv; row0 < NTOK; row0 += NR * W) {
    if (row0 + NR * W < NTOK) MIXO_LOAD(nv, na, nx, row0 + NR * W);
#pragma unroll
    for (int r = 0; r < NR; ++r) { const int row = row0 + r * W;
      if (row < NTOK) {
        float v[2][8], g[2][8]; float ss = 0.f;
#pragma unroll
        for (int j = 0; j < 2; ++j) { unpack8(rv[r][j], v[j]); unpack8(ra[r][j], g[j]); }
        if (lane >= 48) {
#pragma unroll
          for (int j = 0; j < 2; ++j) { float x[8]; unpack8(rx[r][j], x);
#pragma unroll
            for (int e = 0; e < 8; ++e) v[j][e] = (v[j][e] + dd * x[e]) * siluf(g[j][e]); }
        } else if (lane >= 32) {
#pragma unroll
          for (int j = 0; j < 2; ++j)
#pragma unroll
            for (int e = 0; e < 8; ++e) v[j][e] *= sigmoidf_(g[j][e]);
        }
#pragma unroll
        for (int j = 0; j < 2; ++j)
#pragma unroll
          for (int e = 0; e < 8; ++e) ss += v[j][e] * v[j][e];
        const float s2 = ss + dppf(ss, 0), s4 = s2 + dppf(s2, 1), s8 = s4 + dppf(s4, 2), s16 = s8 + dppf(s8, 3);
        const float rr = lane < 32 ? rsqrtf(s8 * (1.0f / 128.0f) + EPSF) : (lane < 48 ? rsqrtf(s4 * (1.0f / 64.0f) + EPSF) : rsqrtf(s16 * (1.0f / 256.0f) + EPSF));
        float y[2][8];
#pragma unroll
        for (int j = 0; j < 2; ++j)
#pragma unroll
          for (int e = 0; e < 8; ++e) { y[j][e] = v[j][e] * rr * wn[j][e]; if (lane < 32) y[j][e] *= siluf(g[j][e]); }
        *(uint4*)(mix + (size_t)row * DM + c0) = pack8(y[0]); *(uint4*)(mix + (size_t)row * DM + c0 + 8) = pack8(y[1]);
      } }
#pragma unroll
    for (int r = 0; r < NR; ++r)
#pragma unroll
      for (int j = 0; j < 2; ++j) { rv[r][j] = nv[r][j]; ra[r][j] = na[r][j]; rx[r][j] = nx[r][j]; }
  }
#undef MIXO_LOAD
}

__device__ __forceinline__ void phase_act(const Params& p, int l) {
  const bf16_t* G = (const bf16_t*)(p.ws + p.big);
  bf16_t* V = (bf16_t*)(p.ws + p.big + SZ_GV);
  const float* cw = p.in[28] + (size_t)l * 3 * DFF; const float* cb = p.in[29] + (size_t)l * DFF;
  const int gtid = obid() * 512 + otid(), gstride = gridDim.x * 512;
  if (gtid < 372 * 352) {
    const int c0 = (gtid % 352) * 8;
    float w[3][8], bias[8]; load8f(cb + c0, bias);
#pragma unroll
    for (int j = 0; j < 3; ++j) load8f(cw + j * DFF + c0, w[j]);
    uint4 cur[10], nxt[10];
#pragma unroll
    for (int i = 0; i < 10; ++i) cur[i] = nxt[i] = make_uint4(0u, 0u, 0u, 0u);
#define ACT_LOAD(R, ch) do { const int rb_ = (ch) * 4; const bf16_t* q_ = G + (size_t)rb_ * DFF + c0; const bf16_t* v_ = V + (size_t)rb_ * DFF + c0; \
      _Pragma("unroll") for (int i = 0; i < 4; ++i) { R[2 + i] = *(const uint4*)(q_ + (size_t)i * DFF); R[6 + i] = *(const uint4*)(v_ + (size_t)i * DFF); } \
      if ((rb_ & 2047) > 0) { R[0] = *(const uint4*)(q_ - (size_t)2 * DFF); R[1] = *(const uint4*)(q_ - (size_t)DFF); } } while (0)
    int chunk = gtid / 352;
    ACT_LOAD(cur, chunk);
#pragma unroll 1
    for (; chunk < 4092; chunk += 372) {
      if (chunk + 372 < 4092) ACT_LOAD(nxt, chunk + 372);
      const int rbase = chunk * 4, b = rbase >> 11, pos0 = rbase & 2047;
      float g[6][8];
#pragma unroll
      for (int i = 0; i < 4; ++i) unpack8(cur[2 + i], g[2 + i]);
      if (pos0 > 0) { unpack8(cur[0], g[0]); unpack8(cur[1], g[1]); }
      else {
#pragma unroll
        for (int e = 0; e < 8; ++e) { g[0][e] = 0.f; g[1][e] = 0.f; }
      }
#pragma unroll
      for (int i = 0; i < 4; ++i) {
        float y[8], val[8]; unpack8(cur[6 + i], val);
#pragma unroll
        for (int e = 0; e < 8; ++e) { const float t = bias[e] + w[0][e] * g[i][e] + w[1][e] * g[i + 1][e] + w[2][e] * g[i + 2][e];
          const float uu = 0.7978845608028654f * (t + 0.044715f * t * t * t);
          y[e] = (t - t * __builtin_amdgcn_rcpf(1.0f + __expf(2.0f * uu))) * val[e]; }
        *(uint4*)(V + (size_t)(rbase + i) * DFF + c0) = pack8(y);
        if (pos0 == 2044 && i >= 2) store8f(p.out + p.o_pffn + (((size_t)l * 8 + b) * 2 + (i - 2)) * DFF + c0, g[2 + i]);
      }
#pragma unroll
      for (int i = 0; i < 10; ++i) cur[i] = nxt[i];
    }
#undef ACT_LOAD
  }
  for (int it = 4092 * 352 + gtid; it < (NTOK / 4) * 352; it += gstride) {
    const int chunk = it / 352, c0 = (it - chunk * 352) * 8, rbase = chunk * 4;
    int isp, b, pos0; decode_row(rbase, isp, b, pos0);
    uint4 rg[4], rv[4]; float g[6][8];
#pragma unroll
    for (int i = 0; i < 4; ++i) { rg[i] = *(const uint4*)(G + (size_t)(rbase + i) * DFF + c0); rv[i] = *(const uint4*)(V + (size_t)(rbase + i) * DFF + c0); }
    if (isp) {
      if (pos0 > 0) {
#pragma unroll
        for (int j = 0; j < 2; ++j) unpack8(*(const uint4*)(G + (size_t)(rbase - 2 + j) * DFF + c0), g[j]);
      } else {
#pragma unroll
        for (int j = 0; j < 2; ++j)
#pragma unroll
          for (int e = 0; e < 8; ++e) g[j][e] = 0.f;
      }
    } else {
#pragma unroll
      for (int j = 0; j < 2; ++j) load8f(p.in[8] + (((size_t)l * 128 + b) * 2 + j) * DFF + c0, g[j]);
    }
    float w[3][8], bias[8]; load8f(cb + c0, bias);
#pragma unroll
    for (int j = 0; j < 3; ++j) load8f(cw + j * DFF + c0, w[j]);
#pragma unroll
    for (int i = 0; i < 4; ++i) unpack8(rg[i], g[2 + i]);
    const bool lastc = isp ? (pos0 == 2044) : true;
#pragma unroll
    for (int i = 0; i < 4; ++i) {
      float y[8], val[8]; unpack8(rv[i], val);
#pragma unroll
      for (int e = 0; e < 8; ++e) { const float t = bias[e] + w[0][e] * g[i][e] + w[1][e] * g[i + 1][e] + w[2][e] * g[i + 2][e];
        const float uu = 0.7978845608028654f * (t + 0.044715f * t * t * t);
        y[e] = (t - t * __builtin_amdgcn_rcpf(1.0f + __expf(2.0f * uu))) * val[e]; }
      *(uint4*)(V + (size_t)(rbase + i) * DFF + c0) = pack8(y);
      if (lastc && i >= 2) store8f((isp ? p.out + p.o_pffn + (((size_t)l * 8 + b) * 2 + (i - 2)) * DFF : p.out + p.o_sffn + (((size_t)l * 128 + b) * 2 + (i - 2)) * DFF) + c0, g[2 + i]);
    }
  }
}

#define XB_TMO      128
#define XB_XCNT(j)  (256  + 64 * (j))
#define XB_XSUB(j)  (1280 + 64 * (j))
#define XB_XGEN(j)  (2304 + 64 * (j))
#define XB_TOP      3328
#define XB_TOPGEN   3392
#define XCD_BAR_WORDS 3456
#define XB_SPIN_CAP (1u << 22)
__device__ __forceinline__ unsigned xb_ld(unsigned* q)              { return __hip_atomic_load(q, __ATOMIC_RELAXED, __HIP_MEMORY_SCOPE_AGENT); }
__device__ __forceinline__ unsigned xb_add(unsigned* q, unsigned v) { return __hip_atomic_fetch_add(q, v, __ATOMIC_RELAXED, __HIP_MEMORY_SCOPE_AGENT); }
__device__ __forceinline__ unsigned xb_xcc_id() { return (unsigned)__builtin_amdgcn_s_getreg((3 << 11) | 20) & 0xFu; }
#define XB_SPIN(cond, bar) do { unsigned _sp = 0; while (cond) { __builtin_amdgcn_s_sleep(1); \
    if ((++_sp & 255u) == 0u) { if (xb_ld(&(bar)[XB_TMO])) break; if (_sp > XB_SPIN_CAP) { atomicAdd(&(bar)[XB_TMO], 1u); break; } } } } while (0)
struct XcdBarrier { unsigned* bar; unsigned x; volatile LAS unsigned* st; };
__device__ __forceinline__ XcdBarrier xcd_barrier_post(unsigned* bar, volatile LAS unsigned* st) {
  XcdBarrier b; b.bar = bar; b.x = xb_xcc_id(); b.st = st;
  if (threadIdx.x == 0) (void)xb_add(&bar[XB_XCNT(b.x)], 1u);
  return b;
}
__device__ __forceinline__ void xcd_barrier_complete(unsigned* bar, unsigned x, unsigned& nloc, unsigned& nx) {
  const unsigned G = gridDim.x * gridDim.y * gridDim.z;
  unsigned sum, cnt, mine, sp = 0u;
  for (;;) {
    sum = 0u; cnt = 0u; mine = 0u;
#pragma unroll
    for (unsigned j = 0; j < 16; ++j) { const unsigned c = xb_ld(&bar[XB_XCNT(j)]); sum += c; cnt += (c > 0u) ? 1u : 0u; mine = (j == x) ? c : mine; }
    if (sum == G) break;
    __builtin_amdgcn_s_sleep(1);
    if ((++sp & 255u) == 0u) { if (xb_ld(&bar[XB_TMO])) break; if (sp > XB_SPIN_CAP) { atomicAdd(&bar[XB_TMO], 1u); break; } }
  }
  nloc = mine > 0u ? mine : 1u; nx = cnt > 0u ? cnt : 1u;
}
__device__ __forceinline__ void xcd_barrier(const XcdBarrier& b0, const Params& p) {
  XcdBarrier b; b.st = b0.st; b.bar = (unsigned*)(p.ws + p.ctr) + 64; b.x = b0.st[2];
  asm volatile("s_waitcnt vmcnt(0)" ::: "memory");
  __syncthreads();
  if (threadIdx.x == 0) {
    unsigned* bar = b.bar;
    __builtin_amdgcn_s_waitcnt(0);
    unsigned nloc = b.st[0], nx = b.st[1];
    if (nloc == 0u) { xcd_barrier_complete(bar, b.x, nloc, nx); b.st[0] = nloc; b.st[1] = nx; }
    const unsigned old = xb_add(&bar[XB_XSUB(b.x)], 1u);
    const unsigned gen = old / nloc;
    if (old + 1u == (gen + 1u) * nloc) {
      __builtin_amdgcn_fence(__ATOMIC_RELEASE, "agent");
      asm volatile("s_waitcnt vmcnt(0)" ::: "memory");
      const unsigned og = xb_add(&bar[XB_TOP], 1u);
      const unsigned tg = og / nx;
      if (og + 1u == (tg + 1u) * nx) xb_add(&bar[XB_TOPGEN], 1u);
      else XB_SPIN(xb_ld(&bar[XB_TOPGEN]) == tg, bar);
      __builtin_amdgcn_fence(__ATOMIC_ACQUIRE, "agent");
      xb_add(&bar[XB_XGEN(b.x)], 1u);
      asm volatile("s_waitcnt vmcnt(0)" ::: "memory");
    } else {
      XB_SPIN(xb_ld(&bar[XB_XGEN(b.x)]) == gen, bar);
      __builtin_amdgcn_fence(__ATOMIC_ACQUIRE, "agent");
      asm volatile("s_waitcnt vmcnt(0)" ::: "memory");
    }
  }
  __syncthreads();
}

template <class T> __device__ __forceinline__ T* uni(T* q) {
  const unsigned long long v = (unsigned long long)q;
  const unsigned lo = __builtin_amdgcn_readfirstlane((unsigned)v), hi = __builtin_amdgcn_readfirstlane((unsigned)(v >> 32));
  return (T*)(((unsigned long long)hi << 32) | lo);
}
__global__ void __launch_bounds__(512, 2) mk_forward(Params pk) {
  extern __shared__ __attribute__((aligned(16))) unsigned char shm[];
  cg::grid_group grid = cg::this_grid();
  float* ldsf = (float*)shm;
  Params* lp = (Params*)(shm + 131072);
  volatile LAS unsigned* xst = (volatile LAS unsigned*)((LAS unsigned char*)shm + 131072 + 768);
  if (otid() == 0) { *lp = pk; xst[0] = 0u; xst[1] = 0u; xst[2] = 0u; xst[3] = 0u; }
  __syncthreads();
  const Params& p = *lp;
  XcdBarrier xb = xcd_barrier_post((unsigned*)(pk.ws + pk.ctr) + 64, xst);
  if (otid() == 0) xst[2] = xb.x;
  xb.bar = nullptr; xb.x = 0;
  phase_wconv(p, 0, ldsf);
  phase_rowwise(p, true, nullptr, nullptr, p.in[9], (bf16_t*)(p.ws + p.hn), 0);
  if (gridDim.x == 0x7fffffffu) grid.sync();
  xcd_barrier(xb, p);
#pragma unroll 1
  for (int step = 0; step < 22; ++step) {
    const int l = step / 11, s = step - l * 11;
    if (s == 0 || s == 5 || s == 7 || s == 9) {
      pg8::Gemm g; pg8::EpiSplit e;
      bf16_t* big = (bf16_t*)(p.ws + p.big);
      if (s == 0) { g.A = (const bf16_t*)(p.ws + p.hn); g.Bt = (const bf16_t*)(p.ws + p.w_in); g.M = NTOK; g.N = INCP; g.K = 1024;
        e.O1 = big; e.ld1 = CONVD; e.nt1 = 9; e.O2 = (bf16_t*)(p.ws + p.big + SZ_PROJA); e.ld2 = PBLD; }
      else if (s == 5) { g.A = big; g.Bt = (const bf16_t*)(p.ws + p.w_out); g.M = NTOK; g.N = 1024; g.K = 1024;
        e.O1 = (bf16_t*)(p.ws + p.big + SZ_PROJA + SZ_PROJB); e.ld1 = DM; e.nt1 = 1000; e.O2 = e.O1; e.ld2 = DM; }
      else if (s == 7) { g.A = (const bf16_t*)(p.ws + p.hn); g.Bt = (const bf16_t*)(p.ws + p.w_up); g.M = NTOK; g.N = 5632; g.K = 1024;
        e.O1 = big; e.ld1 = DFF; e.nt1 = 11; e.O2 = (bf16_t*)(p.ws + p.big + SZ_GV); e.ld2 = DFF; }
      else { g.A = (const bf16_t*)(p.ws + p.big + SZ_GV); g.Bt = (const bf16_t*)(p.ws + p.w_dn); g.M = NTOK; g.N = 1024; g.K = DFF;
        e.O1 = (bf16_t*)(p.ws + p.hn); e.ld1 = DM; e.nt1 = 1000; e.O2 = e.O1; e.ld2 = DM; }
      g.ld = g.K; e.F = nullptr;
      const bool split = (s == 5 || s == 9);
      if (split) g.M = NPROMPT;
      g.A = uni(g.A); g.Bt = uni(g.Bt); e.O1 = uni(e.O1); e.O2 = uni(e.O2);
      float* outs = uni((float*)(p.ws + p.big + ((size_t)40 << 20)));
#pragma unroll 1
      for (int pass = 0; pass < (split ? 2 : 1); ++pass) {
        pg8::MkOrder S; S.mode = pass;
        if (pass == 0) S.st.init(g.M, g.N, (int)gridDim.x, (int)obid());
        else { S.sl.init(NTOK - NPROMPT, g.N, g.K, (int)gridDim.x, (int)obid()); g.A += (size_t)NPROMPT * g.ld; g.M = NTOK - NPROMPT; g.K = 256; e.F = outs; }
        pg8::gemm_phase<pg8::EpiSplit, pg8::MkOrder, false>((PG8_LAS unsigned char*)shm, g, S, e, nullptr);
      }
    } else if (s == 1) phase_prep(p, l);
    else if (s == 2) phase_gdnT(p, l, (LAS unsigned char*)shm);
    else if (s == 3) phase_mixers(p, l, (LAS float*)shm);
    else if (s == 4) phase_mixout(p, l);
    else if (s == 6) phase_rowwise(p, l == 0, (const bf16_t*)(p.ws + p.big + SZ_PROJA + SZ_PROJB), p.in[10] + l * DM, p.in[11] + l * DM, (bf16_t*)(p.ws + p.hn), 4);
    else if (s == 8) phase_act(p, l);
    else {
      phase_rowwise(p, false, (const bf16_t*)(p.ws + p.hn), p.in[12] + l * DM, l == 0 ? p.in[9] + DM : nullptr, (bf16_t*)(p.ws + p.hn), 11);
      if (l == 0) phase_wconv(p, 1, ldsf);
    }
    if (step < 21) xcd_barrier(xb, p);
  }
}

extern "C" void kernel_launch(void* const* d_in, const int* in_sizes, int n_in, void* d_out, int out_size, void* d_ws, size_t ws_size, hipStream_t stream) {
  constexpr size_t kDynLds = 131072 + 1024;
  static int grid_blocks = 0;
  if (!grid_blocks) {
    int dev = 0, cus = 0, per_cu = 0;
    (void)hipGetDevice(&dev);
    (void)hipDeviceGetAttribute(&cus, hipDeviceAttributeMultiprocessorCount, dev);
    (void)hipFuncSetAttribute((const void*)mk_forward, hipFuncAttributeMaxDynamicSharedMemorySize, (int)kDynLds);
    (void)hipOccupancyMaxActiveBlocksPerMultiprocessor(&per_cu, mk_forward, 512, kDynLds);
    if (per_cu < 1) per_cu = 1;
    grid_blocks = cus * 1;
  }
  Params p{};
  for (int i = 0; i < 31; ++i) p.in[i] = (const float*)d_in[i];
  p.out = (float*)d_out; p.ws = (unsigned char*)d_ws;
  long o = 0;
  o += 16777216L; p.o_ys = o; o += 524288L;
  p.o_pconv = o; o += 2L * 8 * 3 * 2304; p.o_pgdn = o; o += 2L * 8 * 4 * 16384; p.o_pmc = o; o += 2L * 8 * 4 * 4096; p.o_pmn = o; o += 2L * 8 * 4 * 64;
  p.o_pmm = o; o += 2L * 8 * 4; p.o_pssd = o; o += 2L * 8 * 4 * 8192; p.o_pffn = o; o += 2L * 8 * 2 * 2816;
  p.o_sconv = o; o += 2L * 128 * 3 * 2304; p.o_sgdn = o; o += 2L * 128 * 4 * 16384; p.o_smc = o; o += 2L * 128 * 4 * 4096; p.o_smn = o; o += 2L * 128 * 4 * 64;
  p.o_smm = o; o += 2L * 128 * 4; p.o_sssd = o; o += 2L * 128 * 4 * 8192; p.o_sffn = o; o += 2L * 128 * 2 * 2816;
  size_t w = 0;
  p.w_in = w; w += (size_t)INCP * 1024 * 2; p.w_out = w; w += (size_t)1024 * 1024 * 2; p.w_up = w; w += (size_t)5632 * 1024 * 2; p.w_dn = w; w += (size_t)1024 * DFF * 2;
  p.hn = w; w += (size_t)NTOK * DM * 2; p.gates = w; w += (size_t)NTOK * 32 * 4; p.ctr = w; w += 256 + XCD_BAR_WORDS * 4 + 256; p.big = w; w += SZ_PROJA + SZ_PROJB + SZ_PROJA;
  if (w > ws_size || o != (long)out_size) { fprintf(stderr, "workspace/out size mismatch: need %zu have %zu, out %ld vs %d\n", w, ws_size, o, out_size); return; }
  (void)hipMemsetAsync((unsigned char*)d_ws + p.ctr, 0, 256 + XCD_BAR_WORDS * 4, stream);
  void* args[] = {&p};
  hipError_t e = hipLaunchCooperativeKernel((void*)mk_forward, dim3(grid_blocks), dim3(512), args, kDynLds, stream);
  if (e != hipSuccess) fprintf(stderr, "cooperative launch failed: %s (grid %d)\n", hipGetErrorString(e), grid_blocks);
}
```
